# Optimizing an MI355X kernel written in HIP

```python
import jax, jax.numpy as jnp
from jax import lax
import numpy as np

D_MODEL = 1024
BATCH = 1
SEQ = 16384
DEPTH = 2

HEAD_DIM = 64
SB_HEADS = 8
MOBA_HEADS = 8
DSA_HEADS = 16
QBLK = 128
MOBA_BLOCK = 256
MOBA_TOPK = 3
DSA_TOPK = 256
IDX_HEADS = 8
IDX_DIM = 64
N_EXPERTS = 32
TOP_K = 4
D_FF = 1024
SWIGLU_LIMIT = 7.0
SWIGLU_ALPHA = 1.702
MOE_GROUP = 128
PLE_DIM = 256
ROPE_THETA = 10000.0
LN_EPS = 1e-5
DN_ALPHA = (2 * DEPTH) ** 0.25
DN_BETA = (8 * DEPTH) ** -0.25

AB_WIDTH = (SB_HEADS + MOBA_HEADS) * HEAD_DIM
AB_IN = 3 * AB_WIDTH
C_WIDTH = DSA_HEADS * HEAD_DIM
C_IN = 3 * C_WIDTH + IDX_HEADS * IDX_DIM + IDX_DIM + IDX_HEADS
N_EVEN = (DEPTH + 1) // 2
N_ODD = DEPTH // 2

kernel_name = "hybrid_stickbreak_moba_dsa_moe_deepnorm"


def layer_norm(x, g, b):
    xf = x.astype(jnp.float32)
    mu = jnp.mean(xf, axis=-1, keepdims=True)
    var = jnp.mean(jnp.square(xf - mu), axis=-1, keepdims=True)
    return ((xf - mu) * lax.rsqrt(var + LN_EPS) * g + b).astype(x.dtype)


def rope(x, pos):
    d = x.shape[-1]
    half = d // 2
    inv = ROPE_THETA ** (-jnp.arange(half, dtype=jnp.float32) / half)
    ang = pos.astype(jnp.float32)[:, None] * inv[None, :]
    shp = (1, ang.shape[0]) + (1,) * (x.ndim - 3) + (half,)
    cos = jnp.cos(ang).reshape(shp)
    sin = jnp.sin(ang).reshape(shp)
    xf = x.astype(jnp.float32)
    x1, x2 = xf[..., :half], xf[..., half:]
    return jnp.concatenate([x1 * cos - x2 * sin, x2 * cos + x1 * sin], axis=-1).astype(x.dtype)


def stick_breaking_attention(q, k, v):
    B, S, H, Dh = q.shape
    scale = Dh ** -0.5
    kpos = jnp.arange(S)

    def block(i):
        qi = lax.dynamic_slice_in_dim(q, i * QBLK, QBLK, axis=1)
        z = jnp.einsum('bqhd,bshd->bhqs', qi, k).astype(jnp.float32) * scale
        qpos = i * QBLK + jnp.arange(QBLK)
        mask = (kpos[None, :] < qpos[:, None])[None, None]
        log_stay = jnp.where(mask, jax.nn.log_sigmoid(-z), 0.0)
        suffix = lax.cumsum(log_stay, axis=3, reverse=True) - log_stay
        a = jnp.where(mask, jnp.exp(jax.nn.log_sigmoid(z) + suffix), 0.0)
        return jnp.einsum('bhqs,bshd->bqhd', a.astype(v.dtype), v)

    out = lax.map(block, jnp.arange(S // QBLK))
    return out.transpose(1, 0, 2, 3, 4).reshape(B, S, H, Dh)


def moba_attention(q, k, v):
    B, S, H, Dh = q.shape
    scale = Dh ** -0.5
    nb = -(-S // MOBA_BLOCK)
    pad = nb * MOBA_BLOCK - S
    kp = jnp.pad(k, ((0, 0), (0, pad), (0, 0), (0, 0)))
    vp = jnp.pad(v, ((0, 0), (0, pad), (0, 0), (0, 0)))
    kblk = kp.reshape(B, nb, MOBA_BLOCK, H, Dh)
    vblk = vp.reshape(B, nb, MOBA_BLOCK, H, Dh)
    kmean = jnp.mean(kblk.astype(jnp.float32), axis=2).astype(k.dtype)
    kbh = kblk.transpose(0, 3, 1, 2, 4)
    vbh = vblk.transpose(0, 3, 1, 2, 4)
    n_sel = min(MOBA_TOPK, nb - 1)
    bi = jnp.arange(B)[:, None, None, None]
    hi = jnp.arange(H)[None, :, None, None]
    own_off = jnp.arange(MOBA_BLOCK)

    def block(i):
        q0 = i * QBLK
        qi = lax.dynamic_slice_in_dim(q, q0, QBLK, axis=1)
        qh = qi.transpose(0, 2, 1, 3)
        qpos = q0 + jnp.arange(QBLK)
        cur = q0 // MOBA_BLOCK
        k_own = lax.dynamic_index_in_dim(kblk, cur, axis=1, keepdims=False)
        v_own = lax.dynamic_index_in_dim(vblk, cur, axis=1, keepdims=False)
        s_own = jnp.einsum('bhqd,bkhd->bhqk', qh, k_own).astype(jnp.float32) * scale
        own_pos = cur * MOBA_BLOCK + own_off
        s_own = jnp.where((own_pos[None, :] <= qpos[:, None])[None, None], s_own, -jnp.inf)
        if n_sel == 0:
            pr = jax.nn.softmax(s_own, axis=-1)
            return jnp.einsum('bhqk,bkhd->bqhd', pr.astype(v.dtype), v_own)
        gate = jnp.einsum('bhqd,bnhd->bhqn', qh, kmean).astype(jnp.float32)
        gate = jnp.where((jnp.arange(nb) < cur)[None, None, None], gate, -jnp.inf)
        _, g_idx = lax.top_k(gate, n_sel)
        valid = g_idx < cur
        k_sel = kbh[bi, hi, g_idx]
        v_sel = vbh[bi, hi, g_idx]
        s_sel = jnp.einsum('bhqd,bhqjkd->bhqjk', qh, k_sel).astype(jnp.float32) * scale
        s_sel = jnp.where(valid[..., None], s_sel, -jnp.inf).reshape(B, H, QBLK, n_sel * MOBA_BLOCK)
        pr = jax.nn.softmax(jnp.concatenate([s_own, s_sel], axis=-1), axis=-1).astype(v.dtype)
        p_own = pr[..., :MOBA_BLOCK]
        p_sel = pr[..., MOBA_BLOCK:].reshape(B, H, QBLK, n_sel, MOBA_BLOCK)
        return (jnp.einsum('bhqk,bkhd->bqhd', p_own, v_own)
                + jnp.einsum('bhqjk,bhqjkd->bqhd', p_sel, v_sel))

    out = lax.map(block, jnp.arange(S // QBLK))
    return out.transpose(1, 0, 2, 3, 4).reshape(B, S, H, Dh)


def dsa_attention(q, k, v, qi, ki, wi):
    B, S, H, Dh = q.shape
    scale = Dh ** -0.5
    idx_scale = IDX_DIM ** -0.5
    topk = min(DSA_TOPK, S // 4)
    kpos = jnp.arange(S)
    bi = jnp.arange(B)[:, None, None]

    def block(i):
        q0 = i * QBLK
        qb = lax.dynamic_slice_in_dim(q, q0, QBLK, axis=1)
        qib = lax.dynamic_slice_in_dim(qi, q0, QBLK, axis=1)
        wib = lax.dynamic_slice_in_dim(wi, q0, QBLK, axis=1).astype(jnp.float32)
        qpos = q0 + jnp.arange(QBLK)
        logits = jnp.einsum('bqhd,bsd->bqhs', qib, ki).astype(jnp.float32) * idx_scale
        score = jnp.einsum('bqh,bqhs->bqs', wib, jax.nn.relu(logits))
        causal = (kpos[None, :] <= qpos[:, None])[None]
        score = jnp.where(causal, score, -jnp.inf)
        _, sel = lax.top_k(score, topk)
        valid = sel <= qpos[None, :, None]
        k_sel = k[bi, sel]
        v_sel = v[bi, sel]
        s = jnp.einsum('bqhd,bqkhd->bhqk', qb, k_sel).astype(jnp.float32) * scale
        s = jnp.where(valid[:, None], s, -jnp.inf)
        pr = jax.nn.softmax(s, axis=-1).astype(v.dtype)
        return jnp.einsum('bhqk,bqkhd->bqhd', pr, v_sel)

    out = lax.map(block, jnp.arange(S // QBLK))
    return out.transpose(1, 0, 2, 3, 4).reshape(B, S, H, Dh)


def mixer_ab(x, w_in, w_out):
    B, S, _ = x.shape
    pos = jnp.arange(S)
    h = x @ w_in
    qa, ka, va, qb, kb, vb = jnp.split(h, 6, axis=-1)
    shp_a = (B, S, SB_HEADS, HEAD_DIM)
    shp_b = (B, S, MOBA_HEADS, HEAD_DIM)
    oa = stick_breaking_attention(qa.reshape(shp_a), ka.reshape(shp_a), va.reshape(shp_a))
    ob = moba_attention(rope(qb.reshape(shp_b), pos), rope(kb.reshape(shp_b), pos), vb.reshape(shp_b))
    o = jnp.concatenate([oa.reshape(B, S, -1), ob.reshape(B, S, -1)], axis=-1)
    return o @ w_out


def mixer_c(x, w_in, w_out):
    B, S, _ = x.shape
    pos = jnp.arange(S)
    h = x @ w_in
    cuts = np.cumsum([C_WIDTH, C_WIDTH, C_WIDTH, IDX_HEADS * IDX_DIM, IDX_DIM]).tolist()
    q, k, v, qi, ki, wi = jnp.split(h, cuts, axis=-1)
    shp = (B, S, DSA_HEADS, HEAD_DIM)
    q = rope(q.reshape(shp), pos)
    k = rope(k.reshape(shp), pos)
    qi = rope(qi.reshape(B, S, IDX_HEADS, IDX_DIM), pos)
    ki = rope(ki, pos)
    wi = wi * IDX_HEADS ** -0.5
    o = dsa_attention(q, k, v.reshape(shp), qi, ki, wi)
    return o.reshape(B, S, -1) @ w_out


def moe(x, w_r, b_r, w1, b1, w2, b2):
    B, S, D = x.shape
    T = B * S
    x2 = x.reshape(T, D)
    logits = (x2 @ w_r + b_r).astype(jnp.float32)
    top_val, top_idx = lax.top_k(logits, TOP_K)
    gates = jax.nn.softmax(top_val, axis=-1)
    n_assign = T * TOP_K
    flat_e = top_idx.reshape(-1)
    flat_tok = jnp.arange(n_assign) // TOP_K
    order = jnp.argsort(flat_e)
    sorted_e = flat_e[order]
    sorted_tok = flat_tok[order]
    gate_sorted = gates.reshape(-1)[order].astype(x.dtype)
    counts = jnp.bincount(flat_e, length=N_EXPERTS)
    starts = jnp.cumsum(counts) - counts
    pcounts = (counts + MOE_GROUP - 1) // MOE_GROUP * MOE_GROUP
    pends = jnp.cumsum(pcounts)
    pstarts = pends - pcounts
    dest = pstarts[sorted_e] + (jnp.arange(n_assign) - starts[sorted_e])
    P = n_assign + N_EXPERTS * MOE_GROUP
    n_grp = P // MOE_GROUP
    buf = jnp.zeros((P, D), x.dtype).at[dest].set(x2[sorted_tok])
    grp_e = jnp.minimum(jnp.searchsorted(pends, jnp.arange(n_grp) * MOE_GROUP, side='right'), N_EXPERTS - 1)

    def expert_group(args):
        xb, e = args
        hgu = xb @ w1[e] + b1[e]
        g = jnp.minimum(hgu[:, 0::2], SWIGLU_LIMIT)
        u = jnp.clip(hgu[:, 1::2], -SWIGLU_LIMIT, SWIGLU_LIMIT)
        glu = g * jax.nn.sigmoid(SWIGLU_ALPHA * g)
        return ((u + 1.0) * glu) @ w2[e] + b2[e]

    out = lax.map(expert_group, (buf.reshape(n_grp, MOE_GROUP, D), grp_e)).reshape(P, D)
    y_sorted = out[dest] * gate_sorted[:, None]
    y = jax.ops.segment_sum(y_sorted, sorted_tok, num_segments=T)
    return y.reshape(B, S, D)


def setup_inputs(seed: int = 0) -> dict:
    key = jax.random.key(seed)
    ks = jax.random.split(key, 17)
    nrm = jax.random.normal
    f32 = jnp.float32
    return {
        "x": nrm(ks[0], (BATCH, SEQ, D_MODEL), f32),
        "p": nrm(ks[1], (DEPTH, BATCH, SEQ, PLE_DIM), f32),
        "ab_w_in": nrm(ks[2], (N_EVEN, D_MODEL, AB_IN), f32) * D_MODEL ** -0.5,
        "ab_w_out": nrm(ks[3], (N_EVEN, AB_WIDTH, D_MODEL), f32) * (AB_WIDTH ** -0.5 * DN_BETA),
        "c_w_in": nrm(ks[4], (N_ODD, D_MODEL, C_IN), f32) * D_MODEL ** -0.5,
        "c_w_out": nrm(ks[5], (N_ODD, C_WIDTH, D_MODEL), f32) * (C_WIDTH ** -0.5 * DN_BETA),
        "ln_g": 1.0 + 0.01 * nrm(ks[6], (DEPTH, 2, D_MODEL), f32),
        "ln_b": 0.01 * nrm(ks[7], (DEPTH, 2, D_MODEL), f32),
        "router_w": nrm(ks[8], (DEPTH, D_MODEL, N_EXPERTS), f32) * D_MODEL ** -0.5,
        "router_b": 0.01 * nrm(ks[9], (DEPTH, N_EXPERTS), f32),
        "moe_w1": nrm(ks[10], (DEPTH, N_EXPERTS, D_MODEL, 2 * D_FF), f32) * D_MODEL ** -0.5,
        "moe_b1": 0.01 * nrm(ks[11], (DEPTH, N_EXPERTS, 2 * D_FF), f32),
        "moe_w2": nrm(ks[12], (DEPTH, N_EXPERTS, D_FF, D_MODEL), f32) * (D_FF ** -0.5 * DN_BETA),
        "moe_b2": 0.01 * nrm(ks[13], (DEPTH, N_EXPERTS, D_MODEL), f32),
        "ple_w_proj": nrm(ks[14], (DEPTH, PLE_DIM, D_MODEL), f32) * PLE_DIM ** -0.5,
        "ple_w_gate": nrm(ks[15], (DEPTH, D_MODEL, D_MODEL), f32) * D_MODEL ** -0.5,
    }


def reference(x, p, ab_w_in, ab_w_out, c_w_in, c_w_out, ln_g, ln_b, router_w, router_b,
              moe_w1, moe_b1, moe_w2, moe_b2, ple_w_proj, ple_w_gate):
    for i in range(DEPTH):
        j = i // 2
        if i % 2 == 0:
            m = mixer_ab(x, ab_w_in[j], ab_w_out[j])
        else:
            m = mixer_c(x, c_w_in[j], c_w_out[j])
        x = layer_norm(DN_ALPHA * x + m, ln_g[i, 0], ln_b[i, 0])
        f = moe(x, router_w[i], router_b[i], moe_w1[i], moe_b1[i], moe_w2[i], moe_b2[i])
        x = layer_norm(DN_ALPHA * x + f, ln_g[i, 1], ln_b[i, 1])
        x = x + jax.nn.sigmoid(x @ ple_w_gate[i]) * (p[i] @ ple_w_proj[i])
    return x
```

```cpp
#include <hip/hip_runtime.h>
#include <hip/hip_cooperative_groups.h>
#include <stdint.h>
#include <cstdio>
namespace cg = cooperative_groups;

typedef unsigned short bf16_t;
typedef short bf16x8 __attribute__((ext_vector_type(8)));
typedef float f32x4 __attribute__((ext_vector_type(4)));
typedef float f32x16 __attribute__((ext_vector_type(16)));
typedef unsigned u32x4 __attribute__((ext_vector_type(4)));

#define T_ 16384
#define DM 1024
#define NEXP 32
#define C_IN_ 3656
#define C_INP 3840
#define LOG2E 1.4426950408889634f
#define DN_ALPHA 1.4142135623730951f
#define NTHR 512
#define NWAVE 8

__device__ __forceinline__ int otid() { int t = threadIdx.x; asm volatile("" : "+v"(t)); return t; }
__device__ __forceinline__ bf16_t f2bf(float f) { unsigned u = __float_as_uint(f); u += 0x7FFFu + ((u >> 16) & 1u); return (bf16_t)(u >> 16); }
__device__ __forceinline__ float bf2f(bf16_t b) { return __uint_as_float(((unsigned)b) << 16); }
typedef __bf16 bf16v2_ __attribute__((ext_vector_type(2)));
typedef float f32v2_ __attribute__((ext_vector_type(2)));
__device__ __forceinline__ unsigned pack2(float lo, float hi) { const f32v2_ v = {lo, hi}; return __builtin_bit_cast(unsigned, __builtin_convertvector(v, bf16v2_)); }
__device__ __forceinline__ float fexp2(float x) { return __builtin_amdgcn_exp2f(x); }
__device__ __forceinline__ float flog2(float x) { return __builtin_amdgcn_logf(x); }
__device__ __forceinline__ float sigmoidf_(float x) { return __builtin_amdgcn_rcpf(1.0f + __builtin_amdgcn_exp2f(-LOG2E * x)); }
__device__ __forceinline__ float wave_sum(float v) {
#pragma unroll
    for (int o = 32; o > 0; o >>= 1) v += __shfl_xor(v, o);
    return v;
}

struct P {
    const float *x, *p, *ab_w_in, *ab_w_out, *c_w_in, *c_w_out, *ln_g, *ln_b, *router_w, *router_b, *moe_w1, *moe_b1, *moe_w2, *moe_b2, *ple_w_proj, *ple_w_gate;
    float* out;
    bf16_t *wb_ab_in, *wb_ab_out, *wb_c_in, *wb_c_out, *wb_w1, *wb_w2, *wb_g, *wb_p;
    bf16_t *xb, *pb;
    float* pp;
    float* rope;
    bf16_t *q16, *k16, *vT16, *o;
    float* ksum;
    unsigned* kmax2;
    int* mb_cnt;
    int* mb_list;
    float* mb_part;
    float* mb_l;
    float *ypre, *x1;
    bf16_t* x1b;
    bf16_t *act, *oslot;
    float* x2;
    bf16_t* x2b;
    float* x3;
    bf16_t *qi, *ki;
    float* wi;
    unsigned* bm;
    int *cnt, *tok_of, *sel_e, *sel_pos;
    float* sel_g;
    float* dbg;
    unsigned* bar;
};

__device__ __forceinline__ int zz_unit(int r, int b, int G) { return (r & 1) ? (r * G + (G - 1 - b)) : (r * G + b); }

__device__ __forceinline__ int w1map(int n) {
    const int is_up = n & 1, j = n >> 1, tile = j >> 7, jj = j & 127, wc = jj >> 5, jl = jj & 31;
    return tile * 256 + wc * 64 + is_up * 32 + jl;
}

__device__ __forceinline__ void conv_job(const float* __restrict__ src, bf16_t* __restrict__ dst, int K, int N, int dst_rows, int mode, int batch) {
    const int tid = otid(), lane = tid & 63, wid = tid >> 6, kg = lane & 7, ng = lane >> 3;
    const int tkn = K / 64, tnn = dst_rows / 32, per = tkn * tnn, total = per * batch;
    const int stride = gridDim.x * NWAVE;
    int u = blockIdx.x * NWAVE + wid;
    if (u >= total) return;
    f32x4 v[8], w[8];
    auto coords = [&](int uu, const float*& S, bf16_t*& D, int& k0, int& n) {
        const int bt = uu / per, r = uu % per, tn = r / tkn, tk = r % tkn;
        S = src + (size_t)bt * K * N; D = dst + (size_t)bt * dst_rows * K; k0 = tk * 64 + 8 * kg; n = tn * 32 + 4 * ng;
    };
    auto load = [&](f32x4 (&x)[8], const float* S, int k0, int n) {
#pragma unroll
        for (int j = 0; j < 8; ++j) { x[j] = (f32x4){0.f, 0.f, 0.f, 0.f}; if (n < N) x[j] = *(const f32x4*)(S + (size_t)(k0 + j) * N + n); }
    };
    auto store = [&](const f32x4 (&x)[8], bf16_t* D, int k0, int n) {
#pragma unroll
        for (int i = 0; i < 4; ++i) {
            const int drow = (mode == 1) ? w1map(n + i) : (n + i);
            *(u32x4*)(D + (size_t)drow * K + k0) = (u32x4){pack2(x[0][i], x[1][i]), pack2(x[2][i], x[3][i]), pack2(x[4][i], x[5][i]), pack2(x[6][i], x[7][i])};
        }
    };
    const float* S0; bf16_t* D0; int k00, n0;
    coords(u, S0, D0, k00, n0);
    load(v, S0, k00, n0);
#pragma unroll 1
    for (;;) {
        const int u1 = u + stride;
        const float* S1 = S0; bf16_t* D1 = D0; int k01 = k00, n1 = n0;
        if (u1 < total) { coords(u1, S1, D1, k01, n1); load(w, S1, k01, n1); }
        store(v, D0, k00, n0);
        if (u1 >= total) break;
        const int u2 = u1 + stride;
        if (u2 < total) { coords(u2, S0, D0, k00, n0); load(v, S0, k00, n0); }
        store(w, D1, k01, n1);
        if (u2 >= total) break;
        u = u2;
    }
}

__device__ __forceinline__ void phase_convert(const P& p, char* lds) {
    conv_job(p.ab_w_in, p.wb_ab_in, 1024, 3072, 3072, 0, 1);
    conv_job(p.ab_w_out, p.wb_ab_out, 1024, 1024, 1024, 0, 1);
    conv_job(p.c_w_in, p.wb_c_in, 1024, C_IN_, C_INP, 0, 1);
    conv_job(p.c_w_out, p.wb_c_out, 1024, 1024, 1024, 0, 1);
    conv_job(p.moe_w1, p.wb_w1, 1024, 2048, 2048, 1, 64);
    conv_job(p.moe_w2, p.wb_w2, 1024, 1024, 1024, 0, 64);
    conv_job(p.ple_w_gate, p.wb_g, 1024, 1024, 1024, 0, 2);
    conv_job(p.ple_w_proj, p.wb_p, 256, 1024, 1024, 0, 2);
    const size_t gtid = (size_t)blockIdx.x * NTHR + otid(), gsz = (size_t)gridDim.x * NTHR;
    for (size_t i = gtid; i < (size_t)T_ * DM / 4; i += gsz) {
        const f32x4 v = *(const f32x4*)(p.x + 4 * i);
        *(uint2*)(p.xb + 4 * i) = make_uint2(pack2(v[0], v[1]), pack2(v[2], v[3]));
    }
    for (size_t i = gtid; i < (size_t)2 * T_ * 256 / 4; i += gsz) {
        const f32x4 v = *(const f32x4*)(p.p + 4 * i);
        *(uint2*)(p.pb + 4 * i) = make_uint2(pack2(v[0], v[1]), pack2(v[2], v[3]));
    }
    for (size_t i = gtid; i < (size_t)T_ * 32; i += gsz) {
        const int pos = (int)(i >> 5), k = (int)(i & 31);
        const double inv = exp2(-(double)k * (13.287712379549449 / 32.0));
        const double ang = (double)pos * inv;
        const double red = ang - 6.283185307179586 * floor(ang * 0.15915494309189535);
        float sn_, cs_;
        sincosf((float)red, &sn_, &cs_);
        p.rope[2 * i] = cs_;
        p.rope[2 * i + 1] = sn_;
    }
    for (size_t i = gtid; i < 8 * 64 * 64; i += gsz) p.ksum[i] = 0.f;
    if (blockIdx.x == 0 && otid() < 64) p.cnt[otid()] = 0;
    if (blockIdx.x == 0 && otid() < 32) p.kmax2[otid()] = 0u;
    if (blockIdx.x == 1) p.mb_cnt[otid()] = 0;
}

#define G_TILE_B 32768
#define G_STAGE_B 65536
#define G_LDS_B 131072
__device__ __forceinline__ int g_lds_byte(int r, int c) {
    const int st = (r >> 4) * 2 + (c >> 5), ob = (r & 15) * 64 + (c & 31) * 2;
    return st * 1024 + (ob ^ (((ob >> 9) & 1) << 5));
}
__device__ __forceinline__ void g_stage_rc(int b, int& R, int& C) {
    const int st = b >> 10, sb = b & 1023, swz = sb ^ (((sb >> 9) & 1) << 5);
    R = (st >> 1) * 16 + swz / 64;
    C = (st & 1) * 32 + (swz % 64) / 2;
}
__device__ __forceinline__ int xcd_remap(int l, int C) {
    const int chunk = (C + 7) >> 3, j = l >> 3, x = l & 7, ul = x * chunk + j;
    return (j < chunk && ul < C) ? ul : -1;
}
struct RoundUnits {
    int total;
    __device__ __forceinline__ int operator()(int k) const {
        const int G = gridDim.x, C = total - k * G;
        if (C <= 0) return -1;
        const int ul = xcd_remap(blockIdx.x, C < G ? C : G);
        return ul < 0 ? -1 : k * G + ul;
    }
};
#define G8_LAS __attribute__((address_space(3)))
#define G8_HTB 16384
struct AOff { unsigned o[2][2]; };

__device__ __forceinline__ void g8_rc(int i, int& R, int& C) { g_stage_rc(otid() * 16 + i * 8192, R, C); }
__device__ __forceinline__ AOff g8_dense_a(int row0, int ld) {
    AOff a; int R, C;
#pragma unroll
    for (int i = 0; i < 2; ++i) {
        g8_rc(i, R, C);
        a.o[0][i] = (unsigned)(((size_t)(row0 + R) * ld + C) * 2);
        a.o[1][i] = (unsigned)(((size_t)(row0 + 128 + R) * ld + C) * 2);
    }
    return a;
}

struct NoHalf { __device__ __forceinline__ bool operator()(int) const { return false; } };
template <bool TR, class UnitFn, class AFn, class BFn, class EpiFn, class HalfFn = NoHalf>
__device__ __forceinline__ void gemm8_units(UnitFn unit_of, int K, char* lds_, const bf16_t* Abase, AFn aoff_of, BFn bbase_of, EpiFn epi, HalfFn half_of = HalfFn()) {
    G8_LAS unsigned char* lds = (G8_LAS unsigned char*)lds_;
    const int tid = otid(), wid = __builtin_amdgcn_readfirstlane(tid >> 6), lane = tid & 63, wr = wid >> 2, wc = wid & 3, fr = lane & 15, fq = lane >> 4;
    const int nt = K / 64;
    int cur = unit_of(0);
    if (cur < 0) return;
    unsigned voffB[2];
#pragma unroll
    for (int i = 0; i < 2; ++i) { int R, C; g8_rc(i, R, C); voffB[i] = (unsigned)(((64 * (R >> 5) + (R & 31)) * K + C) * 2); }
    const size_t kstep = 128;
    const size_t hstepB = (size_t)32 * K * 2;
    const unsigned ldsw = (unsigned)wid * 1024u;
    const int aoffl = g_lds_byte(wr * 64 + fr, fq * 8), boffl = g_lds_byte(wc * 32 + fr, fq * 8);
#define G8_SA(b, h) (((b) * 2 + (h)) * G8_HTB)
#define G8_SB(b, h) ((4 + (b) * 2 + (h)) * G8_HTB)
#define G8_STAGE_A(bufoff, AO, h, kb) do { _Pragma("unroll") for (int _i = 0; _i < 2; ++_i) \
        __builtin_amdgcn_global_load_lds((const unsigned*)((const char*)Abase + (kb) + (AO).o[h][_i]), (G8_LAS unsigned*)(lds + (bufoff) + ldsw + _i * 8192), 16, 0, 0); } while (0)
#define G8_STAGE_B(bufoff, gbase) do { _Pragma("unroll") for (int _i = 0; _i < 2; ++_i) \
        __builtin_amdgcn_global_load_lds((const unsigned*)((const char*)(gbase) + voffB[_i]), (G8_LAS unsigned*)(lds + (bufoff) + ldsw + _i * 8192), 16, 0, 0); } while (0)
#define G8_LDA(dst, b, h) do { _Pragma("unroll") for (int m = 0; m < 4; ++m) _Pragma("unroll") for (int k = 0; k < 2; ++k) dst[m][k] = *(const G8_LAS bf16x8*)(lds + G8_SA(b, h) + aoffl + m * 2048 + k * 1024); } while (0)
#define G8_LDB(dst, b, h) do { _Pragma("unroll") for (int n = 0; n < 2; ++n) _Pragma("unroll") for (int k = 0; k < 2; ++k) dst[n][k] = *(const G8_LAS bf16x8*)(lds + G8_SB(b, h) + boffl + n * 2048 + k * 1024); } while (0)
#define G8_MMA(ai, bj, At_, Bt_) do { __builtin_amdgcn_s_setprio(1); _Pragma("unroll") for (int m = 0; m < 4; ++m) _Pragma("unroll") for (int n = 0; n < 2; ++n) _Pragma("unroll") for (int k = 0; k < 2; ++k) \
        acc[ai][bj][m][n] = TR ? __builtin_amdgcn_mfma_f32_16x16x32_bf16(Bt_[n][k], At_[m][k], acc[ai][bj][m][n], 0, 0, 0) \
                               : __builtin_amdgcn_mfma_f32_16x16x32_bf16(At_[m][k], Bt_[n][k], acc[ai][bj][m][n], 0, 0, 0); __builtin_amdgcn_s_setprio(0); } while (0)
#define G8_WAIT_V(n) asm volatile("s_waitcnt vmcnt(" #n ")" ::: "memory")
#define G8_WAIT_L(n) asm volatile("s_waitcnt lgkmcnt(" #n ")" ::: "memory")
#define G8_BAR __builtin_amdgcn_s_barrier()
#define G8_SCHED __builtin_amdgcn_sched_barrier(0)
    f32x4 acc[2][2][4][2];
#pragma unroll
    for (int a = 0; a < 2; ++a)
#pragma unroll
        for (int b = 0; b < 2; ++b)
#pragma unroll
            for (int m = 0; m < 4; ++m)
#pragma unroll
                for (int n = 0; n < 2; ++n) acc[a][b][m][n] = (f32x4){0.f, 0.f, 0.f, 0.f};
    bf16x8 At[4][2], B0[2][2], B1[2][2];
    AOff cA = aoff_of(cur), nA = cA;
    const char* cB = (const char*)bbase_of(cur);
    __syncthreads();
    G8_STAGE_B(G8_SB(0, 0), cB); G8_STAGE_A(G8_SA(0, 0), cA, 0, 0); G8_STAGE_B(G8_SB(0, 1), cB + hstepB); G8_STAGE_A(G8_SA(0, 1), cA, 1, 0);
    if (wr == 1) G8_BAR;
    G8_WAIT_V(4); G8_BAR;
    G8_STAGE_B(G8_SB(1, 0), cB + kstep); G8_STAGE_A(G8_SA(1, 0), cA, 0, kstep); G8_STAGE_B(G8_SB(1, 1), cB + hstepB + kstep);
    G8_WAIT_V(6); G8_BAR;
    for (int ui = 0;; ++ui) {
        const int nxt = unit_of(ui + 1);
        const bool has_next = nxt >= 0;
        const char* nB = cB;
        if (has_next) { nA = aoff_of(nxt); nB = (const char*)bbase_of(nxt); } else nA = cA;
        for (int t = 0; t < nt; t += 2) {
            const bool last = (t == nt - 2);
            const size_t k1 = (size_t)(t + 1) * kstep;
            AOff a2;
#pragma unroll
            for (int hh = 0; hh < 2; ++hh)
#pragma unroll
                for (int i = 0; i < 2; ++i) a2.o[hh][i] = last ? nA.o[hh][i] : cA.o[hh][i];
            const size_t k2 = last ? 0 : (size_t)(t + 2) * kstep, k3 = k2 + kstep;
            const char* b2 = last ? nB : cB + (size_t)(t + 2) * kstep;
            const char* b3 = b2 + kstep;
            G8_LDB(B0, 0, 0); G8_SCHED; G8_LDA(At, 0, 0); G8_STAGE_A(G8_SA(1, 1), cA, 1, k1);
            G8_WAIT_L(8); G8_BAR; G8_WAIT_L(0); G8_MMA(0, 0, At, B0); G8_BAR; G8_SCHED;
            G8_LDB(B1, 0, 1); G8_STAGE_B(G8_SB(0, 0), b2);
            G8_BAR; G8_WAIT_L(0); G8_MMA(0, 1, At, B1); G8_BAR;
            G8_LDA(At, 0, 1); G8_STAGE_A(G8_SA(0, 0), a2, 0, k2);
            G8_BAR; G8_WAIT_L(0); G8_MMA(1, 0, At, B0); G8_BAR; G8_SCHED;
            G8_STAGE_B(G8_SB(0, 1), b2 + hstepB);
            G8_WAIT_V(6); G8_BAR; G8_MMA(1, 1, At, B1); G8_BAR;
            G8_LDB(B0, 1, 0); G8_SCHED; G8_LDA(At, 1, 0); G8_STAGE_A(G8_SA(0, 1), a2, 1, k2);
            G8_WAIT_L(8); G8_BAR; G8_WAIT_L(0); G8_MMA(0, 0, At, B0); G8_BAR; G8_SCHED;
            G8_LDB(B1, 1, 1); G8_STAGE_B(G8_SB(1, 0), b3);
            G8_BAR; G8_WAIT_L(0); G8_MMA(0, 1, At, B1); G8_BAR;
            G8_LDA(At, 1, 1); G8_STAGE_A(G8_SA(1, 0), a2, 0, k3);
            G8_BAR; G8_WAIT_L(0); G8_MMA(1, 0, At, B0); G8_BAR; G8_SCHED;
            G8_STAGE_B(G8_SB(1, 1), b3 + hstepB);
            G8_WAIT_V(6); G8_BAR; G8_MMA(1, 1, At, B1); G8_BAR;
        }
        epi(cur, acc, wr, wc, fr, fq);
        if (!has_next) break;
#pragma unroll
        for (int a = 0; a < 2; ++a)
#pragma unroll
            for (int b = 0; b < 2; ++b)
#pragma unroll
                for (int m = 0; m < 4; ++m)
#pragma unroll
                    for (int n = 0; n < 2; ++n) acc[a][b][m][n] = (f32x4){0.f, 0.f, 0.f, 0.f};
        cur = nxt; cA = nA; cB = nB;
    }
    G8_WAIT_V(0);
    if (wr == 0) G8_BAR;
    G8_BAR;
#undef G8_SA
#undef G8_SB
#undef G8_STAGE_A
#undef G8_STAGE_B
#undef G8_LDA
#undef G8_LDB
#undef G8_MMA
#undef G8_WAIT_V
#undef G8_WAIT_L
#undef G8_BAR
#undef G8_SCHED
}
typedef f32x4 Acc8[2][2][4][2];
__device__ __forceinline__ void phase_pp(const P& p, char* lds) {
    gemm8_units<true>(RoundUnits{2 * 64 * 4}, 256, lds, p.pb,
        [&](int t) { const int l = t >> 8, mt = (t & 255) >> 2; return g8_dense_a(l * T_ + mt * 256, 256); },
        [&](int t) { const int l = t >> 8, nt = t & 3; return p.wb_p + ((size_t)l * 1024 + nt * 256) * 256; },
        [&](int t, Acc8& acc, int wr, int wc, int fr, int fq) {
            const int l = t >> 8, mt = (t & 255) >> 2, nt = t & 3;
            float* O = p.pp + (size_t)l * T_ * DM;
#pragma unroll
            for (int ai = 0; ai < 2; ++ai)
#pragma unroll
                for (int m = 0; m < 4; ++m)
#pragma unroll
                    for (int bj = 0; bj < 2; ++bj)
#pragma unroll
                        for (int n = 0; n < 2; ++n) {
                            const int tok = mt * 256 + 128 * ai + 64 * wr + 16 * m + fr, col = nt * 256 + 64 * wc + 32 * bj + 16 * n + 4 * fq;
                            *(f32x4*)(O + (size_t)tok * DM + col) = acc[ai][bj][m][n];
                        }
        });
}

template <bool ROPE>
__device__ __forceinline__ void epi_rows(const P& p, bf16_t* dst, int stride, Acc8& acc, int tok0, int wr, int fr, int fq, float scale) {
#pragma unroll
    for (int ai = 0; ai < 2; ++ai)
#pragma unroll
        for (int m = 0; m < 4; ++m) {
            const int tok = tok0 + 128 * ai + 64 * wr + 16 * m + fr;
            if (ROPE) {
#pragma unroll
                for (int n = 0; n < 2; ++n) {
                    const float* rt = p.rope + ((size_t)tok * 32 + n * 16 + 4 * fq) * 2;
                    const f32x4 cs0 = *(const f32x4*)rt, cs1 = *(const f32x4*)(rt + 4);
                    const float c[4] = {cs0[0], cs0[2], cs1[0], cs1[2]}, sn[4] = {cs0[1], cs0[3], cs1[1], cs1[3]};
#pragma unroll
                    for (int j = 0; j < 4; ++j) {
                        const float x1 = acc[ai][0][m][n][j], x2 = acc[ai][1][m][n][j];
                        acc[ai][0][m][n][j] = x1 * c[j] - x2 * sn[j];
                        acc[ai][1][m][n][j] = x2 * c[j] + x1 * sn[j];
                    }
                }
            }
#pragma unroll
            for (int bj = 0; bj < 2; ++bj)
#pragma unroll
                for (int n = 0; n < 2; ++n) {
                    const f32x4 v = acc[ai][bj][m][n] * scale;
                    *(uint2*)(dst + (size_t)tok * stride + 32 * bj + 16 * n + 4 * fq) = make_uint2(pack2(v[0], v[1]), pack2(v[2], v[3]));
                }
            __builtin_amdgcn_sched_barrier(0);
        }
}
template <bool KSUM>
__device__ __forceinline__ void epi_key(const P& p, bf16_t* dst, Acc8& acc, int tok0, int wr, int fr, int fq, unsigned* kmax2, float* ks) {
    f32x4 sum[2][2];
#pragma unroll
    for (int bj = 0; bj < 2; ++bj)
#pragma unroll
        for (int n = 0; n < 2; ++n) sum[bj][n] = (f32x4){0.f, 0.f, 0.f, 0.f};
    float mx = 0.f;
#pragma unroll
    for (int ai = 0; ai < 2; ++ai)
#pragma unroll
        for (int m = 0; m < 4; ++m) {
            const int tok = tok0 + 128 * ai + 64 * wr + 16 * m + fr;
#pragma unroll
            for (int n = 0; n < 2; ++n) {
                const float* rt = p.rope + ((size_t)tok * 32 + n * 16 + 4 * fq) * 2;
                const f32x4 cs0 = *(const f32x4*)rt, cs1 = *(const f32x4*)(rt + 4);
                const float c[4] = {cs0[0], cs0[2], cs1[0], cs1[2]}, sn[4] = {cs0[1], cs0[3], cs1[1], cs1[3]};
#pragma unroll
                for (int j = 0; j < 4; ++j) {
                    const float x1 = acc[ai][0][m][n][j], x2 = acc[ai][1][m][n][j];
                    acc[ai][0][m][n][j] = x1 * c[j] - x2 * sn[j];
                    acc[ai][1][m][n][j] = x2 * c[j] + x1 * sn[j];
                }
            }
            float ss = 0.f;
#pragma unroll
            for (int bj = 0; bj < 2; ++bj)
#pragma unroll
                for (int n = 0; n < 2; ++n) {
                    const f32x4 a = acc[ai][bj][m][n];
                    const unsigned w0 = pack2(a[0], a[1]), w1 = pack2(a[2], a[3]);
                    *(uint2*)(dst + (size_t)tok * 64 + 32 * bj + 16 * n + 4 * fq) = make_uint2(w0, w1);
                    const float e0 = __uint_as_float(w0 << 16), e1 = __uint_as_float(w0 & 0xffff0000u), e2 = __uint_as_float(w1 << 16), e3 = __uint_as_float(w1 & 0xffff0000u);
                    ss += (e0 * e0 + e1 * e1) + (e2 * e2 + e3 * e3);
                    if (KSUM) sum[bj][n] = sum[bj][n] + a;
                }
            ss += __shfl_xor(ss, 16);
            ss += __shfl_xor(ss, 32);
            mx = fmaxf(mx, ss);
            __builtin_amdgcn_sched_barrier(0);
        }
#pragma unroll
    for (int o = 8; o > 0; o >>= 1) mx = fmaxf(mx, __shfl_xor(mx, o));
    if ((otid() & 63) == 0) atomicMax(kmax2, __float_as_uint(mx));
    if (KSUM) {
#pragma unroll
        for (int bj = 0; bj < 2; ++bj)
#pragma unroll
            for (int n = 0; n < 2; ++n) {
                f32x4 sv = sum[bj][n];
#pragma unroll
                for (int o = 1; o < 16; o <<= 1) { sv[0] += __shfl_xor(sv[0], o); sv[1] += __shfl_xor(sv[1], o); sv[2] += __shfl_xor(sv[2], o); sv[3] += __shfl_xor(sv[3], o); }
                if (fr == 0) {
#pragma unroll
                    for (int j = 0; j < 4; ++j) atomicAdd(ks + 32 * bj + 16 * n + 4 * fq + j, sv[j]);
                }
            }
    }
}
__device__ __forceinline__ void epi_vT(bf16_t* dst  , Acc8& acc, int tok0, int wr, int fr, int fq) {
#pragma unroll
    for (int ai = 0; ai < 2; ++ai)
#pragma unroll
        for (int m = 0; m < 4; ++m)
#pragma unroll
            for (int bj = 0; bj < 2; ++bj)
#pragma unroll
                for (int n = 0; n < 2; ++n) {
                    const f32x4 v = acc[ai][bj][m][n];
                    *(uint2*)(dst + (size_t)(32 * bj + 16 * n + fr) * T_ + tok0 + 128 * ai + 64 * wr + 16 * m + 4 * fq) = make_uint2(pack2(v[0], v[1]), pack2(v[2], v[3]));
                }
}

template <bool TR, class NtFn, class EpiFn>
__device__ __forceinline__ void typed_loop(const P& p, char* lds, const bf16_t* W, int& base, int count, NtFn ntile_of, EpiFn epi) {
    const int G = gridDim.x, bidx = blockIdx.x, b0 = base;
    const int l = (((bidx - b0) % G) + G) % G;
    const int ul = l < count ? xcd_remap(l, count) : -1;
    gemm8_units<TR>([&](int k) { return (k == 0 && ul >= 0) ? ul : -1; }, DM, lds, p.xb,
        [&](int t) { int mt, nt; ntile_of(t, mt, nt); return g8_dense_a(mt * 256, DM); },
        [&](int t) { int mt, nt; ntile_of(t, mt, nt); return W + (size_t)nt * 256 * DM; },
        [&](int t, Acc8& acc, int wr, int wc, int fr, int fq) { int mt, nt; ntile_of(t, mt, nt); epi(acc, mt, nt, mt * 256, wr, wc, fr, fq); });
    base += count;
}

template <int LAYER>
__device__ __forceinline__ void phase_inproj(const P& p, char* lds) {
    int base = 0;
    if (LAYER == 0) {
        const bf16_t* W = p.wb_ab_in;
        typed_loop<true>(p, lds, W, base, 128, [](int i, int& mt, int& nt) { mt = i >> 1; nt = i & 1; },
            [&](Acc8& acc, int mt, int nt, int tok0, int wr, int wc, int fr, int fq) {
                epi_rows<false>(p, p.q16 + (size_t)(nt * 4 + wc) * T_ * 64, 64, acc, tok0, wr, fr, fq, 0.125f); });
        typed_loop<true>(p, lds, W, base, 128, [](int i, int& mt, int& nt) { mt = i >> 1; nt = 2 + (i & 1); },
            [&](Acc8& acc, int mt, int nt, int tok0, int wr, int wc, int fr, int fq) {
                epi_rows<false>(p, p.k16 + (size_t)((nt - 2) * 4 + wc) * T_ * 64, 64, acc, tok0, wr, fr, fq, 1.0f); });
        typed_loop<false>(p, lds, W, base, 256, [](int i, int& mt, int& nt) { mt = i >> 2; const int vi = i & 3; nt = (vi < 2 ? 4 : 8) + vi; },
            [&](Acc8& acc, int mt, int nt, int tok0, int wr, int wc, int fr, int fq) {
                const int head = (nt < 6 ? 0 : 8) + (nt & 1) * 4 + wc;
                epi_vT(p.vT16 + (size_t)head * 64 * T_, acc, tok0, wr, fr, fq); });
        typed_loop<true>(p, lds, W, base, 128, [](int i, int& mt, int& nt) { mt = i >> 1; nt = 6 + (i & 1); },
            [&](Acc8& acc, int mt, int nt, int tok0, int wr, int wc, int fr, int fq) {
                epi_rows<true>(p, p.q16 + (size_t)(8 + (nt - 6) * 4 + wc) * T_ * 64, 64, acc, tok0, wr, fr, fq, 0.125f * LOG2E); });
        typed_loop<true>(p, lds, W, base, 128, [](int i, int& mt, int& nt) { mt = i >> 1; nt = 8 + (i & 1); },
            [&](Acc8& acc, int mt, int nt, int tok0, int wr, int wc, int fr, int fq) {
                const int hd = (nt - 8) * 4 + wc;
                epi_key<true>(p, p.k16 + (size_t)(8 + hd) * T_ * 64, acc, tok0, wr, fr, fq, p.kmax2 + 8 + hd, p.ksum + ((size_t)hd * 64 + mt) * 64); });
    } else {
        const bf16_t* W = p.wb_c_in;
        typed_loop<true>(p, lds, W, base, 256, [](int i, int& mt, int& nt) { mt = i >> 2; nt = i & 3; },
            [&](Acc8& acc, int mt, int nt, int tok0, int wr, int wc, int fr, int fq) {
                epi_rows<true>(p, p.q16 + (size_t)(nt * 4 + wc) * T_ * 64, 64, acc, tok0, wr, fr, fq, 0.125f * LOG2E); });
        typed_loop<true>(p, lds, W, base, 256, [](int i, int& mt, int& nt) { mt = i >> 2; nt = 4 + (i & 3); },
            [&](Acc8& acc, int mt, int nt, int tok0, int wr, int wc, int fr, int fq) {
                const int hd = (nt - 4) * 4 + wc;
                epi_key<false>(p, p.k16 + (size_t)hd * T_ * 64, acc, tok0, wr, fr, fq, p.kmax2 + 16 + hd, nullptr); });
        typed_loop<false>(p, lds, W, base, 256, [](int i, int& mt, int& nt) { mt = i >> 2; nt = 8 + (i & 3); },
            [&](Acc8& acc, int mt, int nt, int tok0, int wr, int wc, int fr, int fq) {
                epi_vT(p.vT16 + (size_t)((nt - 8) * 4 + wc) * 64 * T_, acc, tok0, wr, fr, fq); });
        typed_loop<true>(p, lds, W, base, 128, [](int i, int& mt, int& nt) { mt = i >> 1; nt = 12 + (i & 1); },
            [&](Acc8& acc, int mt, int nt, int tok0, int wr, int wc, int fr, int fq) {
                const int hd = (nt - 12) * 4 + wc;
                epi_rows<true>(p, p.qi + (size_t)hd * 64, 512, acc, tok0, wr, fr, fq, 0.125f); });
        typed_loop<true>(p, lds, W, base, 64, [](int i, int& mt, int& nt) { mt = i; nt = 14; },
            [&](Acc8& acc, int mt, int nt, int tok0, int wr, int wc, int fr, int fq) {
                if (wc == 0) {
                    epi_rows<true>(p, p.ki, 64, acc, tok0, wr, fr, fq, 1.0f);
                } else if (wc == 1 && fq < 2) {
#pragma unroll
                    for (int ai = 0; ai < 2; ++ai)
#pragma unroll
                        for (int m = 0; m < 4; ++m)
                            *(f32x4*)(p.wi + (size_t)(tok0 + 128 * ai + 64 * wr + 16 * m + fr) * 8 + 4 * fq) = acc[ai][0][m][0] * 0.35355339059327373f;
                } });
    }
}
__device__ __forceinline__ void phase_outproj(const P& p, const bf16_t* W, const float* xres, char* lds) {
    gemm8_units<true>(RoundUnits{64 * 4}, DM, lds, p.o,
        [&](int t) { return g8_dense_a((t >> 2) * 256, DM); },
        [&](int t) { return W + (size_t)(t & 3) * 256 * DM; },
        [&](int t, Acc8& acc, int wr, int wc, int fr, int fq) {
            const int mt = t >> 2, nt = t & 3;
#pragma unroll
            for (int ai = 0; ai < 2; ++ai)
#pragma unroll
                for (int m = 0; m < 4; ++m)
#pragma unroll
                    for (int bj = 0; bj < 2; ++bj)
#pragma unroll
                        for (int n = 0; n < 2; ++n) {
                            const size_t off = (size_t)(mt * 256 + 128 * ai + 64 * wr + 16 * m + fr) * DM + nt * 256 + 64 * wc + 32 * bj + 16 * n + 4 * fq;
                            const f32x4 xr = *(const f32x4*)(xres + off);
                            *(f32x4*)(p.ypre + off) = xr * DN_ALPHA + acc[ai][bj][m][n];
                        }
        });
}

__device__ __forceinline__ void ln_row(f32x4 (&v)[4], const float* g, const float* b, int lane) {
    float s = 0.f;
#pragma unroll
    for (int c = 0; c < 4; ++c) s += (v[c][0] + v[c][1]) + (v[c][2] + v[c][3]);
    const float mu = wave_sum(s) * (1.0f / DM);
    float q = 0.f;
#pragma unroll
    for (int c = 0; c < 4; ++c) {
        v[c] = v[c] - mu;
        q += (v[c][0] * v[c][0] + v[c][1] * v[c][1]) + (v[c][2] * v[c][2] + v[c][3] * v[c][3]);
    }
    const float rstd = 1.0f / sqrtf(wave_sum(q) * (1.0f / DM) + 1e-5f);
#pragma unroll
    for (int c = 0; c < 4; ++c) {
        const f32x4 gg = *(const f32x4*)(g + 4 * lane + 256 * c), bb = *(const f32x4*)(b + 4 * lane + 256 * c);
        v[c] = v[c] * rstd * gg + bb;
    }
}

#define RT_XS_STRIDE 1025
#define RT_RED_OFF (32 * RT_XS_STRIDE * 4)
#define RT_DEC_OFF (RT_RED_OFF + 16384)
__device__ __forceinline__ void phase_ln_router(const P& p, int layer, char* lds) {
    const int tid = otid(), lane = tid & 63, wid = tid >> 6;
    float* xs = (float*)lds;
    float* red = (float*)(lds + RT_RED_OFF);
    int* dec = (int*)(lds + RT_DEC_OFF);
    float* decg = (float*)(lds + RT_DEC_OFF + 1024);
    int* lcnt = (int*)(lds + RT_DEC_OFF + 2048);
    int* gbase = lcnt + 32;
    const float* g = p.ln_g + (size_t)(layer * 2 + 0) * DM;
    const float* b = p.ln_b + (size_t)(layer * 2 + 0) * DM;
    const float* wr_ = p.router_w + (size_t)layer * DM * NEXP;
    const float* br_ = p.router_b + layer * NEXP;
    int* cnt = p.cnt + layer * NEXP;
#pragma unroll 1
    for (int itb = 0; (blockIdx.x + itb * gridDim.x) * 32 < T_; itb += 2) {
    __syncthreads();
    if (tid < 32) lcnt[tid] = 0;
#pragma unroll 1
    for (int it = 0; it < 2; ++it) {
        const int t0 = (blockIdx.x + (itb + it) * gridDim.x) * 32;
        if (t0 >= T_) break;
#pragma unroll 1
        for (int r = 0; r < 4; ++r) {
            const int tl_ = wid * 4 + r, tok = t0 + tl_;
            f32x4 v[4];
#pragma unroll
            for (int c = 0; c < 4; ++c) v[c] = *(const f32x4*)(p.ypre + (size_t)tok * DM + 4 * lane + 256 * c);
            ln_row(v, g, b, lane);
#pragma unroll
            for (int c = 0; c < 4; ++c) {
                *(f32x4*)(p.x1 + (size_t)tok * DM + 4 * lane + 256 * c) = v[c];
                *(uint2*)(p.x1b + (size_t)tok * DM + 4 * lane + 256 * c) = make_uint2(pack2(v[c][0], v[c][1]), pack2(v[c][2], v[c][3]));
                float* xr = xs + tl_ * RT_XS_STRIDE + 4 * lane + 256 * c;
                xr[0] = v[c][0]; xr[1] = v[c][1]; xr[2] = v[c][2]; xr[3] = v[c][3];
            }
        }
        __syncthreads();
        f32x16 d;
#pragma unroll
        for (int i = 0; i < 16; ++i) d[i] = 0.f;
        {
            const int i_ = lane & 31, kk = lane >> 5;
            const float* xa = xs + i_ * RT_XS_STRIDE + wid * 128 + kk;
            const float* wb = wr_ + (size_t)(wid * 128 + kk) * NEXP + i_;
#pragma unroll 8
            for (int s = 0; s < 64; ++s) d = __builtin_amdgcn_mfma_f32_32x32x2f32(xa[2 * s], wb[(size_t)(2 * s) * NEXP], d, 0, 0, 0);
        }
#pragma unroll
        for (int step = 4; step >= 1; step >>= 1) {
            if (wid >= step && wid < 2 * step) {
                float* rb = red + (wid - step) * 1024;
#pragma unroll
                for (int i = 0; i < 16; ++i) rb[i * 64 + lane] = d[i];
            }
            __syncthreads();
            if (wid < step) {
                const float* rb = red + wid * 1024;
#pragma unroll
                for (int i = 0; i < 16; ++i) d[i] += rb[i * 64 + lane];
            }
            __syncthreads();
        }
        if (wid == 0) {
#pragma unroll
            for (int i = 0; i < 16; ++i) red[((i & 3) + 8 * (i >> 2) + 4 * (lane >> 5)) * 32 + (lane & 31)] = d[i];
        }
        __syncthreads();
#pragma unroll
        for (int r = 0; r < 2; ++r) {
            const int e = lane & 31, hf = lane >> 5, tl_ = wid * 4 + 2 * r + hf;
            float cur = red[tl_ * 32 + e] + br_[e];
            float tv[4]; int ti[4];
#pragma unroll
            for (int k = 0; k < 4; ++k) {
                float mv = cur;
#pragma unroll
                for (int o = 16; o > 0; o >>= 1) mv = fmaxf(mv, __shfl_xor(mv, o));
                const unsigned long long bal = __ballot(cur == mv);
                const unsigned bh = hf ? (unsigned)(bal >> 32) : (unsigned)bal;
                const int idx = __ffs(bh) - 1;
                tv[k] = mv; ti[k] = idx;
                if (e == idx) cur = -3.0e38f;
            }
            const float e1 = __expf(tv[1] - tv[0]), e2 = __expf(tv[2] - tv[0]), e3 = __expf(tv[3] - tv[0]);
            const float inv = 1.0f / (1.0f + e1 + e2 + e3);
            if (e < 4) {
                const int ee = e == 0 ? ti[0] : e == 1 ? ti[1] : e == 2 ? ti[2] : ti[3];
                const float gg = e == 0 ? inv : e == 1 ? e1 * inv : e == 2 ? e2 * inv : e3 * inv;
                const int lpos = atomicAdd(lcnt + ee, 1);
                dec[(it * 32 + tl_) * 4 + e] = ee | (lpos << 8);
                decg[(it * 32 + tl_) * 4 + e] = gg;
            }
        }
        __syncthreads();
    }
    if (tid < 32) gbase[tid] = lcnt[tid] > 0 ? atomicAdd(cnt + tid, lcnt[tid]) : 0;
    __syncthreads();
    if (tid < 256) {
        const int it = tid >> 7, t0 = (blockIdx.x + (itb + it) * gridDim.x) * 32;
        if (t0 < T_) {
            const int tok = t0 + ((tid >> 2) & 31), k = tid & 3;
            const int dv = dec[tid], ee = dv & 255, pos = gbase[ee] + (dv >> 8);
            p.tok_of[(size_t)ee * T_ + pos] = tok;
            p.sel_e[tok * 4 + k] = ee;
            p.sel_pos[tok * 4 + k] = pos;
            p.sel_g[tok * 4 + k] = decg[tid];
        }
    }
    }
    __syncthreads();
}

__device__ __forceinline__ void moe_prefix(const int* cnt, int* mpre) {
    if (otid() == 0) {
        int s = 0;
        for (int e = 0; e < NEXP; ++e) { mpre[e] = s; s += (cnt[e] + 255) >> 8; }
        mpre[NEXP] = s;
    }
    __syncthreads();
}
#define MPRE_OFF G_LDS_B

__device__ __forceinline__ void phase_moe1(const P& p, int layer, char* lds) {
    int* mpre = (int*)(lds + MPRE_OFF);
    const int* cnt = p.cnt + layer * NEXP;
    moe_prefix(cnt, mpre);
    const int total = mpre[NEXP] * 8;
    auto expert_of = [&](int mg) { int e = 0;
#pragma unroll 1
        while (mpre[e + 1] <= mg) ++e;
        return e; };
    gemm8_units<true>(RoundUnits{total}, DM, lds, p.x1b,
        [&](int t) {
            const int mg = t >> 3, e = expert_of(mg), i = mg - mpre[e], ce_ = cnt[e];
            const int* tk = p.tok_of + (size_t)e * T_;
            AOff a; int R, C;
#pragma unroll
            for (int ii = 0; ii < 2; ++ii) {
                g8_rc(ii, R, C);
                const int p0 = i * 256 + R, p1 = p0 + 128;
                a.o[0][ii] = (unsigned)(((size_t)tk[p0 < ce_ ? p0 : 0] * DM + C) * 2);
                a.o[1][ii] = (unsigned)(((size_t)tk[p1 < ce_ ? p1 : 0] * DM + C) * 2);
            }
            return a;
        },
        [&](int t) { const int mg = t >> 3, nt = t & 7, e = expert_of(mg); return p.wb_w1 + ((size_t)(layer * NEXP + e) * 2048 + nt * 256) * DM; },
        [&](int t, Acc8& acc, int wr, int wc, int fr, int fq) {
            const int mg = t >> 3, nt = t & 7, e = expert_of(mg);
            const float* b1 = p.moe_b1 + (size_t)(layer * NEXP + e) * 2048;
#pragma unroll
            for (int n = 0; n < 2; ++n) {
                const int j0 = nt * 128 + wc * 32 + n * 16 + 4 * fq;
                float bg[4], bu[4];
#pragma unroll
                for (int j = 0; j < 4; ++j) { bg[j] = b1[2 * (j0 + j)]; bu[j] = b1[2 * (j0 + j) + 1]; }
#pragma unroll
                for (int ai = 0; ai < 2; ++ai)
#pragma unroll
                    for (int m = 0; m < 4; ++m) {
                        float r[4];
#pragma unroll
                        for (int j = 0; j < 4; ++j) {
                            const float gv = fminf(acc[ai][0][m][n][j] + bg[j], 7.0f);
                            const float uv = fminf(fmaxf(acc[ai][1][m][n][j] + bu[j], -7.0f), 7.0f);
                            const float glu = gv * sigmoidf_(1.702f * gv);
                            r[j] = (uv + 1.0f) * glu;
                        }
                        const size_t slot = (size_t)mg * 256 + 128 * ai + 64 * wr + 16 * m + fr;
                        *(uint2*)(p.act + slot * DM + j0) = make_uint2(pack2(r[0], r[1]), pack2(r[2], r[3]));
                    }
            }
        },
        [&](int t) { const int mg = t >> 3, e = expert_of(mg); return cnt[e] - (mg - mpre[e]) * 256 <= 128; });
}

__device__ __forceinline__ void phase_moe2(const P& p, int layer, char* lds) {
    int* mpre = (int*)(lds + MPRE_OFF);
    const int* cnt = p.cnt + layer * NEXP;
    moe_prefix(cnt, mpre);
    const int total = mpre[NEXP] * 4;
    auto expert_of = [&](int mg) { int e = 0;
#pragma unroll 1
        while (mpre[e + 1] <= mg) ++e;
        return e; };
    gemm8_units<true>(RoundUnits{total}, DM, lds, p.act,
        [&](int t) { return g8_dense_a((t >> 2) * 256, DM); },
        [&](int t) { const int mg = t >> 2, nt = t & 3, e = expert_of(mg); return p.wb_w2 + ((size_t)(layer * NEXP + e) * 1024 + nt * 256) * DM; },
        [&](int t, Acc8& acc, int wr, int wc, int fr, int fq) {
            const int mg = t >> 2, nt = t & 3, e = expert_of(mg);
            const float* b2 = p.moe_b2 + (size_t)(layer * NEXP + e) * DM;
#pragma unroll
            for (int ai = 0; ai < 2; ++ai)
#pragma unroll
                for (int m = 0; m < 4; ++m)
#pragma unroll
                    for (int bj = 0; bj < 2; ++bj)
#pragma unroll
                        for (int n = 0; n < 2; ++n) {
                            const int col = nt * 256 + 64 * wc + 32 * bj + 16 * n + 4 * fq;
                            const f32x4 v = acc[ai][bj][m][n] + *(const f32x4*)(b2 + col);
                            const size_t slot = (size_t)mg * 256 + 128 * ai + 64 * wr + 16 * m + fr;
                            *(uint2*)(p.oslot + slot * DM + col) = make_uint2(pack2(v[0], v[1]), pack2(v[2], v[3]));
                        }
        },
        [&](int t) { const int mg = t >> 2, e = expert_of(mg); return cnt[e] - (mg - mpre[e]) * 256 <= 128; });
}

__device__ __forceinline__ void phase_combine_ln(const P& p, int layer, char* lds) {
    const int tid = otid(), lane = tid & 63, wid = tid >> 6;
    int* mpre = (int*)(lds + MPRE_OFF);
    moe_prefix(p.cnt + layer * NEXP, mpre);
    const float* g = p.ln_g + (size_t)(layer * 2 + 1) * DM;
    const float* b = p.ln_b + (size_t)(layer * 2 + 1) * DM;
#pragma unroll 1
    for (int tok = blockIdx.x * NWAVE + wid; tok < T_; tok += gridDim.x * NWAVE) {
        f32x4 v[4];
#pragma unroll
        for (int c = 0; c < 4; ++c) v[c] = *(const f32x4*)(p.x1 + (size_t)tok * DM + 4 * lane + 256 * c) * DN_ALPHA;
        f32x4 f[4];
#pragma unroll
        for (int c = 0; c < 4; ++c) f[c] = (f32x4){0.f, 0.f, 0.f, 0.f};
#pragma unroll
        for (int k = 0; k < 4; ++k) {
            const int e = p.sel_e[tok * 4 + k], pos = p.sel_pos[tok * 4 + k];
            const float gt = p.sel_g[tok * 4 + k];
            const bf16_t* row = p.oslot + ((size_t)mpre[e] * 256 + pos) * DM;
#pragma unroll
            for (int c = 0; c < 4; ++c) {
                const uint2 w = *(const uint2*)(row + 4 * lane + 256 * c);
                f[c][0] += gt * __uint_as_float(w.x << 16);
                f[c][1] += gt * __uint_as_float(w.x & 0xffff0000u);
                f[c][2] += gt * __uint_as_float(w.y << 16);
                f[c][3] += gt * __uint_as_float(w.y & 0xffff0000u);
            }
        }
#pragma unroll
        for (int c = 0; c < 4; ++c) v[c] = v[c] + f[c];
        ln_row(v, g, b, lane);
#pragma unroll
        for (int c = 0; c < 4; ++c) {
            *(f32x4*)(p.x2 + (size_t)tok * DM + 4 * lane + 256 * c) = v[c];
            *(uint2*)(p.x2b + (size_t)tok * DM + 4 * lane + 256 * c) = make_uint2(pack2(v[c][0], v[c][1]), pack2(v[c][2], v[c][3]));
        }
    }
}

__device__ __forceinline__ void phase_ple(const P& p, int layer, float* xout, char* lds) {
    const float* pp = p.pp + (size_t)layer * T_ * DM;
    gemm8_units<true>(RoundUnits{64 * 4}, DM, lds, p.x2b,
        [&](int t) { return g8_dense_a((t >> 2) * 256, DM); },
        [&](int t) { return p.wb_g + (size_t)layer * DM * DM + (size_t)(t & 3) * 256 * DM; },
        [&](int t, Acc8& acc, int wr, int wc, int fr, int fq) {
            const int mt = t >> 2, nt = t & 3;
#pragma unroll
            for (int ai = 0; ai < 2; ++ai)
#pragma unroll
                for (int m = 0; m < 4; ++m)
#pragma unroll
                    for (int bj = 0; bj < 2; ++bj)
#pragma unroll
                        for (int n = 0; n < 2; ++n) {
                            const size_t off = (size_t)(mt * 256 + 128 * ai + 64 * wr + 16 * m + fr) * DM + nt * 256 + 64 * wc + 32 * bj + 16 * n + 4 * fq;
                            const f32x4 x2v = *(const f32x4*)(p.x2 + off), ppv = *(const f32x4*)(pp + off);
                            f32x4 r;
#pragma unroll
                            for (int j = 0; j < 4; ++j) r[j] = x2v[j] + sigmoidf_(acc[ai][bj][m][n][j]) * ppv[j];
                            *(f32x4*)(xout + off) = r;
                            *(uint2*)(p.xb + off) = make_uint2(pack2(r[0], r[1]), pack2(r[2], r[3]));
                        }
        });
}
#define KROW 144
#define VROW 136
#define KTILE_B (64 * KROW)
#define VTILE_B (64 * VROW)
#define ABUF_B (KTILE_B + VTILE_B)

struct TileRegs { u32x4 k0, v0; };

__device__ __forceinline__ void tile_gload(TileRegs& r, const bf16_t* kbase  , const bf16_t* vtbase  , int k0) {
    const int ci = otid(), row = ci >> 3, cc = ci & 7;
    r.k0 = *(const u32x4*)(kbase + (size_t)(k0 + row) * 64 + cc * 8);
    r.v0 = *(const u32x4*)(vtbase + (size_t)row * T_ + k0 + cc * 8);
}
__device__ __forceinline__ void tile_swrite(const TileRegs& r, char* buf) {
    const int ci = otid(), row = ci >> 3, cc = ci & 7;
    *(u32x4*)(buf + row * KROW + cc * 16) = r.k0;
    *(uint2*)(buf + KTILE_B + row * VROW + cc * 16) = make_uint2(r.v0[0], r.v0[1]);
    *(uint2*)(buf + KTILE_B + row * VROW + cc * 16 + 8) = make_uint2(r.v0[2], r.v0[3]);
}

__device__ __forceinline__ void load_qfrag(bf16x8 (&qf)[4], const bf16_t* qrow  , int h) {
#pragma unroll
    for (int kk = 0; kk < 4; ++kk) qf[kk] = *(const bf16x8*)(qrow + 16 * kk + 8 * h);
}
__device__ __forceinline__ float qnorm2(const bf16x8 (&qf)[4]) {
    float s = 0.f;
#pragma unroll
    for (int kk = 0; kk < 4; ++kk)
#pragma unroll
        for (int j = 0; j < 8; ++j) { const float e = bf2f((bf16_t)qf[kk][j]); s += e * e; }
    return s + __shfl_xor(s, 32);
}

__device__ __forceinline__ f32x16 qk_subtile(const char* kbuf, int t2, const bf16x8 (&qf)[4], int c, int h) {
    f32x16 s;
#pragma unroll
    for (int i = 0; i < 16; ++i) s[i] = 0.f;
#pragma unroll
    for (int kk = 0; kk < 4; ++kk) {
        const bf16x8 kf = *(const bf16x8*)(kbuf + (32 * t2 + c) * KROW + (16 * kk + 8 * h) * 2);
        s = __builtin_amdgcn_mfma_f32_32x32x16_bf16(kf, qf[kk], s, 0, 0, 0);
    }
    return s;
}

__device__ __forceinline__ void pv_subtile(const char* vbuf, int t2, const float (&pr)[16], f32x16 (&o)[2], int c, int h) {
#pragma unroll
    for (int s = 0; s < 2; ++s) {
        u32x4 pbu;
#pragma unroll
        for (int j = 0; j < 4; ++j) pbu[j] = pack2(pr[8 * s + 2 * j], pr[8 * s + 2 * j + 1]);
        const bf16x8 pbv = __builtin_bit_cast(bf16x8, pbu);
#pragma unroll
        for (int dt = 0; dt < 2; ++dt) {
            const char* a = vbuf + (32 * dt + c) * VROW + (32 * t2 + 16 * s + 4 * h) * 2;
            const uint2 lo = *(const uint2*)a, hi = *(const uint2*)(a + 16);
            const u32x4 vfu = {lo.x, lo.y, hi.x, hi.y};
            o[dt] = __builtin_amdgcn_mfma_f32_32x32x16_bf16(__builtin_bit_cast(bf16x8, vfu), pbv, o[dt], 0, 0, 0);
        }
    }
}

__device__ __forceinline__ void store_o(bf16_t* orow  , const f32x16 (&o)[2], int h, float scale) {
#pragma unroll
    for (int dt = 0; dt < 2; ++dt)
#pragma unroll
        for (int g = 0; g < 4; ++g) {
            const int d = 32 * dt + 8 * g + 4 * h;
            *(uint2*)(orow + d) = make_uint2(pack2(o[dt][4 * g] * scale, o[dt][4 * g + 1] * scale), pack2(o[dt][4 * g + 2] * scale, o[dt][4 * g + 3] * scale));
        }
}

#define SB_STOP 32.0f
__device__ __forceinline__ void phase_sb(const P& p, char* lds) {
    const int tid = otid(), lane = tid & 63, w = tid >> 6, c = lane & 31, h = lane >> 5;
#pragma unroll 1
    for (int t = blockIdx.x; t < 8 * 64; t += gridDim.x) {
        const int head = t & 7, qb = 63 - (t >> 3);
        const int q0 = qb * 256, qw = q0 + 32 * w, query = qw + c;
        const bf16_t* kbase = p.k16 + (size_t)head * T_ * 64;
        const bf16_t* vtbase = p.vT16 + (size_t)head * 64 * T_;
        bf16x8 qf[4];
        load_qfrag(qf, p.q16 + ((size_t)head * T_ + query) * 64, h);
        f32x16 o[2];
#pragma unroll
        for (int i = 0; i < 16; ++i) { o[0][i] = 0.f; o[1][i] = 0.f; }
        float R = 0.f;
        int kt = (q0 + 255) >> 6;
        TileRegs tr;
        tile_gload(tr, kbase, vtbase, kt * 64);
        __syncthreads();
        tile_swrite(tr, lds);
        __syncthreads();
        int buf = 0;
#pragma unroll 1
        for (;;) {
            const bool more = kt > 0;
            if (more) tile_gload(tr, kbase, vtbase, (kt - 1) * 64);
            const char* kb = lds + buf * ABUF_B;
            const char* vb = kb + KTILE_B;
            const int k0 = kt * 64;
#pragma unroll
            for (int t2 = 1; t2 >= 0; --t2) {
                const int keybase = k0 + 32 * t2;
                if (keybase < qw + 31) {
                    const f32x16 s = qk_subtile(kb, t2, qf, c, h);
                    const bool need_mask = keybase + 31 >= qw;
                    float L[16], E[16];
#pragma unroll
                    for (int r = 0; r < 16; ++r) {
                        const float z2 = s[r] * LOG2E;
                        const int zb = __float_as_int(z2);
                        float l = __int_as_float(zb > 0 ? zb : 0) + flog2(1.0f + fexp2(-fabsf(z2)));
                        const int key = keybase + (r & 3) + 8 * (r >> 2) + 4 * h;
                        const bool valid = !need_mask || key < query;
                        l = valid ? l : 0.f;
                        L[r] = l;
                        E[r] = valid ? (z2 - l) : -1.0e30f;
                    }
                    float gs[4], tot[4], ps[4];
#pragma unroll
                    for (int g = 0; g < 4; ++g) {
                        gs[g] = (L[4 * g] + L[4 * g + 1]) + (L[4 * g + 2] + L[4 * g + 3]);
                        ps[g] = __shfl_xor(gs[g], 32);
                        tot[g] = gs[g] + ps[g];
                    }
                    float above[4];
                    above[3] = (h == 0 ? ps[3] : 0.f);
                    above[2] = tot[3] + (h == 0 ? ps[2] : 0.f);
                    above[1] = tot[3] + tot[2] + (h == 0 ? ps[1] : 0.f);
                    above[0] = tot[3] + tot[2] + tot[1] + (h == 0 ? ps[0] : 0.f);
                    float pr[16];
#pragma unroll
                    for (int g = 0; g < 4; ++g) {
                        float run = R + above[g];
#pragma unroll
                        for (int i = 3; i >= 0; --i) {
                            pr[4 * g + i] = fexp2(E[4 * g + i] - run);
                            run += L[4 * g + i];
                        }
                    }
                    R += (tot[0] + tot[1]) + (tot[2] + tot[3]);
                    pv_subtile(vb, t2, pr, o, c, h);
                }
            }
            const int done = __syncthreads_and(R > SB_STOP);
            if (!more || done) break;
            tile_swrite(tr, lds + (buf ^ 1) * ABUF_B);
            __syncthreads();
            buf ^= 1;
            --kt;
        }
        store_o(p.o + (size_t)query * DM + head * 64, o, h, 1.0f);
    }
}

__device__ __forceinline__ void softmax_subtile(const f32x16& s, unsigned W, float M2, float& l, f32x16 (&o)[2], const char* vb, int t2, int c, int h) {
    const unsigned Wh = W >> (4 * h);
    float pr[16];
    float ls = 0.f;
#pragma unroll
    for (int r = 0; r < 16; ++r) {
        const bool ok = (Wh >> ((r & 3) + 8 * (r >> 2))) & 1u;
        const float pv = ok ? fexp2(s[r] * LOG2E - M2) : 0.f;
        pr[r] = pv;
        ls += pv;
    }
    l += ls;
    pv_subtile(vb, t2, pr, o, c, h);
}

__device__ __forceinline__ unsigned causal_word(int query, int keybase) {
    const int nk = query - keybase + 1;
    return nk >= 32 ? 0xffffffffu : (nk <= 0 ? 0u : ((1u << nk) - 1u));
}
__device__ __forceinline__ float shift_bound_l2(float qn2, unsigned kmax2_bits) {
    return fminf(sqrtf(qn2 * __uint_as_float(kmax2_bits)) * 1.002f, 64.0f);
}
__device__ __forceinline__ float shift_bound(float qn2, unsigned kmax2_bits) {
    const float b = sqrtf(qn2 * __uint_as_float(kmax2_bits)) * (LOG2E * 1.002f);
    return fminf(b, 64.0f);
}

__device__ __forceinline__ void attn_tile64(const char* kb, const char* vb, const bf16x8 (&qf)[4], unsigned W0, unsigned W1, float M2, float& l, f32x16 (&o)[2], int c, int h) {
    bf16x8 k0[4], k1[4];
#pragma unroll
    for (int kk = 0; kk < 4; ++kk) {
        k0[kk] = *(const bf16x8*)(kb + c * KROW + (16 * kk + 8 * h) * 2);
        k1[kk] = *(const bf16x8*)(kb + (32 + c) * KROW + (16 * kk + 8 * h) * 2);
    }
    const unsigned Wh0 = W0 >> (4 * h), Wh1 = W1 >> (4 * h);
    f32x16 s0, s1;
#pragma unroll
    for (int r = 0; r < 16; ++r) {
        const int bit = (r & 3) + 8 * (r >> 2);
        s0[r] = ((Wh0 >> bit) & 1u) ? -M2 : -1.0e30f;
        s1[r] = ((Wh1 >> bit) & 1u) ? -M2 : -1.0e30f;
    }
#pragma unroll
    for (int kk = 0; kk < 4; ++kk) {
        s0 = __builtin_amdgcn_mfma_f32_32x32x16_bf16(k0[kk], qf[kk], s0, 0, 0, 0);
        s1 = __builtin_amdgcn_mfma_f32_32x32x16_bf16(k1[kk], qf[kk], s1, 0, 0, 0);
    }
    u32x4 vf[2][2][2];
#pragma unroll
    for (int t2 = 0; t2 < 2; ++t2)
#pragma unroll
        for (int sI = 0; sI < 2; ++sI)
#pragma unroll
            for (int dt = 0; dt < 2; ++dt) {
                const char* a = vb + (32 * dt + c) * VROW + (32 * t2 + 16 * sI + 4 * h) * 2;
                const uint2 lo = *(const uint2*)a, hi = *(const uint2*)(a + 16);
                vf[t2][sI][dt] = (u32x4){lo.x, lo.y, hi.x, hi.y};
            }
    u32x4 pb[2][2];
    f32v2_ ls2 = {0.f, 0.f};
#pragma unroll
    for (int sI = 0; sI < 2; ++sI) {
        f32v2_ pa[4], pc[4];
#pragma unroll
        for (int j = 0; j < 4; ++j) {
            const int r = 8 * sI + 2 * j;
            pa[j][0] = fexp2(s0[r]); pa[j][1] = fexp2(s0[r + 1]);
            pc[j][0] = fexp2(s1[r]); pc[j][1] = fexp2(s1[r + 1]);
            ls2 = ls2 + pa[j] + pc[j];
        }
        pb[0][sI] = (u32x4){pack2(pa[0][0], pa[0][1]), pack2(pa[1][0], pa[1][1]), pack2(pa[2][0], pa[2][1]), pack2(pa[3][0], pa[3][1])};
        pb[1][sI] = (u32x4){pack2(pc[0][0], pc[0][1]), pack2(pc[1][0], pc[1][1]), pack2(pc[2][0], pc[2][1]), pack2(pc[3][0], pc[3][1])};
    }
    l += ls2[0] + ls2[1];
#pragma unroll
    for (int t2 = 0; t2 < 2; ++t2)
#pragma unroll
        for (int sI = 0; sI < 2; ++sI)
#pragma unroll
            for (int dt = 0; dt < 2; ++dt)
                o[dt] = __builtin_amdgcn_mfma_f32_32x32x16_bf16(__builtin_bit_cast(bf16x8, vf[t2][sI][dt]), __builtin_bit_cast(bf16x8, pb[t2][sI]), o[dt], 0, 0, 0);
}

__device__ __forceinline__ void phase_moba_gate(const P& p, char* lds) {
    const int tid = otid(), lane = tid & 63, w = tid >> 6, c = lane & 31, h = lane >> 5;
#pragma unroll 1
    for (int t = blockIdx.x; t < 8 * 63; t += gridDim.x) {
        const int head = t & 7, cur = 63 - (t >> 3);
        const int query = cur * 256 + 32 * w + c;
        bf16x8 qf[4];
        load_qfrag(qf, p.q16 + ((size_t)(8 + head) * T_ + query) * 64, h);
        int sel0 = -1, sel1 = -1, sel2 = -1;
        __syncthreads();
        if (tid < 64) ((int*)(lds + 16384))[tid] = 0;
        {
            const int row = tid >> 3, cc = tid & 7;
            const float* ks = p.ksum + ((size_t)head * 64 + row) * 64 + cc * 8;
            const f32x4 a = *(const f32x4*)ks * (1.0f / 256.0f), b = *(const f32x4*)(ks + 4) * (1.0f / 256.0f);
            *(u32x4*)(lds + row * KROW + cc * 16) = (u32x4){pack2(a[0], a[1]), pack2(a[2], a[3]), pack2(b[0], b[1]), pack2(b[2], b[3])};
        }
        __syncthreads();
        float v0 = -3.0e38f, v1 = -3.0e38f, v2 = -3.0e38f;
#pragma unroll
        for (int t2 = 0; t2 < 2; ++t2) {
            const f32x16 s = qk_subtile(lds, t2, qf, c, h);
#pragma unroll
            for (int r = 0; r < 16; ++r) {
                const int n = 32 * t2 + (r & 3) + 8 * (r >> 2) + 4 * h;
                const float g = s[r];
                if (n < cur) {
                    if (g > v0) { v2 = v1; sel2 = sel1; v1 = v0; sel1 = sel0; v0 = g; sel0 = n; }
                    else if (g > v1) { v2 = v1; sel2 = sel1; v1 = g; sel1 = n; }
                    else if (g > v2) { v2 = g; sel2 = n; }
                }
            }
        }
        const float pv0 = __shfl_xor(v0, 32), pv1 = __shfl_xor(v1, 32), pv2 = __shfl_xor(v2, 32);
        const int pn0 = __shfl_xor(sel0, 32), pn1 = __shfl_xor(sel1, 32), pn2 = __shfl_xor(sel2, 32);
#pragma unroll
        for (int k = 0; k < 3; ++k) {
            const float g = k == 0 ? pv0 : (k == 1 ? pv1 : pv2);
            const int n = k == 0 ? pn0 : (k == 1 ? pn1 : pn2);
            if (n >= 0) {
                if (g > v0 || (g == v0 && n < sel0)) { v2 = v1; sel2 = sel1; v1 = v0; sel1 = sel0; v0 = g; sel0 = n; }
                else if (g > v1 || (g == v1 && n < sel1)) { v2 = v1; sel2 = sel1; v1 = g; sel1 = n; }
                else if (g > v2 || (g == v2 && n < sel2)) { v2 = g; sel2 = n; }
            }
        }
        int* lc = (int*)(lds + 16384);
        int* gb = lc + 64;
        int lp0 = 0, lp1 = 0, lp2 = 0;
        if (h == 0) {
            if (sel0 >= 0) lp0 = atomicAdd(lc + sel0, 1);
            if (sel1 >= 0) lp1 = atomicAdd(lc + sel1, 1);
            if (sel2 >= 0) lp2 = atomicAdd(lc + sel2, 1);
        }
        __syncthreads();
        if (tid < 64) gb[tid] = lc[tid] > 0 ? atomicAdd(p.mb_cnt + head * 64 + tid, lc[tid]) : 0;
        __syncthreads();
        if (h == 0) {
            if (sel0 >= 0) p.mb_list[((size_t)head * 64 + sel0) * T_ + gb[sel0] + lp0] = (query << 2) | 0;
            if (sel1 >= 0) p.mb_list[((size_t)head * 64 + sel1) * T_ + gb[sel1] + lp1] = (query << 2) | 1;
            if (sel2 >= 0) p.mb_list[((size_t)head * 64 + sel2) * T_ + gb[sel2] + lp2] = (query << 2) | 2;
        }
    }
}

#define MB_PRE_OFF (2 * ABUF_B)
__device__ __forceinline__ void phase_moba_sparse(const P& p, char* lds) {
    const int tid = otid(), lane = tid & 63, w = tid >> 6, c = lane & 31, h = lane >> 5;
    int* pre = (int*)(lds + MB_PRE_OFF);
    __syncthreads();
    if (tid < 64) {
        int loc[8]; int s = 0;
#pragma unroll
        for (int i = 0; i < 8; ++i) { loc[i] = (p.mb_cnt[tid * 8 + i] + 255) >> 8; s += loc[i]; }
        int incl = s;
#pragma unroll
        for (int o = 1; o < 64; o <<= 1) { const int v = __shfl_up(incl, o); if (tid >= o) incl += v; }
        int run = incl - s;
#pragma unroll
        for (int i = 0; i < 8; ++i) { pre[tid * 8 + i] = run; run += loc[i]; }
        if (tid == 63) pre[512] = run;
    }
    __syncthreads();
    const int total = pre[512];
#pragma unroll 1
    for (int u = blockIdx.x; u < total; u += gridDim.x) {
        int lo = 0, hi = 512;
#pragma unroll 1
        while (hi - lo > 1) { const int mid = (lo + hi) >> 1; if (pre[mid] <= u) lo = mid; else hi = mid; }
        const int li = lo, chunk = u - pre[li], head = li >> 6, n = li & 63;
        const int cnt = p.mb_cnt[li], idx = chunk * 256 + 32 * w + c;
        const bool valid = idx < cnt;
        const int ent = p.mb_list[(size_t)li * T_ + (valid ? idx : 0)];
        const int query = ent >> 2, slot = ent & 3;
        const bf16_t* kbase = p.k16 + (size_t)(8 + head) * T_ * 64;
        const bf16_t* vtbase = p.vT16 + (size_t)(8 + head) * 64 * T_;
        bf16x8 qf[4];
        load_qfrag(qf, p.q16 + ((size_t)(8 + head) * T_ + query) * 64, h);
        const float M2 = shift_bound_l2(qnorm2(qf), p.kmax2[8 + head]);
        f32x16 o[2];
#pragma unroll
        for (int i = 0; i < 16; ++i) { o[0][i] = 0.f; o[1][i] = 0.f; }
        float l = 0.f;
        TileRegs tr;
        tile_gload(tr, kbase, vtbase, n * 256);
        __syncthreads();
        tile_swrite(tr, lds);
        __syncthreads();
#pragma unroll 1
        for (int kt = 0; kt < 4; ++kt) {
            if (kt < 3) tile_gload(tr, kbase, vtbase, n * 256 + (kt + 1) * 64);
            const char* kb = lds + (kt & 1) * ABUF_B;
            attn_tile64(kb, kb + KTILE_B, qf, 0xffffffffu, 0xffffffffu, M2, l, o, c, h);
            if (kt < 3) {
                tile_swrite(tr, lds + ((kt + 1) & 1) * ABUF_B);
                __syncthreads();
            }
        }
        l += __shfl_xor(l, 32);
        if (valid) {
            float* po = p.mb_part + (((size_t)head * T_ + query) * 3 + slot) * 64;
#pragma unroll
            for (int dt = 0; dt < 2; ++dt)
#pragma unroll
                for (int g = 0; g < 4; ++g) *(f32x4*)(po + 32 * dt + 8 * g + 4 * h) = (f32x4){o[dt][4 * g], o[dt][4 * g + 1], o[dt][4 * g + 2], o[dt][4 * g + 3]};
            if (h == 0) p.mb_l[((size_t)head * T_ + query) * 3 + slot] = l;
        }
    }
}

__device__ __forceinline__ void phase_moba_own(const P& p, char* lds) {
    const int tid = otid(), lane = tid & 63, w = tid >> 6, c = lane & 31, h = lane >> 5;
#pragma unroll 1
    for (int t = blockIdx.x; t < 8 * 64; t += gridDim.x) {
        const int head = t & 7, cur = t >> 3;
        const int q0 = cur * 256, qw = q0 + 32 * w, query = qw + c;
        const bf16_t* kbase = p.k16 + (size_t)(8 + head) * T_ * 64;
        const bf16_t* vtbase = p.vT16 + (size_t)(8 + head) * 64 * T_;
        bf16x8 qf[4];
        load_qfrag(qf, p.q16 + ((size_t)(8 + head) * T_ + query) * 64, h);
        const float M2 = shift_bound_l2(qnorm2(qf), p.kmax2[8 + head]);
        f32x16 o[2];
#pragma unroll
        for (int i = 0; i < 16; ++i) { o[0][i] = 0.f; o[1][i] = 0.f; }
        float l = 0.f;
        TileRegs tr;
        tile_gload(tr, kbase, vtbase, q0);
        __syncthreads();
        tile_swrite(tr, lds);
        __syncthreads();
#pragma unroll 1
        for (int kt = 0; kt < 4; ++kt) {
            if (kt < 3) tile_gload(tr, kbase, vtbase, q0 + (kt + 1) * 64);
            const char* kb = lds + (kt & 1) * ABUF_B;
            const int keybase = q0 + kt * 64;
            const unsigned W0 = causal_word(query, keybase), W1 = causal_word(query, keybase + 32);
            if (__ballot((W0 | W1) != 0u) != 0ull) attn_tile64(kb, kb + KTILE_B, qf, W0, W1, M2, l, o, c, h);
            if (kt < 3) {
                tile_swrite(tr, lds + ((kt + 1) & 1) * ABUF_B);
                __syncthreads();
            }
        }
        l += __shfl_xor(l, 32);
        const int nsel = cur < 3 ? cur : 3;
#pragma unroll 1
        for (int sI = 0; sI < nsel; ++sI) {
            const float* po = p.mb_part + (((size_t)head * T_ + query) * 3 + sI) * 64;
#pragma unroll
            for (int dt = 0; dt < 2; ++dt)
#pragma unroll
                for (int g = 0; g < 4; ++g) {
                    const f32x4 v = *(const f32x4*)(po + 32 * dt + 8 * g + 4 * h);
                    o[dt][4 * g] += v[0]; o[dt][4 * g + 1] += v[1]; o[dt][4 * g + 2] += v[2]; o[dt][4 * g + 3] += v[3];
                }
            l += p.mb_l[((size_t)head * T_ + query) * 3 + sI];
        }
        store_o(p.o + (size_t)query * DM + 512 + head * 64, o, h, 1.0f / l);
    }
}

__device__ __forceinline__ void attn_tile64_2h(const char* kbA, const char* vbA, const char* kbB, const char* vbB,
                                               const bf16x8 (&qA)[4], const bf16x8 (&qB)[4], unsigned W0, unsigned W1, float MA, float MB,
                                               float& lA, float& lB, f32x16 (&oA)[2], f32x16 (&oB)[2], int c, int h) {
    u32x4 pA[2][2], pB[2][2];
    float lsA = 0.f, lsB = 0.f;
#pragma unroll
    for (int t2 = 0; t2 < 2; ++t2) {
        const unsigned Wh = (t2 ? W1 : W0) >> (4 * h);
        bool ok[16];
#pragma unroll
        for (int r = 0; r < 16; ++r) ok[r] = (Wh >> ((r & 3) + 8 * (r >> 2))) & 1u;
#pragma unroll
        for (int hd = 0; hd < 2; ++hd) {
            const char* kb = hd ? kbB : kbA;
            bf16x8 kf[4];
#pragma unroll
            for (int kk = 0; kk < 4; ++kk) kf[kk] = *(const bf16x8*)(kb + (32 * t2 + c) * KROW + (16 * kk + 8 * h) * 2);
            const float Mx = hd ? MB : MA;
            f32x16 sv;
#pragma unroll
            for (int i = 0; i < 16; ++i) sv[i] = ok[i] ? -Mx : -1.0e30f;
#pragma unroll
            for (int kk = 0; kk < 4; ++kk) sv = __builtin_amdgcn_mfma_f32_32x32x16_bf16(kf[kk], hd ? qB[kk] : qA[kk], sv, 0, 0, 0);
            f32v2_ ls2 = {0.f, 0.f};
#pragma unroll
            for (int sI = 0; sI < 2; ++sI) {
                f32v2_ a2[4];
#pragma unroll
                for (int j = 0; j < 4; ++j) {
                    a2[j][0] = fexp2(sv[8 * sI + 2 * j]);
                    a2[j][1] = fexp2(sv[8 * sI + 2 * j + 1]);
                    ls2 = ls2 + a2[j];
                }
                const u32x4 pk = (u32x4){pack2(a2[0][0], a2[0][1]), pack2(a2[1][0], a2[1][1]), pack2(a2[2][0], a2[2][1]), pack2(a2[3][0], a2[3][1])};
                if (hd) pB[t2][sI] = pk; else pA[t2][sI] = pk;
            }
            if (hd) lsB += ls2[0] + ls2[1]; else lsA += ls2[0] + ls2[1];
        }
    }
    lA += lsA;
    lB += lsB;
#pragma unroll
    for (int hd = 0; hd < 2; ++hd) {
        const char* vb = hd ? vbB : vbA;
#pragma unroll
        for (int t2 = 0; t2 < 2; ++t2) {
            u32x4 vf[2][2];
#pragma unroll
            for (int sI = 0; sI < 2; ++sI)
#pragma unroll
                for (int dt = 0; dt < 2; ++dt) {
                    const char* a = vb + (32 * dt + c) * VROW + (32 * t2 + 16 * sI + 4 * h) * 2;
                    const uint2 lo = *(const uint2*)a, hi = *(const uint2*)(a + 16);
                    vf[sI][dt] = (u32x4){lo.x, lo.y, hi.x, hi.y};
                }
#pragma unroll
            for (int sI = 0; sI < 2; ++sI)
#pragma unroll
                for (int dt = 0; dt < 2; ++dt) {
                    if (hd == 0) oA[dt] = __builtin_amdgcn_mfma_f32_32x32x16_bf16(__builtin_bit_cast(bf16x8, vf[sI][dt]), __builtin_bit_cast(bf16x8, pA[t2][sI]), oA[dt], 0, 0, 0);
                    else oB[dt] = __builtin_amdgcn_mfma_f32_32x32x16_bf16(__builtin_bit_cast(bf16x8, vf[sI][dt]), __builtin_bit_cast(bf16x8, pB[t2][sI]), oB[dt], 0, 0, 0);
                }
        }
    }
}

__device__ __forceinline__ void phase_dsa(const P& p, char* lds) {
    const int tid = otid(), lane = tid & 63, w = tid >> 6, c = lane & 31, h = lane >> 5;
    const int G = gridDim.x;
#pragma unroll 1
    for (int r = 0; r * G < 8 * 64; ++r) {
        const int t = zz_unit(r, blockIdx.x, G);
        if (t >= 8 * 64) continue;
        const int hA = (t & 7) * 2, hB = hA + 1, qb = 63 - (t >> 3);
        const int q0 = qb * 256, qw = q0 + 32 * w, query = qw + c;
        const bf16_t* kbaseA = p.k16 + (size_t)hA * T_ * 64;
        const bf16_t* vtbaseA = p.vT16 + (size_t)hA * 64 * T_;
        const bf16_t* kbaseB = p.k16 + (size_t)hB * T_ * 64;
        const bf16_t* vtbaseB = p.vT16 + (size_t)hB * 64 * T_;
        bf16x8 qA[4], qB[4];
        load_qfrag(qA, p.q16 + ((size_t)hA * T_ + query) * 64, h);
        load_qfrag(qB, p.q16 + ((size_t)hB * T_ + query) * 64, h);
        const float MA = shift_bound_l2(qnorm2(qA), p.kmax2[16 + hA]), MB = shift_bound_l2(qnorm2(qB), p.kmax2[16 + hB]);
        f32x16 oA[2], oB[2];
#pragma unroll
        for (int i = 0; i < 16; ++i) { oA[0][i] = 0.f; oA[1][i] = 0.f; oB[0][i] = 0.f; oB[1][i] = 0.f; }
        float lA = 0.f, lB = 0.f;
        const int ktend = (q0 + 255) >> 6;
        TileRegs trA, trB;
        const unsigned* bmq = p.bm + query;
        unsigned W0 = bmq[0], W1 = bmq[(size_t)T_];
        tile_gload(trA, kbaseA, vtbaseA, 0);
        tile_gload(trB, kbaseB, vtbaseB, 0);
        __syncthreads();
        tile_swrite(trA, lds);
        tile_swrite(trB, lds + ABUF_B);
        __syncthreads();
        int buf = 0;
#pragma unroll 1
        for (int kt = 0; kt <= ktend; ++kt) {
            const bool more = kt < ktend;
            const int ktn = more ? kt + 1 : kt;
            const unsigned Wn0 = bmq[(size_t)(2 * ktn) * T_], Wn1 = bmq[(size_t)(2 * ktn + 1) * T_];
            tile_gload(trA, kbaseA, vtbaseA, ktn * 64);
            tile_gload(trB, kbaseB, vtbaseB, ktn * 64);
            const char* kb = lds + buf * (2 * ABUF_B);
            attn_tile64_2h(kb, kb + KTILE_B, kb + ABUF_B, kb + ABUF_B + KTILE_B, qA, qB, W0, W1, MA, MB, lA, lB, oA, oB, c, h);
            if (!more) break;
            tile_swrite(trA, lds + (buf ^ 1) * (2 * ABUF_B));
            tile_swrite(trB, lds + (buf ^ 1) * (2 * ABUF_B) + ABUF_B);
            __syncthreads();
            buf ^= 1;
            W0 = Wn0; W1 = Wn1;
        }
        lA += __shfl_xor(lA, 32);
        lB += __shfl_xor(lB, 32);
        store_o(p.o + (size_t)query * DM + hA * 64, oA, h, 1.0f / lA);
        store_o(p.o + (size_t)query * DM + hB * 64, oB, h, 1.0f / lB);
    }
}
#ifndef FORCE_SLOW
#define FORCE_SLOW 0
#endif
#define IDX_ROWS 32
#define IDX_HIST_B (IDX_ROWS * 4096)
#define IDX_INFO_OFF IDX_HIST_B
#define IDX_CAND_OFF (IDX_HIST_B + 1024)
#define IDX_CAP 16
#define IDX_LDS_B (IDX_CAND_OFF + IDX_ROWS * IDX_CAP * 8)
#define IDX_FCAP 256

__device__ __forceinline__ unsigned fkey(float s) {
    const unsigned u = __float_as_uint(s + 0.0f);
    return (u & 0x80000000u) ? ~u : (u | 0x80000000u);
}
__device__ __forceinline__ unsigned sbin(float s) {
    const unsigned u = __float_as_uint(s + 0.0f);
    int t = (int)((u & 0x7fffffffu) >> 17) - (115 << 6);
    t = t < 0 ? 0 : (t > 1023 ? 1023 : t);
    return (u >> 31) ? (unsigned)(1023 - t) : (unsigned)(1024 + t);
}

__device__ __forceinline__ void find_bin(const unsigned* hrow, int need, int lane, int& bin_out, int& above_out) {
    unsigned wv[16];
    const int wbase = 1008 - 16 * lane;
#pragma unroll
    for (int i = 0; i < 4; ++i) {
        const u32x4 q = *(const u32x4*)(hrow + wbase + 4 * i);
        wv[4 * i] = q[0]; wv[4 * i + 1] = q[1]; wv[4 * i + 2] = q[2]; wv[4 * i + 3] = q[3];
    }
    int tot = 0;
#pragma unroll
    for (int i = 0; i < 16; ++i) tot += (int)(wv[i] >> 16) + (int)(wv[i] & 0xffffu);
    int incl = tot;
#pragma unroll
    for (int o = 1; o < 64; o <<= 1) {
        const int v = __shfl_up(incl, o);
        if (lane >= o) incl += v;
    }
    const unsigned long long bal = __ballot(incl >= need);
    const int fl = __ffsll(bal) - 1;
    int b = 0, ab = 0;
    if (lane == fl) {
        int cum = incl - tot;
        bool found = false;
#pragma unroll
        for (int i = 15; i >= 0; --i) {
            const int hi = (int)(wv[i] >> 16), lo = (int)(wv[i] & 0xffffu);
            if (!found) { if (cum + hi >= need) { found = true; b = 2 * (wbase + i) + 1; ab = cum; } else cum += hi; }
            if (!found) { if (cum + lo >= need) { found = true; b = 2 * (wbase + i); ab = cum; } else cum += lo; }
        }
    }
    bin_out = __shfl(b, fl < 0 ? 0 : fl);
    above_out = __shfl(ab, fl < 0 ? 0 : fl);
}

struct IdxCtx {
    bf16x8 af[4];
    float wq[2][8];
    int qabs[2], qloc[2];
};

__device__ __forceinline__ void idx_setup(const P& p, IdxCtx& x, int q0, int w, int c, int h) {
    const int u = ((c >> 4) & 1) + 2 * ((c >> 2) & 1), hd = (c & 3) + 4 * ((c >> 3) & 1);
    const bf16_t* qp = p.qi + ((size_t)(q0 + 4 * w + u) * 8 + hd) * 64;
#pragma unroll
    for (int kk = 0; kk < 4; ++kk) x.af[kk] = *(const bf16x8*)(qp + 16 * kk + 8 * h);
#pragma unroll
    for (int uu = 0; uu < 2; ++uu) {
        x.qloc[uu] = 4 * w + 2 * h + uu;
        x.qabs[uu] = q0 + x.qloc[uu];
        const f32x4 a = *(const f32x4*)(p.wi + (size_t)x.qabs[uu] * 8), b = *(const f32x4*)(p.wi + (size_t)x.qabs[uu] * 8 + 4);
        x.wq[uu][0] = a[0]; x.wq[uu][1] = a[1]; x.wq[uu][2] = a[2]; x.wq[uu][3] = a[3];
        x.wq[uu][4] = b[0]; x.wq[uu][5] = b[1]; x.wq[uu][6] = b[2]; x.wq[uu][7] = b[3];
    }
}
__device__ __forceinline__ void idx_load(const P& p, bf16x8 (&bk)[4], int kt, int c, int h) {
    const bf16_t* kp = p.ki + (size_t)(32 * kt + c) * 64 + 8 * h;
#pragma unroll
    for (int kk = 0; kk < 4; ++kk) bk[kk] = *(const bf16x8*)(kp + 16 * kk);
}
__device__ __forceinline__ void idx_scores(const IdxCtx& x, const bf16x8 (&bk)[4], float& s0, float& s1) {
    f32x16 s;
#pragma unroll
    for (int i = 0; i < 16; ++i) s[i] = 0.f;
#pragma unroll
    for (int kk = 0; kk < 4; ++kk) s = __builtin_amdgcn_mfma_f32_32x32x16_bf16(x.af[kk], bk[kk], s, 0, 0, 0);
    float r[16];
#pragma unroll
    for (int i = 0; i < 16; ++i) r[i] = fmaxf(s[i], 0.f);
    const float e0 = __builtin_fmaf(x.wq[0][6], r[6], __builtin_fmaf(x.wq[0][4], r[4], __builtin_fmaf(x.wq[0][2], r[2], x.wq[0][0] * r[0])));
    const float o0 = __builtin_fmaf(x.wq[0][7], r[7], __builtin_fmaf(x.wq[0][5], r[5], __builtin_fmaf(x.wq[0][3], r[3], x.wq[0][1] * r[1])));
    const float e1 = __builtin_fmaf(x.wq[1][6], r[14], __builtin_fmaf(x.wq[1][4], r[12], __builtin_fmaf(x.wq[1][2], r[10], x.wq[1][0] * r[8])));
    const float o1 = __builtin_fmaf(x.wq[1][7], r[15], __builtin_fmaf(x.wq[1][5], r[13], __builtin_fmaf(x.wq[1][3], r[11], x.wq[1][1] * r[9])));
    s0 = e0 + o0;
    s1 = e1 + o1;
}

__device__ __forceinline__ float relu1(float v) { const int b = __float_as_int(v); return __int_as_float(b > 0 ? b : 0); }
__device__ __forceinline__ void idx_scores2(const IdxCtx& x, const bf16x8 (&bk0)[4], const bf16x8 (&bk1)[4], float& a0, float& a1, float& b0, float& b1) {
    f32x16 s, t;
#pragma unroll
    for (int i = 0; i < 16; ++i) { s[i] = 0.f; t[i] = 0.f; }
#pragma unroll
    for (int kk = 0; kk < 4; ++kk) {
        s = __builtin_amdgcn_mfma_f32_32x32x16_bf16(x.af[kk], bk0[kk], s, 0, 0, 0);
        t = __builtin_amdgcn_mfma_f32_32x32x16_bf16(x.af[kk], bk1[kk], t, 0, 0, 0);
    }
    float r[16], q[16];
#pragma unroll
    for (int i = 0; i < 16; ++i) { r[i] = relu1(s[i]); q[i] = relu1(t[i]); }
    {
        const float e0 = __builtin_fmaf(x.wq[0][6], r[6], __builtin_fmaf(x.wq[0][4], r[4], __builtin_fmaf(x.wq[0][2], r[2], x.wq[0][0] * r[0])));
        const float o0 = __builtin_fmaf(x.wq[0][7], r[7], __builtin_fmaf(x.wq[0][5], r[5], __builtin_fmaf(x.wq[0][3], r[3], x.wq[0][1] * r[1])));
        const float e1 = __builtin_fmaf(x.wq[1][6], r[14], __builtin_fmaf(x.wq[1][4], r[12], __builtin_fmaf(x.wq[1][2], r[10], x.wq[1][0] * r[8])));
        const float o1 = __builtin_fmaf(x.wq[1][7], r[15], __builtin_fmaf(x.wq[1][5], r[13], __builtin_fmaf(x.wq[1][3], r[11], x.wq[1][1] * r[9])));
        a0 = e0 + o0; a1 = e1 + o1;
    }
    {
        const float e0 = __builtin_fmaf(x.wq[0][6], q[6], __builtin_fmaf(x.wq[0][4], q[4], __builtin_fmaf(x.wq[0][2], q[2], x.wq[0][0] * q[0])));
        const float o0 = __builtin_fmaf(x.wq[0][7], q[7], __builtin_fmaf(x.wq[0][5], q[5], __builtin_fmaf(x.wq[0][3], q[3], x.wq[0][1] * q[1])));
        const float e1 = __builtin_fmaf(x.wq[1][6], q[14], __builtin_fmaf(x.wq[1][4], q[12], __builtin_fmaf(x.wq[1][2], q[10], x.wq[1][0] * q[8])));
        const float o1 = __builtin_fmaf(x.wq[1][7], q[15], __builtin_fmaf(x.wq[1][5], q[13], __builtin_fmaf(x.wq[1][3], q[11], x.wq[1][1] * q[9])));
        b0 = e0 + o0; b1 = e1 + o1;
    }
}

#define IDX_RING_OFF IDX_LDS_B
#define IDX_RING_TILE_B (64 * 144)
#define IDX_TOTAL_LDS_B (IDX_RING_OFF + 2 * IDX_RING_TILE_B)
template <class F>
__device__ __forceinline__ void idx_sweep(const P& p, const IdxCtx& x, int ntile, int c, int h, char* lds, F body) {
    const int tid = otid(), row = tid >> 3, cc = tid & 7;
    char* ring = lds + IDX_RING_OFF;
    const int nt64 = (ntile + 1) >> 1;
    const bf16_t* src = p.ki + (size_t)row * 64 + cc * 8;
    u32x4 reg = *(const u32x4*)src;
    __syncthreads();
    *(u32x4*)(ring + row * 144 + cc * 16) = reg;
    __syncthreads();
#pragma unroll 1
    for (int t = 0; t < nt64; ++t) {
        const bool more = t + 1 < nt64;
        if (more) reg = *(const u32x4*)(src + (size_t)(t + 1) * 64 * 64);
        const char* rb = ring + (t & 1) * IDX_RING_TILE_B;
        bf16x8 bk0[4], bk1[4];
#pragma unroll
        for (int kk = 0; kk < 4; ++kk) {
            bk0[kk] = *(const bf16x8*)(rb + c * 144 + 32 * kk + 16 * h);
            bk1[kk] = *(const bf16x8*)(rb + (32 + c) * 144 + 32 * kk + 16 * h);
        }
        __builtin_amdgcn_sched_barrier(0);
        float sa0, sa1, sb0, sb1;
        idx_scores2(x, bk0, bk1, sa0, sa1, sb0, sb1);
        body(2 * t, sa0, sa1);
        body(2 * t + 1, sb0, sb1);
        if (more) *(u32x4*)(ring + ((t + 1) & 1) * IDX_RING_TILE_B + row * 144 + cc * 16) = reg;
        __syncthreads();
    }
}

__device__ __forceinline__ void idx_unit_slow(const P& p, const IdxCtx& x, char* lds, int q0, int ntile, int tid, int lane, int w, int c, int h) {
    unsigned* hist = (unsigned*)lds;
    int* info = (int*)(lds + IDX_INFO_OFF);
    uint2* cand = (uint2*)(lds + IDX_CAND_OFF);
    __syncthreads();
    if (tid < IDX_ROWS) {
        const int nk = q0 + tid + 1;
        info[tid] = nk < 256 ? nk : 256;
        info[5 * IDX_ROWS + tid] = 0;
    }
#pragma unroll 1
    for (int pass = 0; pass < 3; ++pass) {
        for (int i = tid; i < IDX_HIST_B / 16; i += NTHR) ((u32x4*)hist)[i] = (u32x4){0u, 0u, 0u, 0u};
        __syncthreads();
        int pb1[2], pb2[2];
#pragma unroll
        for (int uu = 0; uu < 2; ++uu) { pb1[uu] = info[IDX_ROWS + x.qloc[uu]]; pb2[uu] = info[3 * IDX_ROWS + x.qloc[uu]]; }
        idx_sweep(p, x, ntile, c, h, lds, [&](int kt, float s0, float s1) {
            const int key = 32 * kt + c;
#pragma unroll
            for (int uu = 0; uu < 2; ++uu) {
                const bool valid = key <= x.qabs[uu];
                const unsigned ku = fkey(uu == 0 ? s0 : s1);
                if (pass == 0) {
                    if (valid) { const unsigned bin = ku >> 21; atomicAdd(hist + x.qloc[uu] * 1024 + (bin >> 1), 1u << (16 * (bin & 1))); }
                } else if (pass == 1) {
                    if (valid && (int)(ku >> 21) == pb1[uu]) { const unsigned bin = (ku >> 10) & 2047u; atomicAdd(hist + x.qloc[uu] * 1024 + (bin >> 1), 1u << (16 * (bin & 1))); }
                } else {
                    const bool sa = x.qabs[uu] < 256;
                    const unsigned pfx = ku >> 10, P22 = ((unsigned)pb1[uu] << 11) | (unsigned)pb2[uu];
                    const bool gt = valid && (sa || pfx > P22);
                    const bool eq = valid && !sa && pfx == P22;
                    const unsigned long long bal = __ballot(gt);
                    if (c == 0) hist[kt * IDX_ROWS + x.qloc[uu]] = h ? (unsigned)(bal >> 32) : (unsigned)bal;
                    if (eq) {
                        const int ix = atomicAdd(info + 5 * IDX_ROWS + x.qloc[uu], 1);
                        if (ix < IDX_CAP) cand[x.qloc[uu] * IDX_CAP + ix] = make_uint2(ku, (unsigned)key);
                    }
                }
            }
        });
        __syncthreads();
        if (pass < 2) {
#pragma unroll 1
            for (int rr = 0; rr < 4; ++rr) {
                const int row = 4 * w + rr;
                const int need = pass == 0 ? info[row] : info[2 * IDX_ROWS + row];
                int b, ab;
                find_bin(hist + row * 1024, need, lane, b, ab);
                if (lane == 0) {
                    if (pass == 0) { info[IDX_ROWS + row] = b; info[2 * IDX_ROWS + row] = need - ab; }
                    else { info[3 * IDX_ROWS + row] = b; info[4 * IDX_ROWS + row] = need - ab; }
                }
            }
            __syncthreads();
        }
    }
    if (tid < IDX_ROWS) {
        const int row = tid, n = info[5 * IDX_ROWS + row] < IDX_CAP ? info[5 * IDX_ROWS + row] : IDX_CAP, need2 = info[4 * IDX_ROWS + row];
        for (int i = 0; i < n; ++i) {
            const uint2 ci = cand[row * IDX_CAP + i];
            int rank = 0;
            for (int j = 0; j < n; ++j) {
                const uint2 cj = cand[row * IDX_CAP + j];
                rank += (cj.x > ci.x || (cj.x == ci.x && cj.y < ci.y)) ? 1 : 0;
            }
            if (rank < need2) hist[(ci.y >> 5) * IDX_ROWS + row] |= 1u << (ci.y & 31u);
        }
    }
    __syncthreads();
}

__device__ __forceinline__ void phase_indexer(const P& p, char* lds) {
    const int tid = otid(), lane = tid & 63, w = tid >> 6, c = lane & 31, h = lane >> 5;
    unsigned* hist = (unsigned*)lds;
    int* info = (int*)(lds + IDX_INFO_OFF);
    uint2* fcand = (uint2*)(lds + 65536);
#pragma unroll 1
    for (int rnd = 0; rnd * (int)gridDim.x < T_ / IDX_ROWS; ++rnd) {
        const int t = zz_unit(rnd, blockIdx.x, gridDim.x);
        if (t >= T_ / IDX_ROWS) continue;
        const int qblk = (T_ / IDX_ROWS - 1) - t;
        const int q0 = qblk * IDX_ROWS;
        IdxCtx x;
        idx_setup(p, x, q0, w, c, h);
        const int ntile = (q0 + IDX_ROWS - 1) / 32 + 1;
        const bool selall_blk = (q0 + IDX_ROWS) <= 256;
        __syncthreads();
        if (tid < IDX_ROWS) {
            const int nk = q0 + tid + 1;
            info[tid] = nk < 256 ? nk : 256;
            info[IDX_ROWS + tid] = 0;
            info[2 * IDX_ROWS + tid] = 0;
            info[5 * IDX_ROWS + tid] = 0;
        }
        const int Lrow = ((ntile + 1) >> 1) * 64;
        unsigned short* bins = (unsigned short*)p.act + (size_t)32 * 64 * ((qblk & 1) ? ((qblk >> 1) + 1) * ((qblk >> 1) + 1) : (qblk >> 1) * ((qblk >> 1) + 1));
        unsigned short* brow0 = bins + (size_t)x.qloc[0] * Lrow;
        unsigned short* brow1 = bins + (size_t)x.qloc[1] * Lrow;
        if (!selall_blk) {
            for (int i = tid; i < IDX_HIST_B / 16; i += NTHR) ((u32x4*)hist)[i] = (u32x4){0u, 0u, 0u, 0u};
            __syncthreads();
            idx_sweep(p, x, ntile, c, h, lds, [&](int kt, float s0, float s1) {
                const int key = 32 * kt + c;
                const unsigned b0 = sbin(s0), b1_ = sbin(s1);
                const unsigned inc0 = key <= x.qabs[0] ? (1u << (16 * (b0 & 1))) : 0u, inc1 = key <= x.qabs[1] ? (1u << (16 * (b1_ & 1))) : 0u;
                atomicAdd(hist + x.qloc[0] * 1024 + (b0 >> 1), inc0);
                atomicAdd(hist + x.qloc[1] * 1024 + (b1_ >> 1), inc1);
                const unsigned p0 = b0 | (__shfl_down(b0, 1) << 16), p1 = b1_ | (__shfl_down(b1_, 1) << 16);
                const unsigned p0h = __shfl_down(p0, 2), p1h = __shfl_down(p1, 2);
                if ((c & 3) == 0) {
                    *(uint2*)(brow0 + key) = make_uint2(p0, p0h);
                    *(uint2*)(brow1 + key) = make_uint2(p1, p1h);
                }
            });
            __syncthreads();
#pragma unroll 1
            for (int rr = 0; rr < 4; ++rr) {
                const int row = 4 * w + rr;
                int b, ab;
                find_bin(hist + row * 1024, info[row], lane, b, ab);
                if (lane == 0) { info[IDX_ROWS + row] = b; info[2 * IDX_ROWS + row] = info[row] - ab; }
            }
            __syncthreads();
        }
        for (int i = tid; i < 65536 / 16; i += NTHR) ((u32x4*)hist)[i] = (u32x4){0u, 0u, 0u, 0u};
        __syncthreads();
        {
            const int row = 4 * w + (lane >> 4), kc = lane & 15, qrow = q0 + row;
            const int tb = info[IDX_ROWS + row];
            const bool sa = selall_blk;
            const unsigned short* br = bins + (size_t)row * Lrow + 8 * kc;
            const int nstep = (Lrow + 127) >> 7;
            u32x4 cur = {0u, 0u, 0u, 0u};
            if (!sa && 8 * kc < Lrow) cur = *(const u32x4*)br;
#pragma unroll 1
            for (int st = 0; st < nstep; ++st) {
                u32x4 nxt = {0u, 0u, 0u, 0u};
                if (!sa && st + 1 < nstep && (st + 1) * 128 + 8 * kc < Lrow) nxt = *(const u32x4*)(br + (st + 1) * 128);
                const int k0 = st * 128 + 8 * kc;
                unsigned m8 = 0u;
#pragma unroll
                for (int i = 0; i < 8; ++i) {
                    const int bn = (int)((cur[i >> 1] >> (16 * (i & 1))) & 0xffffu), key = k0 + i;
                    const bool v = key <= qrow;
                    if (v && (sa || bn > tb)) m8 |= 1u << i;
                    if (v && !sa && bn == tb) {
                        const int ix = atomicAdd(info + 5 * IDX_ROWS + row, 1);
                        if (ix < IDX_FCAP) fcand[row * IDX_FCAP + ix] = make_uint2(0u, (unsigned)key);
                    }
                }
                const unsigned w1 = __shfl_down(m8, 1), w2 = __shfl_down(m8, 2), w3 = __shfl_down(m8, 3);
                if ((kc & 3) == 0 && k0 < Lrow) hist[(st * 4 + (kc >> 2)) * IDX_ROWS + row] = m8 | (w1 << 8) | (w2 << 16) | (w3 << 24);
                cur = nxt;
            }
        }
        const int ovf = __syncthreads_or(FORCE_SLOW || (tid < IDX_ROWS && info[5 * IDX_ROWS + tid] > IDX_FCAP));
        if (ovf) {
            idx_unit_slow(p, x, lds, q0, ntile, tid, lane, w, c, h);
        } else {
#pragma unroll 1
            for (int rr = 0; rr < 4; ++rr) {
                const int row = 4 * w + rr, n = info[5 * IDX_ROWS + row], need1 = info[2 * IDX_ROWS + row];
                uint2* cl = fcand + row * IDX_FCAP;
                if (n > 0) {
                    const int hd = lane >> 3, dc = lane & 7;
                    const bf16x8 qv = *(const bf16x8*)(p.qi + ((size_t)(q0 + row) * 8 + hd) * 64 + 8 * dc);
                    const float wgt = p.wi[(size_t)(q0 + row) * 8 + hd];
#pragma unroll 1
                    for (int j0 = 0; j0 < n; j0 += 8) {
                        bf16x8 kv[8];
#pragma unroll
                        for (int u = 0; u < 8; ++u) {
                            const unsigned key = cl[j0 + u < n ? j0 + u : n - 1].y;
                            kv[u] = *(const bf16x8*)(p.ki + (size_t)key * 64 + 8 * dc);
                        }
#pragma unroll
                        for (int u = 0; u < 8; ++u) {
                            float d = 0.f;
#pragma unroll
                            for (int e = 0; e < 8; ++e) d = __builtin_fmaf(bf2f((bf16_t)qv[e]), bf2f((bf16_t)kv[u][e]), d);
                            d += __shfl_xor(d, 1); d += __shfl_xor(d, 2); d += __shfl_xor(d, 4);
                            float sc = wgt * fmaxf(d, 0.f);
                            sc += __shfl_xor(sc, 8); sc += __shfl_xor(sc, 16); sc += __shfl_xor(sc, 32);
                            if (lane == 0 && j0 + u < n) cl[j0 + u].x = fkey(sc);
                        }
                    }
                }
                __builtin_amdgcn_s_waitcnt(0xc07f);
                __builtin_amdgcn_wave_barrier();
#pragma unroll 1
                for (int i0 = 0; i0 < n; i0 += 64) {
                    const int i = i0 + lane;
                    const uint2 ci = cl[i < n ? i : 0];
                    int rank = 0;
#pragma unroll 1
                    for (int j = 0; j < n; ++j) {
                        const uint2 cj = cl[j];
                        rank += (cj.x > ci.x || (cj.x == ci.x && cj.y < ci.y)) ? 1 : 0;
                    }
                    if (i < n && rank < need1) atomicOr(hist + (ci.y >> 5) * IDX_ROWS + row, 1u << (ci.y & 31u));
                }
            }
            __syncthreads();
        }
        const int nw = (((q0 & ~255) >> 5) + 8) * IDX_ROWS;
        for (int i = tid; i < nw; i += NTHR) {
            const int kt = i / IDX_ROWS, r = i % IDX_ROWS;
            p.bm[(size_t)kt * T_ + q0 + r] = hist[i];
        }
    }
}
#define XB_TMO      128
#define XB_XCNT(j)  (256  + 64 * (j))
#define XB_XSUB(j)  (1280 + 64 * (j))
#define XB_XGEN(j)  (2304 + 64 * (j))
#define XB_TOP      3328
#define XB_TOPGEN   3392
#define XCD_BAR_WORDS 3456
#define XB_SPIN_CAP (1u << 22)
#define LAS __attribute__((address_space(3)))

__device__ __forceinline__ unsigned xb_ld(unsigned* p)              { return __hip_atomic_load(p, __ATOMIC_RELAXED, __HIP_MEMORY_SCOPE_AGENT); }
__device__ __forceinline__ unsigned xb_add(unsigned* p, unsigned v) { return __hip_atomic_fetch_add(p, v, __ATOMIC_RELAXED, __HIP_MEMORY_SCOPE_AGENT); }
__device__ __forceinline__ unsigned xb_xcc_id() { return (unsigned)__builtin_amdgcn_s_getreg((3 << 11) | 20) & 0xFu; }
#define XB_SPIN(cond, bar) do { unsigned _sp = 0; while (cond) { __builtin_amdgcn_s_sleep(1); \
    if ((++_sp & 255u) == 0u) { if (xb_ld(&(bar)[XB_TMO])) break; if (_sp > XB_SPIN_CAP) { atomicAdd(&(bar)[XB_TMO], 1u); break; } } } } while (0)

struct XcdBarrier { unsigned* bar; unsigned x; volatile LAS unsigned* st; };

__device__ __forceinline__ XcdBarrier xcd_barrier_post(unsigned* bar, volatile LAS unsigned* st) {
    XcdBarrier b; b.bar = bar; b.x = xb_xcc_id(); b.st = st;
    if (threadIdx.x == 0) (void)xb_add(&bar[XB_XCNT(b.x)], 1u);
    return b;
}
__device__ __forceinline__ void xcd_barrier_complete(unsigned* bar, unsigned x, unsigned& nloc, unsigned& nx) {
    const unsigned G = gridDim.x * gridDim.y * gridDim.z;
    unsigned sum, cnt, mine, sp = 0u;
    for (;;) {
        sum = 0u; cnt = 0u; mine = 0u;
#pragma unroll
        for (unsigned j = 0; j < 16; ++j) { const unsigned c = xb_ld(&bar[XB_XCNT(j)]); sum += c; cnt += (c > 0u) ? 1u : 0u; mine = (j == x) ? c : mine; }
        if (sum == G) break;
        __builtin_amdgcn_s_sleep(1);
        if ((++sp & 255u) == 0u) { if (xb_ld(&bar[XB_TMO])) break; if (sp > XB_SPIN_CAP) { atomicAdd(&bar[XB_TMO], 1u); break; } }
    }
    nloc = mine > 0u ? mine : 1u; nx = cnt > 0u ? cnt : 1u;
}
__device__ __forceinline__ void xcd_barrier(const XcdBarrier& b) {
    asm volatile("s_waitcnt vmcnt(0)" ::: "memory");
    __syncthreads();
    if (threadIdx.x == 0) {
        unsigned* bar = b.bar;
        __builtin_amdgcn_s_waitcnt(0);
        unsigned nloc = b.st[0], nx = b.st[1];
        if (nloc == 0u) { xcd_barrier_complete(bar, b.x, nloc, nx); b.st[0] = nloc; b.st[1] = nx; }
        const unsigned old = xb_add(&bar[XB_XSUB(b.x)], 1u);
        const unsigned gen = old / nloc;
        if (old + 1u == (gen + 1u) * nloc) {
            __builtin_amdgcn_fence(__ATOMIC_RELEASE, "agent");
            asm volatile("s_waitcnt vmcnt(0)" ::: "memory");
            const unsigned og = xb_add(&bar[XB_TOP], 1u);
            const unsigned tg = og / nx;
            if (og + 1u == (tg + 1u) * nx) xb_add(&bar[XB_TOPGEN], 1u);
            else XB_SPIN(xb_ld(&bar[XB_TOPGEN]) == tg, bar);
            __builtin_amdgcn_fence(__ATOMIC_ACQUIRE, "agent");
            xb_add(&bar[XB_XGEN(b.x)], 1u);
            asm volatile("s_waitcnt vmcnt(0)" ::: "memory");
        } else {
            XB_SPIN(xb_ld(&bar[XB_XGEN(b.x)]) == gen, bar);
            __builtin_amdgcn_fence(__ATOMIC_ACQUIRE, "agent");
            asm volatile("s_waitcnt vmcnt(0)" ::: "memory");
        }
    }
    __syncthreads();
}


#define GSYNC() xcd_barrier(xb)
#define MEGA_LDS_B (IDX_TOTAL_LDS_B > (RT_DEC_OFF + 4096) ? IDX_TOTAL_LDS_B : (RT_DEC_OFF + 4096))
template <int layer>
__device__ __forceinline__ void tail_phases(const P& p, char* lds, const XcdBarrier& xb) {
    phase_outproj(p, layer == 0 ? p.wb_ab_out : p.wb_c_out, layer == 0 ? p.x : p.x3, lds);
    GSYNC();
    phase_ln_router(p, layer, lds);
    GSYNC();
    phase_moe1(p, layer, lds);
    GSYNC();
    phase_moe2(p, layer, lds);
    GSYNC();
    phase_combine_ln(p, layer, lds);
    GSYNC();
    phase_ple(p, layer, layer == 0 ? p.x3 : p.out, lds);
    if (layer == 0) GSYNC();
}

__global__ void __launch_bounds__(512, 2) mega(P p) {
    extern __shared__ __attribute__((aligned(16))) char lds[];
    cg::grid_group grid = cg::this_grid();
    volatile LAS unsigned* st = (volatile LAS unsigned*)(lds + MEGA_LDS_B);
    if (threadIdx.x == 0) { st[0] = 0u; st[1] = 0u; }
    __syncthreads();
    const XcdBarrier xb = xcd_barrier_post(p.bar, st);
    phase_convert(p, lds);
    if (p.bar == nullptr) grid.sync();
    xcd_barrier(xb);
    phase_pp(p, lds);
    phase_inproj<0>(p, lds);
    GSYNC();
    phase_moba_gate(p, lds);
    phase_sb(p, lds);
    GSYNC();
    phase_moba_sparse(p, lds);
    GSYNC();
    phase_moba_own(p, lds);
    GSYNC();
#if defined(DEBUG_STAGE) && (DEBUG_STAGE == 2 || DEBUG_STAGE == 1)
    return;
#endif
    tail_phases<0>(p, lds, xb);
    phase_inproj<1>(p, lds);
    GSYNC();
    phase_indexer(p, lds);
    GSYNC();
    phase_dsa(p, lds);
    GSYNC();
    tail_phases<1>(p, lds, xb);
}

static inline char* carve(char*& cur, size_t bytes) { char* r = cur; cur += (bytes + 255) & ~(size_t)255; return r; }

static void make_params(P& p, void* const* d_in, void* d_out, void* d_ws) {
    p.x = (const float*)d_in[0]; p.p = (const float*)d_in[1]; p.ab_w_in = (const float*)d_in[2]; p.ab_w_out = (const float*)d_in[3];
    p.c_w_in = (const float*)d_in[4]; p.c_w_out = (const float*)d_in[5]; p.ln_g = (const float*)d_in[6]; p.ln_b = (const float*)d_in[7];
    p.router_w = (const float*)d_in[8]; p.router_b = (const float*)d_in[9]; p.moe_w1 = (const float*)d_in[10]; p.moe_b1 = (const float*)d_in[11];
    p.moe_w2 = (const float*)d_in[12]; p.moe_b2 = (const float*)d_in[13]; p.ple_w_proj = (const float*)d_in[14]; p.ple_w_gate = (const float*)d_in[15];
    p.out = (float*)d_out;
    char* cur = (char*)d_ws;
    const size_t T = T_;
    p.cnt = (int*)carve(cur, 256);
    p.dbg = (float*)carve(cur, 256);
    p.bar = (unsigned*)carve(cur, XCD_BAR_WORDS * sizeof(unsigned));
    p.wb_ab_in = (bf16_t*)carve(cur, (size_t)3072 * 1024 * 2);
    p.wb_ab_out = (bf16_t*)carve(cur, (size_t)1024 * 1024 * 2);
    p.wb_c_in = (bf16_t*)carve(cur, (size_t)C_INP * 1024 * 2);
    p.ksum = (float*)carve(cur, 8 * 64 * 64 * 4);
    p.kmax2 = (unsigned*)carve(cur, 256);
    p.mb_cnt = (int*)carve(cur, 512 * 4);
    p.mb_list = (int*)carve(cur, (size_t)512 * T * 4);
    p.mb_part = (float*)carve(cur, (size_t)8 * T * 3 * 64 * 4);
    p.mb_l = (float*)carve(cur, (size_t)8 * T * 3 * 4);
    p.wb_c_out = (bf16_t*)carve(cur, (size_t)1024 * 1024 * 2);
    p.wb_w1 = (bf16_t*)carve(cur, (size_t)64 * 2048 * 1024 * 2);
    p.wb_w2 = (bf16_t*)carve(cur, (size_t)64 * 1024 * 1024 * 2);
    p.wb_g = (bf16_t*)carve(cur, (size_t)2 * 1024 * 1024 * 2);
    p.wb_p = (bf16_t*)carve(cur, (size_t)2 * 1024 * 256 * 2);
    p.xb = (bf16_t*)carve(cur, T * DM * 2);
    p.pb = (bf16_t*)carve(cur, 2 * T * 256 * 2);
    p.pp = (float*)carve(cur, 2 * T * DM * 4);
    p.rope = (float*)carve(cur, T * 32 * 2 * 4);
    p.q16 = (bf16_t*)carve(cur, 16 * T * 64 * 2);
    p.k16 = (bf16_t*)carve(cur, 16 * T * 64 * 2);
    p.vT16 = (bf16_t*)carve(cur, 16 * T * 64 * 2);
    p.o = (bf16_t*)carve(cur, T * DM * 2);
    p.ypre = (float*)carve(cur, T * DM * 4);
    p.x1 = (float*)carve(cur, T * DM * 4);
    p.x1b = (bf16_t*)carve(cur, T * DM * 2);
    p.act = (bf16_t*)carve(cur, (size_t)(65536 + 32 * 256) * DM * 2);
    p.oslot = (bf16_t*)carve(cur, (size_t)(65536 + 32 * 256) * DM * 2);
    p.x2 = (float*)carve(cur, T * DM * 4);
    p.x2b = (bf16_t*)carve(cur, T * DM * 2);
    p.x3 = (float*)carve(cur, T * DM * 4);
    p.qi = (bf16_t*)carve(cur, T * 8 * 64 * 2);
    p.ki = (bf16_t*)carve(cur, T * 64 * 2);
    p.wi = (float*)carve(cur, T * 8 * 4);
    p.bm = (unsigned*)carve(cur, (size_t)512 * T * 4);
    p.tok_of = (int*)carve(cur, (size_t)32 * T * 4);
    p.sel_e = (int*)carve(cur, T * 4 * 4);
    p.sel_pos = (int*)carve(cur, T * 4 * 4);
    p.sel_g = (float*)carve(cur, T * 4 * 4);
}

extern "C" void kernel_launch(void* const* d_in, const int* in_sizes, int n_in, void* d_out, int out_size, void* d_ws, size_t ws_size, hipStream_t stream) {
    P p{};
    make_params(p, d_in, d_out, d_ws);
    constexpr size_t kDynLds = MEGA_LDS_B + 16;
    static int grid_blocks = 0;
    if (!grid_blocks) {
        int dev = 0, cus = 0, per_cu = 0;
        hipGetDevice(&dev);
        hipDeviceGetAttribute(&cus, hipDeviceAttributeMultiprocessorCount, dev);
        hipFuncSetAttribute((const void*)mega, hipFuncAttributeMaxDynamicSharedMemorySize, (int)kDynLds);
        hipOccupancyMaxActiveBlocksPerMultiprocessor(&per_cu, mega, NTHR, kDynLds);
        if (per_cu > 1) per_cu = 1;
        if (per_cu < 1) per_cu = 1;
        grid_blocks = cus * per_cu;
    }
    hipMemsetAsync(p.bar, 0, XCD_BAR_WORDS * sizeof(unsigned), stream);
    void* args[] = {&p};
    hipError_t e = hipLaunchCooperativeKernel((void*)mega, dim3(grid_blocks), dim3(NTHR), args, kDynLds, stream);
    if (e != hipSuccess) fprintf(stderr, "cooperative launch failed: %s (grid %d)\n", hipGetErrorString(e), grid_blocks);
#if defined(DEBUG_STAGE) && DEBUG_STAGE == 1
    k_dbg_zero<<<1, 64, 0, stream>>>(p);
    k_chk_sb<<<512, 64, 0, stream>>>(p);
    k_report<<<1024, 256, 0, stream>>>(p, 0, 100.0f);
#endif
#if defined(DEBUG_STAGE) && DEBUG_STAGE == 5
    k_dbg_zero<<<1, 64, 0, stream>>>(p);
    k_chk_moe<<<128, 256, 0, stream>>>(p);
    k_report<<<1024, 256, 0, stream>>>(p, 0, 100.0f);
#endif
#if defined(DEBUG_STAGE) && DEBUG_STAGE == 4
    k_dbg_zero<<<1, 64, 0, stream>>>(p);
    k_chk_dsa<<<512, 64, 0, stream>>>(p);
    k_report<<<1024, 256, 0, stream>>>(p, 0, 100.0f);
#endif
#if defined(DEBUG_STAGE) && DEBUG_STAGE == 3
    k_dbg_zero<<<1, 64, 0, stream>>>(p);
    k_chk_idx<<<32, 256, 65536, stream>>>(p);
    k_report<<<1024, 256, 0, stream>>>(p, 1, 1.0f / 32.0f);
#endif
#if defined(DEBUG_STAGE) && DEBUG_STAGE == 2
    k_dbg_zero<<<1, 64, 0, stream>>>(p);
    k_chk_moba<<<512, 64, 0, stream>>>(p);
    k_report<<<1024, 256, 0, stream>>>(p, 1, 1.0f);
#endif
}
```

```cpp
#include <hip/hip_runtime.h>
#include <hip/hip_cooperative_groups.h>
#include <stdint.h>
#include <cstdio>
namespace cg = cooperative_groups;

typedef unsigned short bf16_t;
typedef short bf16x8 __attribute__((ext_vector_type(8)));
typedef float f32x4 __attribute__((ext_vector_type(4)));
typedef float f32x16 __attribute__((ext_vector_type(16)));
typedef unsigned u32x4 __attribute__((ext_vector_type(4)));

#define T_ 16384
#define DM 1024
#define NEXP 32
#define C_IN_ 3656
#define C_INP 3840
#define LOG2E 1.4426950408889634f
#define DN_ALPHA 1.4142135623730951f
#define NTHR 512
#define NWAVE 8

__device__ __forceinline__ int otid() { int t = threadIdx.x; asm volatile("" : "+v"(t)); return t; }
__device__ __forceinline__ bf16_t f2bf(float f) { unsigned u = __float_as_uint(f); u += 0x7FFFu + ((u >> 16) & 1u); return (bf16_t)(u >> 16); }
__device__ __forceinline__ float bf2f(bf16_t b) { return __uint_as_float(((unsigned)b) << 16); }
typedef __bf16 bf16v2_ __attribute__((ext_vector_type(2)));
typedef float f32v2_ __attribute__((ext_vector_type(2)));
__device__ __forceinline__ unsigned pack2(float lo, float hi) { const f32v2_ v = {lo, hi}; return __builtin_bit_cast(unsigned, __builtin_convertvector(v, bf16v2_)); }
__device__ __forceinline__ float fexp2(float x) { return __builtin_amdgcn_exp2f(x); }
__device__ __forceinline__ float flog2(float x) { return __builtin_amdgcn_logf(x); }
__device__ __forceinline__ float sigmoidf_(float x) { return __builtin_amdgcn_rcpf(1.0f + __builtin_amdgcn_exp2f(-LOG2E * x)); }
__device__ __forceinline__ float wave_sum(float v) {
#pragma unroll
    for (int o = 32; o > 0; o >>= 1) v += __shfl_xor(v, o);
    return v;
}

struct P {
    const float *x, *p, *ab_w_in, *ab_w_out, *c_w_in, *c_w_out, *ln_g, *ln_b, *router_w, *router_b, *moe_w1, *moe_b1, *moe_w2, *moe_b2, *ple_w_proj, *ple_w_gate;
    float* out;
    bf16_t *wb_ab_in, *wb_ab_out, *wb_c_in, *wb_c_out, *wb_w1, *wb_w2, *wb_g, *wb_p;
    bf16_t *xb, *pb;
    float* pp;
    float* rope;
    bf16_t *q16, *k16, *vT16, *o;
    float* ksum;
    unsigned* kmax2;
    int* mb_cnt;
    int* mb_list;
    float* mb_part;
    float* mb_l;
    float *ypre, *x1;
    bf16_t* x1b;
    bf16_t *act, *oslot;
    float* x2;
    bf16_t* x2b;
    float* x3;
    bf16_t *qi, *ki;
    float* wi;
    unsigned* bm;
    int *cnt, *tok_of, *sel_e, *sel_pos;
    float* sel_g;
    float* dbg;
    unsigned* bar;
};

__device__ __forceinline__ int zz_unit(int r, int b, int G) { return (r & 1) ? (r * G + (G - 1 - b)) : (r * G + b); }

__device__ __forceinline__ int w1map(int n) {
    const int is_up = n & 1, j = n >> 1, tile = j >> 7, jj = j & 127, wc = jj >> 5, jl = jj & 31;
    return tile * 256 + wc * 64 + is_up * 32 + jl;
}

__device__ __forceinline__ void conv_job(const float* __restrict__ src, bf16_t* __restrict__ dst, int K, int N, int dst_rows, int mode, int batch) {
    const int tid = otid(), lane = tid & 63, wid = tid >> 6, kg = lane & 7, ng = lane >> 3;
    const int tkn = K / 64, tnn = dst_rows / 32, per = tkn * tnn, total = per * batch;
    const int stride = gridDim.x * NWAVE;
    int u = blockIdx.x * NWAVE + wid;
    if (u >= total) return;
    f32x4 v[8], w[8];
    auto coords = [&](int uu, const float*& S, bf16_t*& D, int& k0, int& n) {
        const int bt = uu / per, r = uu % per, tn = r / tkn, tk = r % tkn;
        S = src + (size_t)bt * K * N; D = dst + (size_t)bt * dst_rows * K; k0 = tk * 64 + 8 * kg; n = tn * 32 + 4 * ng;
    };
    auto load = [&](f32x4 (&x)[8], const float* S, int k0, int n) {
#pragma unroll
        for (int j = 0; j < 8; ++j) { x[j] = (f32x4){0.f, 0.f, 0.f, 0.f}; if (n < N) x[j] = *(const f32x4*)(S + (size_t)(k0 + j) * N + n); }
    };
    auto store = [&](const f32x4 (&x)[8], bf16_t* D, int k0, int n) {
#pragma unroll
        for (int i = 0; i < 4; ++i) {
            const int drow = (mode == 1) ? w1map(n + i) : (n + i);
            *(u32x4*)(D + (size_t)drow * K + k0) = (u32x4){pack2(x[0][i], x[1][i]), pack2(x[2][i], x[3][i]), pack2(x[4][i], x[5][i]), pack2(x[6][i], x[7][i])};
        }
    };
    const float* S0; bf16_t* D0; int k00, n0;
    coords(u, S0, D0, k00, n0);
    load(v, S0, k00, n0);
#pragma unroll 1
    for (;;) {
        const int u1 = u + stride;
        const float* S1 = S0; bf16_t* D1 = D0; int k01 = k00, n1 = n0;
        if (u1 < total) { coords(u1, S1, D1, k01, n1); load(w, S1, k01, n1); }
        store(v, D0, k00, n0);
        if (u1 >= total) break;
        const int u2 = u1 + stride;
        if (u2 < total) { coords(u2, S0, D0, k00, n0); load(v, S0, k00, n0); }
        store(w, D1, k01, n1);
        if (u2 >= total) break;
        u = u2;
    }
}

__device__ __forceinline__ void phase_convert(const P& p, char* lds) {
    conv_job(p.ab_w_in, p.wb_ab_in, 1024, 3072, 3072, 0, 1);
    conv_job(p.ab_w_out, p.wb_ab_out, 1024, 1024, 1024, 0, 1);
    conv_job(p.c_w_in, p.wb_c_in, 1024, C_IN_, C_INP, 0, 1);
    conv_job(p.c_w_out, p.wb_c_out, 1024, 1024, 1024, 0, 1);
    conv_job(p.moe_w1, p.wb_w1, 1024, 2048, 2048, 1, 64);
    conv_job(p.moe_w2, p.wb_w2, 1024, 1024, 1024, 0, 64);
    conv_job(p.ple_w_gate, p.wb_g, 1024, 1024, 1024, 0, 2);
    conv_job(p.ple_w_proj, p.wb_p, 256, 1024, 1024, 0, 2);
    const size_t gtid = (size_t)blockIdx.x * NTHR + otid(), gsz = (size_t)gridDim.x * NTHR;
    for (size_t i = gtid; i < (size_t)T_ * DM / 4; i += gsz) {
        const f32x4 v = *(const f32x4*)(p.x + 4 * i);
        *(uint2*)(p.xb + 4 * i) = make_uint2(pack2(v[0], v[1]), pack2(v[2], v[3]));
    }
    for (size_t i = gtid; i < (size_t)2 * T_ * 256 / 4; i += gsz) {
        const f32x4 v = *(const f32x4*)(p.p + 4 * i);
        *(uint2*)(p.pb + 4 * i) = make_uint2(pack2(v[0], v[1]), pack2(v[2], v[3]));
    }
    for (size_t i = gtid; i < (size_t)T_ * 32; i += gsz) {
        const int pos = (int)(i >> 5), k = (int)(i & 31);
        const double inv = exp2(-(double)k * (13.287712379549449 / 32.0));
        const double ang = (double)pos * inv;
        const double red = ang - 6.283185307179586 * floor(ang * 0.15915494309189535);
        float sn_, cs_;
        sincosf((float)red, &sn_, &cs_);
        p.rope[2 * i] = cs_;
        p.rope[2 * i + 1] = sn_;
    }
    for (size_t i = gtid; i < 8 * 64 * 64; i += gsz) p.ksum[i] = 0.f;
    if (blockIdx.x == 0 && otid() < 64) p.cnt[otid()] = 0;
    if (blockIdx.x == 0 && otid() < 32) p.kmax2[otid()] = 0u;
    if (blockIdx.x == 1) p.mb_cnt[otid()] = 0;
}

#define G_TILE_B 32768
#define G_STAGE_B 65536
#define G_LDS_B 131072
__device__ __forceinline__ int g_lds_byte(int r, int c) {
    const int st = (r >> 4) * 2 + (c >> 5), ob = (r & 15) * 64 + (c & 31) * 2;
    return st * 1024 + (ob ^ (((ob >> 9) & 1) << 5));
}
__device__ __forceinline__ void g_stage_rc(int b, int& R, int& C) {
    const int st = b >> 10, sb = b & 1023, swz = sb ^ (((sb >> 9) & 1) << 5);
    R = (st >> 1) * 16 + swz / 64;
    C = (st & 1) * 32 + (swz % 64) / 2;
}
__device__ __forceinline__ int xcd_remap(int l, int C) {
    const int chunk = (C + 7) >> 3, j = l >> 3, x = l & 7, ul = x * chunk + j;
    return (j < chunk && ul < C) ? ul : -1;
}
struct RoundUnits {
    int total;
    __device__ __forceinline__ int operator()(int k) const {
        const int G = gridDim.x, C = total - k * G;
        if (C <= 0) return -1;
        const int ul = xcd_remap(blockIdx.x, C < G ? C : G);
        return ul < 0 ? -1 : k * G + ul;
    }
};
#define G8_LAS __attribute__((address_space(3)))
#define G8_HTB 16384
struct AOff { unsigned o[2][2]; };

__device__ __forceinline__ void g8_rc(int i, int& R, int& C) { g_stage_rc(otid() * 16 + i * 8192, R, C); }
__device__ __forceinline__ AOff g8_dense_a(int row0, int ld) {
    AOff a; int R, C;
#pragma unroll
    for (int i = 0; i < 2; ++i) {
        g8_rc(i, R, C);
        a.o[0][i] = (unsigned)(((size_t)(row0 + R) * ld + C) * 2);
        a.o[1][i] = (unsigned)(((size_t)(row0 + 128 + R) * ld + C) * 2);
    }
    return a;
}

struct NoHalf { __device__ __forceinline__ bool operator()(int) const { return false; } };
template <bool TR, class UnitFn, class AFn, class BFn, class EpiFn, class HalfFn = NoHalf>
__device__ __forceinline__ void gemm8_units(UnitFn unit_of, int K, char* lds_, const bf16_t* Abase, AFn aoff_of, BFn bbase_of, EpiFn epi, HalfFn half_of = HalfFn()) {
    G8_LAS unsigned char* lds = (G8_LAS unsigned char*)lds_;
    const int tid = otid(), wid = __builtin_amdgcn_readfirstlane(tid >> 6), lane = tid & 63, wr = wid >> 2, wc = wid & 3, fr = lane & 15, fq = lane >> 4;
    const int nt = K / 64;
    int cur = unit_of(0);
    if (cur < 0) return;
    unsigned voffB[2];
#pragma unroll
    for (int i = 0; i < 2; ++i) { int R, C; g8_rc(i, R, C); voffB[i] = (unsigned)(((64 * (R >> 5) + (R & 31)) * K + C) * 2); }
    const size_t kstep = 128;
    const size_t hstepB = (size_t)32 * K * 2;
    const unsigned ldsw = (unsigned)wid * 1024u;
    const int aoffl = g_lds_byte(wr * 64 + fr, fq * 8), boffl = g_lds_byte(wc * 32 + fr, fq * 8);
#define G8_SA(b, h) (((b) * 2 + (h)) * G8_HTB)
#define G8_SB(b, h) ((4 + (b) * 2 + (h)) * G8_HTB)
#define G8_STAGE_A(bufoff, AO, h, kb) do { _Pragma("unroll") for (int _i = 0; _i < 2; ++_i) \
        __builtin_amdgcn_global_load_lds((const unsigned*)((const char*)Abase + (kb) + (AO).o[h][_i]), (G8_LAS unsigned*)(lds + (bufoff) + ldsw + _i * 8192), 16, 0, 0); } while (0)
#define G8_STAGE_B(bufoff, gbase) do { _Pragma("unroll") for (int _i = 0; _i < 2; ++_i) \
        __builtin_amdgcn_global_load_lds((const unsigned*)((const char*)(gbase) + voffB[_i]), (G8_LAS unsigned*)(lds + (bufoff) + ldsw + _i * 8192), 16, 0, 0); } while (0)
#define G8_LDA(dst, b, h) do { _Pragma("unroll") for (int m = 0; m < 4; ++m) _Pragma("unroll") for (int k = 0; k < 2; ++k) dst[m][k] = *(const G8_LAS bf16x8*)(lds + G8_SA(b, h) + aoffl + m * 2048 + k * 1024); } while (0)
#define G8_LDB(dst, b, h) do { _Pragma("unroll") for (int n = 0; n < 2; ++n) _Pragma("unroll") for (int k = 0; k < 2; ++k) dst[n][k] = *(const G8_LAS bf16x8*)(lds + G8_SB(b, h) + boffl + n * 2048 + k * 1024); } while (0)
#define G8_MMA(ai, bj, At_, Bt_) do { __builtin_amdgcn_s_setprio(1); _Pragma("unroll") for (int m = 0; m < 4; ++m) _Pragma("unroll") for (int n = 0; n < 2; ++n) _Pragma("unroll") for (int k = 0; k < 2; ++k) \
        acc[ai][bj][m][n] = TR ? __builtin_amdgcn_mfma_f32_16x16x32_bf16(Bt_[n][k], At_[m][k], acc[ai][bj][m][n], 0, 0, 0) \
                               : __builtin_amdgcn_mfma_f32_16x16x32_bf16(At_[m][k], Bt_[n][k], acc[ai][bj][m][n], 0, 0, 0); __builtin_amdgcn_s_setprio(0); } while (0)
#define G8_WAIT_V(n) asm volatile("s_waitcnt vmcnt(" #n ")" ::: "memory")
#define G8_WAIT_L(n) asm volatile("s_waitcnt lgkmcnt(" #n ")" ::: "memory")
#define G8_BAR __builtin_amdgcn_s_barrier()
#define G8_SCHED __builtin_amdgcn_sched_barrier(0)
    f32x4 acc[2][2][4][2];
#pragma unroll
    for (int a = 0; a < 2; ++a)
#pragma unroll
        for (int b = 0; b < 2; ++b)
#pragma unroll
            for (int m = 0; m < 4; ++m)
#pragma unroll
                for (int n = 0; n < 2; ++n) acc[a][b][m][n] = (f32x4){0.f, 0.f, 0.f, 0.f};
    bf16x8 At[4][2], B0[2][2], B1[2][2];
    AOff cA = aoff_of(cur), nA = cA;
    const char* cB = (const char*)bbase_of(cur);
    __syncthreads();
    G8_STAGE_B(G8_SB(0, 0), cB); G8_STAGE_A(G8_SA(0, 0), cA, 0, 0); G8_STAGE_B(G8_SB(0, 1), cB + hstepB); G8_STAGE_A(G8_SA(0, 1), cA, 1, 0);
    if (wr == 1) G8_BAR;
    G8_WAIT_V(4); G8_BAR;
    G8_STAGE_B(G8_SB(1, 0), cB + kstep); G8_STAGE_A(G8_SA(1, 0), cA, 0, kstep); G8_STAGE_B(G8_SB(1, 1), cB + hstepB + kstep);
    G8_WAIT_V(6); G8_BAR;
    for (int ui = 0;; ++ui) {
        const int nxt = unit_of(ui + 1);
        const bool has_next = nxt >= 0;
        const char* nB = cB;
        if (has_next) { nA = aoff_of(nxt); nB = (const char*)bbase_of(nxt); } else nA = cA;
        for (int t = 0; t < nt; t += 2) {
            const bool last = (t == nt - 2);
            const size_t k1 = (size_t)(t + 1) * kstep;
            AOff a2;
#pragma unroll
            for (int hh = 0; hh < 2; ++hh)
#pragma unroll
                for (int i = 0; i < 2; ++i) a2.o[hh][i] = last ? nA.o[hh][i] : cA.o[hh][i];
            const size_t k2 = last ? 0 : (size_t)(t + 2) * kstep, k3 = k2 + kstep;
            const char* b2 = last ? nB : cB + (size_t)(t + 2) * kstep;
            const char* b3 = b2 + kstep;
            G8_LDB(B0, 0, 0); G8_SCHED; G8_LDA(At, 0, 0); G8_STAGE_A(G8_SA(1, 1), cA, 1, k1);
            G8_WAIT_L(8); G8_BAR; G8_WAIT_L(0); G8_MMA(0, 0, At, B0); G8_BAR; G8_SCHED;
            G8_LDB(B1, 0, 1); G8_STAGE_B(G8_SB(0, 0), b2);
            G8_BAR; G8_WAIT_L(0); G8_MMA(0, 1, At, B1); G8_BAR;
            G8_LDA(At, 0, 1); G8_STAGE_A(G8_SA(0, 0), a2, 0, k2);
            G8_BAR; G8_WAIT_L(0); G8_MMA(1, 0, At, B0); G8_BAR; G8_SCHED;
            G8_STAGE_B(G8_SB(0, 1), b2 + hstepB);
            G8_WAIT_V(6); G8_BAR; G8_MMA(1, 1, At, B1); G8_BAR;
            G8_LDB(B0, 1, 0); G8_SCHED; G8_LDA(At, 1, 0); G8_STAGE_A(G8_SA(0, 1), a2, 1, k2);
            G8_WAIT_L(8); G8_BAR; G8_WAIT_L(0); G8_MMA(0, 0, At, B0); G8_BAR; G8_SCHED;
            G8_LDB(B1, 1, 1); G8_STAGE_B(G8_SB(1, 0), b3);
            G8_BAR; G8_WAIT_L(0); G8_MMA(0, 1, At, B1); G8_BAR;
            G8_LDA(At, 1, 1); G8_STAGE_A(G8_SA(1, 0), a2, 0, k3);
            G8_BAR; G8_WAIT_L(0); G8_MMA(1, 0, At, B0); G8_BAR; G8_SCHED;
            G8_STAGE_B(G8_SB(1, 1), b3 + hstepB);
            G8_WAIT_V(6); G8_BAR; G8_MMA(1, 1, At, B1); G8_BAR;
        }
        epi(cur, acc, wr, wc, fr, fq);
        if (!has_next) break;
#pragma unroll
        for (int a = 0; a < 2; ++a)
#pragma unroll
            for (int b = 0; b < 2; ++b)
#pragma unroll
                for (int m = 0; m < 4; ++m)
#pragma unroll
                    for (int n = 0; n < 2; ++n) acc[a][b][m][n] = (f32x4){0.f, 0.f, 0.f, 0.f};
        cur = nxt; cA = nA; cB = nB;
    }
    G8_WAIT_V(0);
    if (wr == 0) G8_BAR;
    G8_BAR;
#undef G8_SA
#undef G8_SB
#undef G8_STAGE_A
#undef G8_STAGE_B
#undef G8_LDA
#undef G8_LDB
#undef G8_MMA
#undef G8_WAIT_V
#undef G8_WAIT_L
#undef G8_BAR
#undef G8_SCHED
}
typedef f32x4 Acc8[2][2][4][2];
__device__ __forceinline__ void phase_pp(const P& p, char* lds) {
    gemm8_units<true>(RoundUnits{2 * 64 * 4}, 256, lds, p.pb,
        [&](int t) { const int l = t >> 8, mt = (t & 255) >> 2; return g8_dense_a(l * T_ + mt * 256, 256); },
        [&](int t) { const int l = t >> 8, nt = t & 3; return p.wb_p + ((size_t)l * 1024 + nt * 256) * 256; },
        [&](int t, Acc8& acc, int wr, int wc, int fr, int fq) {
            const int l = t >> 8, mt = (t & 255) >> 2, nt = t & 3;
            float* O = p.pp + (size_t)l * T_ * DM;
#pragma unroll
            for (int ai = 0; ai < 2; ++ai)
#pragma unroll
                for (int m = 0; m < 4; ++m)
#pragma unroll
                    for (int bj = 0; bj < 2; ++bj)
#pragma unroll
                        for (int n = 0; n < 2; ++n) {
                            const int tok = mt * 256 + 128 * ai + 64 * wr + 16 * m + fr, col = nt * 256 + 64 * wc + 32 * bj + 16 * n + 4 * fq;
                            *(f32x4*)(O + (size_t)tok * DM + col) = acc[ai][bj][m][n];
                        }
        });
}

template <bool ROPE>
__device__ __forceinline__ void epi_rows(const P& p, bf16_t* dst, int stride, Acc8& acc, int tok0, int wr, int fr, int fq, float scale) {
#pragma unroll
    for (int ai = 0; ai < 2; ++ai)
#pragma unroll
        for (int m = 0; m < 4; ++m) {
            const int tok = tok0 + 128 * ai + 64 * wr + 16 * m + fr;
            if (ROPE) {
#pragma unroll
                for (int n = 0; n < 2; ++n) {
                    const float* rt = p.rope + ((size_t)tok * 32 + n * 16 + 4 * fq) * 2;
                    const f32x4 cs0 = *(const f32x4*)rt, cs1 = *(const f32x4*)(rt + 4);
                    const float c[4] = {cs0[0], cs0[2], cs1[0], cs1[2]}, sn[4] = {cs0[1], cs0[3], cs1[1], cs1[3]};
#pragma unroll
                    for (int j = 0; j < 4; ++j) {
                        const float x1 = acc[ai][0][m][n][j], x2 = acc[ai][1][m][n][j];
                        acc[ai][0][m][n][j] = x1 * c[j] - x2 * sn[j];
                        acc[ai][1][m][n][j] = x2 * c[j] + x1 * sn[j];
                    }
                }
            }
#pragma unroll
            for (int bj = 0; bj < 2; ++bj)
#pragma unroll
                for (int n = 0; n < 2; ++n) {
                    const f32x4 v = acc[ai][bj][m][n] * scale;
                    *(uint2*)(dst + (size_t)tok * stride + 32 * bj + 16 * n + 4 * fq) = make_uint2(pack2(v[0], v[1]), pack2(v[2], v[3]));
                }
            __builtin_amdgcn_sched_barrier(0);
        }
}
template <bool KSUM>
__device__ __forceinline__ void epi_key(const P& p, bf16_t* dst, Acc8& acc, int tok0, int wr, int fr, int fq, unsigned* kmax2, float* ks) {
    f32x4 sum[2][2];
#pragma unroll
    for (int bj = 0; bj < 2; ++bj)
#pragma unroll
        for (int n = 0; n < 2; ++n) sum[bj][n] = (f32x4){0.f, 0.f, 0.f, 0.f};
    float mx = 0.f;
#pragma unroll
    for (int ai = 0; ai < 2; ++ai)
#pragma unroll
        for (int m = 0; m < 4; ++m) {
            const int tok = tok0 + 128 * ai + 64 * wr + 16 * m + fr;
#pragma unroll
            for (int n = 0; n < 2; ++n) {
                const float* rt = p.rope + ((size_t)tok * 32 + n * 16 + 4 * fq) * 2;
                const f32x4 cs0 = *(const f32x4*)rt, cs1 = *(const f32x4*)(rt + 4);
                const float c[4] = {cs0[0], cs0[2], cs1[0], cs1[2]}, sn[4] = {cs0[1], cs0[3], cs1[1], cs1[3]};
#pragma unroll
                for (int j = 0; j < 4; ++j) {
                    const float x1 = acc[ai][0][m][n][j], x2 = acc[ai][1][m][n][j];
                    acc[ai][0][m][n][j] = x1 * c[j] - x2 * sn[j];
                    acc[ai][1][m][n][j] = x2 * c[j] + x1 * sn[j];
                }
            }
            float ss = 0.f;
#pragma unroll
            for (int bj = 0; bj < 2; ++bj)
#pragma unroll
                for (int n = 0; n < 2; ++n) {
                    const f32x4 a = acc[ai][bj][m][n];
                    const unsigned w0 = pack2(a[0], a[1]), w1 = pack2(a[2], a[3]);
                    *(uint2*)(dst + (size_t)tok * 64 + 32 * bj + 16 * n + 4 * fq) = make_uint2(w0, w1);
                    const float e0 = __uint_as_float(w0 << 16), e1 = __uint_as_float(w0 & 0xffff0000u), e2 = __uint_as_float(w1 << 16), e3 = __uint_as_float(w1 & 0xffff0000u);
                    ss += (e0 * e0 + e1 * e1) + (e2 * e2 + e3 * e3);
                    if (KSUM) sum[bj][n] = sum[bj][n] + a;
                }
            ss += __shfl_xor(ss, 16);
            ss += __shfl_xor(ss, 32);
            mx = fmaxf(mx, ss);
            __builtin_amdgcn_sched_barrier(0);
        }
#pragma unroll
    for (int o = 8; o > 0; o >>= 1) mx = fmaxf(mx, __shfl_xor(mx, o));
    if ((otid() & 63) == 0) atomicMax(kmax2, __float_as_uint(mx));
    if (KSUM) {
#pragma unroll
        for (int bj = 0; bj < 2; ++bj)
#pragma unroll
            for (int n = 0; n < 2; ++n) {
                f32x4 sv = sum[bj][n];
#pragma unroll
                for (int o = 1; o < 16; o <<= 1) { sv[0] += __shfl_xor(sv[0], o); sv[1] += __shfl_xor(sv[1], o); sv[2] += __shfl_xor(sv[2], o); sv[3] += __shfl_xor(sv[3], o); }
                if (fr == 0) {
#pragma unroll
                    for (int j = 0; j < 4; ++j) atomicAdd(ks + 32 * bj + 16 * n + 4 * fq + j, sv[j]);
                }
            }
    }
}
__device__ __forceinline__ void epi_vT(bf16_t* dst  , Acc8& acc, int tok0, int wr, int fr, int fq) {
#pragma unroll
    for (int ai = 0; ai < 2; ++ai)
#pragma unroll
        for (int m = 0; m < 4; ++m)
#pragma unroll
            for (int bj = 0; bj < 2; ++bj)
#pragma unroll
                for (int n = 0; n < 2; ++n) {
                    const f32x4 v = acc[ai][bj][m][n];
                    *(uint2*)(dst + (size_t)(32 * bj + 16 * n + fr) * T_ + tok0 + 128 * ai + 64 * wr + 16 * m + 4 * fq) = make_uint2(pack2(v[0], v[1]), pack2(v[2], v[3]));
                }
}

template <bool TR, class NtFn, class EpiFn>
__device__ __forceinline__ void typed_loop(const P& p, char* lds, const bf16_t* W, int& base, int count, NtFn ntile_of, EpiFn epi) {
    const int G = gridDim.x, bidx = blockIdx.x, b0 = base;
    const int l = (((bidx - b0) % G) + G) % G;
    const int ul = l < count ? xcd_remap(l, count) : -1;
    gemm8_units<TR>([&](int k) { return (k == 0 && ul >= 0) ? ul : -1; }, DM, lds, p.xb,
        [&](int t) { int mt, nt; ntile_of(t, mt, nt); return g8_dense_a(mt * 256, DM); },
        [&](int t) { int mt, nt; ntile_of(t, mt, nt); return W + (size_t)nt * 256 * DM; },
        [&](int t, Acc8& acc, int wr, int wc, int fr, int fq) { int mt, nt; ntile_of(t, mt, nt); epi(acc, mt, nt, mt * 256, wr, wc, fr, fq); });
    base += count;
}

template <int LAYER>
__device__ __forceinline__ void phase_inproj(const P& p, char* lds) {
    int base = 0;
    if (LAYER == 0) {
        const bf16_t* W = p.wb_ab_in;
        typed_loop<true>(p, lds, W, base, 128, [](int i, int& mt, int& nt) { mt = i >> 1; nt = i & 1; },
            [&](Acc8& acc, int mt, int nt, int tok0, int wr, int wc, int fr, int fq) {
                epi_rows<false>(p, p.q16 + (size_t)(nt * 4 + wc) * T_ * 64, 64, acc, tok0, wr, fr, fq, 0.125f); });
        typed_loop<true>(p, lds, W, base, 128, [](int i, int& mt, int& nt) { mt = i >> 1; nt = 2 + (i & 1); },
            [&](Acc8& acc, int mt, int nt, int tok0, int wr, int wc, int fr, int fq) {
                epi_rows<false>(p, p.k16 + (size_t)((nt - 2) * 4 + wc) * T_ * 64, 64, acc, tok0, wr, fr, fq, 1.0f); });
        typed_loop<false>(p, lds, W, base, 256, [](int i, int& mt, int& nt) { mt = i >> 2; const int vi = i & 3; nt = (vi < 2 ? 4 : 8) + vi; },
            [&](Acc8& acc, int mt, int nt, int tok0, int wr, int wc, int fr, int fq) {
                const int head = (nt < 6 ? 0 : 8) + (nt & 1) * 4 + wc;
                epi_vT(p.vT16 + (size_t)head * 64 * T_, acc, tok0, wr, fr, fq); });
        typed_loop<true>(p, lds, W, base, 128, [](int i, int& mt, int& nt) { mt = i >> 1; nt = 6 + (i & 1); },
            [&](Acc8& acc, int mt, int nt, int tok0, int wr, int wc, int fr, int fq) {
                epi_rows<true>(p, p.q16 + (size_t)(8 + (nt - 6) * 4 + wc) * T_ * 64, 64, acc, tok0, wr, fr, fq, 0.125f * LOG2E); });
        typed_loop<true>(p, lds, W, base, 128, [](int i, int& mt, int& nt) { mt = i >> 1; nt = 8 + (i & 1); },
            [&](Acc8& acc, int mt, int nt, int tok0, int wr, int wc, int fr, int fq) {
                const int hd = (nt - 8) * 4 + wc;
                epi_key<true>(p, p.k16 + (size_t)(8 + hd) * T_ * 64, acc, tok0, wr, fr, fq, p.kmax2 + 8 + hd, p.ksum + ((size_t)hd * 64 + mt) * 64); });
    } else {
        const bf16_t* W = p.wb_c_in;
        typed_loop<true>(p, lds, W, base, 256, [](int i, int& mt, int& nt) { mt = i >> 2; nt = i & 3; },
            [&](Acc8& acc, int mt, int nt, int tok0, int wr, int wc, int fr, int fq) {
                epi_rows<true>(p, p.q16 + (size_t)(nt * 4 + wc) * T_ * 64, 64, acc, tok0, wr, fr, fq, 0.125f * LOG2E); });
        typed_loop<true>(p, lds, W, base, 256, [](int i, int& mt, int& nt) { mt = i >> 2; nt = 4 + (i & 3); },
            [&](Acc8& acc, int mt, int nt, int tok0, int wr, int wc, int fr, int fq) {
                const int hd = (nt - 4) * 4 + wc;
                epi_key<false>(p, p.k16 + (size_t)hd * T_ * 64, acc, tok0, wr, fr, fq, p.kmax2 + 16 + hd, nullptr); });
        typed_loop<false>(p, lds, W, base, 256, [](int i, int& mt, int& nt) { mt = i >> 2; nt = 8 + (i & 3); },
            [&](Acc8& acc, int mt, int nt, int tok0, int wr, int wc, int fr, int fq) {
                epi_vT(p.vT16 + (size_t)((nt - 8) * 4 + wc) * 64 * T_, acc, tok0, wr, fr, fq); });
        typed_loop<true>(p, lds, W, base, 128, [](int i, int& mt, int& nt) { mt = i >> 1; nt = 12 + (i & 1); },
            [&](Acc8& acc, int mt, int nt, int tok0, int wr, int wc, int fr, int fq) {
                const int hd = (nt - 12) * 4 + wc;
                epi_rows<true>(p, p.qi + (size_t)hd * 64, 512, acc, tok0, wr, fr, fq, 0.125f); });
        typed_loop<true>(p, lds, W, base, 64, [](int i, int& mt, int& nt) { mt = i; nt = 14; },
            [&](Acc8& acc, int mt, int nt, int tok0, int wr, int wc, int fr, int fq) {
                if (wc == 0) {
                    epi_rows<true>(p, p.ki, 64, acc, tok0, wr, fr, fq, 1.0f);
                } else if (wc == 1 && fq < 2) {
#pragma unroll
                    for (int ai = 0; ai < 2; ++ai)
#pragma unroll
                        for (int m = 0; m < 4; ++m)
                            *(f32x4*)(p.wi + (size_t)(tok0 + 128 * ai + 64 * wr + 16 * m + fr) * 8 + 4 * fq) = acc[ai][0][m][0] * 0.35355339059327373f;
                } });
    }
}
__device__ __forceinline__ void phase_outproj(const P& p, const bf16_t* W, const float* xres, char* lds) {
    gemm8_units<true>(RoundUnits{64 * 4}, DM, lds, p.o,
        [&](int t) { return g8_dense_a((t >> 2) * 256, DM); },
        [&](int t) { return W + (size_t)(t & 3) * 256 * DM; },
        [&](int t, Acc8& acc, int wr, int wc, int fr, int fq) {
            const int mt = t >> 2, nt = t & 3;
#pragma unroll
            for (int ai = 0; ai < 2; ++ai)
#pragma unroll
                for (int m = 0; m < 4; ++m)
#pragma unroll
                    for (int bj = 0; bj < 2; ++bj)
#pragma unroll
                        for (int n = 0; n < 2; ++n) {
                            const size_t off = (size_t)(mt * 256 + 128 * ai + 64 * wr + 16 * m + fr) * DM + nt * 256 + 64 * wc + 32 * bj + 16 * n + 4 * fq;
                            const f32x4 xr = *(const f32x4*)(xres + off);
                            *(f32x4*)(p.ypre + off) = xr * DN_ALPHA + acc[ai][bj][m][n];
                        }
        });
}

__device__ __forceinline__ void ln_row(f32x4 (&v)[4], const float* g, const float* b, int lane) {
    float s = 0.f;
#pragma unroll
    for (int c = 0; c < 4; ++c) s += (v[c][0] + v[c][1]) + (v[c][2] + v[c][3]);
    const float mu = wave_sum(s) * (1.0f / DM);
    float q = 0.f;
#pragma unroll
    for (int c = 0; c < 4; ++c) {
        v[c] = v[c] - mu;
        q += (v[c][0] * v[c][0] + v[c][1] * v[c][1]) + (v[c][2] * v[c][2] + v[c][3] * v[c][3]);
    }
    const float rstd = 1.0f / sqrtf(wave_sum(q) * (1.0f / DM) + 1e-5f);
#pragma unroll
    for (int c = 0; c < 4; ++c) {
        const f32x4 gg = *(const f32x4*)(g + 4 * lane + 256 * c), bb = *(const f32x4*)(b + 4 * lane + 256 * c);
        v[c] = v[c] * rstd * gg + bb;
    }
}

#define RT_XS_STRIDE 1025
#define RT_RED_OFF (32 * RT_XS_STRIDE * 4)
#define RT_DEC_OFF (RT_RED_OFF + 16384)
__device__ __forceinline__ void phase_ln_router(const P& p, int layer, char* lds) {
    const int tid = otid(), lane = tid & 63, wid = tid >> 6;
    float* xs = (float*)lds;
    float* red = (float*)(lds + RT_RED_OFF);
    int* dec = (int*)(lds + RT_DEC_OFF);
    float* decg = (float*)(lds + RT_DEC_OFF + 1024);
    int* lcnt = (int*)(lds + RT_DEC_OFF + 2048);
    int* gbase = lcnt + 32;
    const float* g = p.ln_g + (size_t)(layer * 2 + 0) * DM;
    const float* b = p.ln_b + (size_t)(layer * 2 + 0) * DM;
    const float* wr_ = p.router_w + (size_t)layer * DM * NEXP;
    const float* br_ = p.router_b + layer * NEXP;
    int* cnt = p.cnt + layer * NEXP;
#pragma unroll 1
    for (int itb = 0; (blockIdx.x + itb * gridDim.x) * 32 < T_; itb += 2) {
    __syncthreads();
    if (tid < 32) lcnt[tid] = 0;
#pragma unroll 1
    for (int it = 0; it < 2; ++it) {
        const int t0 = (blockIdx.x + (itb + it) * gridDim.x) * 32;
        if (t0 >= T_) break;
#pragma unroll 1
        for (int r = 0; r < 4; ++r) {
            const int tl_ = wid * 4 + r, tok = t0 + tl_;
            f32x4 v[4];
#pragma unroll
            for (int c = 0; c < 4; ++c) v[c] = *(const f32x4*)(p.ypre + (size_t)tok * DM + 4 * lane + 256 * c);
            ln_row(v, g, b, lane);
#pragma unroll
            for (int c = 0; c < 4; ++c) {
                *(f32x4*)(p.x1 + (size_t)tok * DM + 4 * lane + 256 * c) = v[c];
                *(uint2*)(p.x1b + (size_t)tok * DM + 4 * lane + 256 * c) = make_uint2(pack2(v[c][0], v[c][1]), pack2(v[c][2], v[c][3]));
                float* xr = xs + tl_ * RT_XS_STRIDE + 4 * lane + 256 * c;
                xr[0] = v[c][0]; xr[1] = v[c][1]; xr[2] = v[c][2]; xr[3] = v[c][3];
            }
        }
        __syncthreads();
        f32x16 d;
#pragma unroll
        for (int i = 0; i < 16; ++i) d[i] = 0.f;
        {
            const int i_ = lane & 31, kk = lane >> 5;
            const float* xa = xs + i_ * RT_XS_STRIDE + wid * 128 + kk;
            const float* wb = wr_ + (size_t)(wid * 128 + kk) * NEXP + i_;
#pragma unroll 8
            for (int s = 0; s < 64; ++s) d = __builtin_amdgcn_mfma_f32_32x32x2f32(xa[2 * s], wb[(size_t)(2 * s) * NEXP], d, 0, 0, 0);
        }
#pragma unroll
        for (int step = 4; step >= 1; step >>= 1) {
            if (wid >= step && wid < 2 * step) {
                float* rb = red + (wid - step) * 1024;
#pragma unroll
                for (int i = 0; i < 16; ++i) rb[i * 64 + lane] = d[i];
            }
            __syncthreads();
            if (wid < step) {
                const float* rb = red + wid * 1024;
#pragma unroll
                for (int i = 0; i < 16; ++i) d[i] += rb[i * 64 + lane];
            }
            __syncthreads();
        }
        if (wid == 0) {
#pragma unroll
            for (int i = 0; i < 16; ++i) red[((i & 3) + 8 * (i >> 2) + 4 * (lane >> 5)) * 32 + (lane & 31)] = d[i];
        }
        __syncthreads();
#pragma unroll
        for (int r = 0; r < 2; ++r) {
            const int e = lane & 31, hf = lane >> 5, tl_ = wid * 4 + 2 * r + hf;
            float cur = red[tl_ * 32 + e] + br_[e];
            float tv[4]; int ti[4];
#pragma unroll
            for (int k = 0; k < 4; ++k) {
                float mv = cur;
#pragma unroll
                for (int o = 16; o > 0; o >>= 1) mv = fmaxf(mv, __shfl_xor(mv, o));
                const unsigned long long bal = __ballot(cur == mv);
                const unsigned bh = hf ? (unsigned)(bal >> 32) : (unsigned)bal;
                const int idx = __ffs(bh) - 1;
                tv[k] = mv; ti[k] = idx;
                if (e == idx) cur = -3.0e38f;
            }
            const float e1 = __expf(tv[1] - tv[0]), e2 = __expf(tv[2] - tv[0]), e3 = __expf(tv[3] - tv[0]);
            const float inv = 1.0f / (1.0f + e1 + e2 + e3);
            if (e < 4) {
                const int ee = e == 0 ? ti[0] : e == 1 ? ti[1] : e == 2 ? ti[2] : ti[3];
                const float gg = e == 0 ? inv : e == 1 ? e1 * inv : e == 2 ? e2 * inv : e3 * inv;
                const int lpos = atomicAdd(lcnt + ee, 1);
                dec[(it * 32 + tl_) * 4 + e] = ee | (lpos << 8);
                decg[(it * 32 + tl_) * 4 + e] = gg;
            }
        }
        __syncthreads();
    }
    if (tid < 32) gbase[tid] = lcnt[tid] > 0 ? atomicAdd(cnt + tid, lcnt[tid]) : 0;
    __syncthreads();
    if (tid < 256) {
        const int it = tid >> 7, t0 = (blockIdx.x + (itb + it) * gridDim.x) * 32;
        if (t0 < T_) {
            const int tok = t0 + ((tid >> 2) & 31), k = tid & 3;
            const int dv = dec[tid], ee = dv & 255, pos = gbase[ee] + (dv >> 8);
            p.tok_of[(size_t)ee * T_ + pos] = tok;
            p.sel_e[tok * 4 + k] = ee;
            p.sel_pos[tok * 4 + k] = pos;
            p.sel_g[tok * 4 + k] = decg[tid];
        }
    }
    }
    __syncthreads();
}

__device__ __forceinline__ void moe_prefix(const int* cnt, int* mpre) {
    if (otid() == 0) {
        int s = 0;
        for (int e = 0; e < NEXP; ++e) { mpre[e] = s; s += (cnt[e] + 255) >> 8; }
        mpre[NEXP] = s;
    }
    __syncthreads();
}
#define MPRE_OFF G_LDS_B

__device__ __forceinline__ void phase_moe1(const P& p, int layer, char* lds) {
    int* mpre = (int*)(lds + MPRE_OFF);
    const int* cnt = p.cnt + layer * NEXP;
    moe_prefix(cnt, mpre);
    const int total = mpre[NEXP] * 8;
    auto expert_of = [&](int mg) { int e = 0;
#pragma unroll 1
        while (mpre[e + 1] <= mg) ++e;
        return e; };
    gemm8_units<true>(RoundUnits{total}, DM, lds, p.x1b,
        [&](int t) {
            const int mg = t >> 3, e = expert_of(mg), i = mg - mpre[e], ce_ = cnt[e];
            const int* tk = p.tok_of + (size_t)e * T_;
            AOff a; int R, C;
#pragma unroll
            for (int ii = 0; ii < 2; ++ii) {
                g8_rc(ii, R, C);
                const int p0 = i * 256 + R, p1 = p0 + 128;
                a.o[0][ii] = (unsigned)(((size_t)tk[p0 < ce_ ? p0 : 0] * DM + C) * 2);
                a.o[1][ii] = (unsigned)(((size_t)tk[p1 < ce_ ? p1 : 0] * DM + C) * 2);
            }
            return a;
        },
        [&](int t) { const int mg = t >> 3, nt = t & 7, e = expert_of(mg); return p.wb_w1 + ((size_t)(layer * NEXP + e) * 2048 + nt * 256) * DM; },
        [&](int t, Acc8& acc, int wr, int wc, int fr, int fq) {
            const int mg = t >> 3, nt = t & 7, e = expert_of(mg);
            const float* b1 = p.moe_b1 + (size_t)(layer * NEXP + e) * 2048;
#pragma unroll
            for (int n = 0; n < 2; ++n) {
                const int j0 = nt * 128 + wc * 32 + n * 16 + 4 * fq;
                float bg[4], bu[4];
#pragma unroll
                for (int j = 0; j < 4; ++j) { bg[j] = b1[2 * (j0 + j)]; bu[j] = b1[2 * (j0 + j) + 1]; }
#pragma unroll
                for (int ai = 0; ai < 2; ++ai)
#pragma unroll
                    for (int m = 0; m < 4; ++m) {
                        float r[4];
#pragma unroll
                        for (int j = 0; j < 4; ++j) {
                            const float gv = fminf(acc[ai][0][m][n][j] + bg[j], 7.0f);
                            const float uv = fminf(fmaxf(acc[ai][1][m][n][j] + bu[j], -7.0f), 7.0f);
                            const float glu = gv * sigmoidf_(1.702f * gv);
                            r[j] = (uv + 1.0f) * glu;
                        }
                        const size_t slot = (size_t)mg * 256 + 128 * ai + 64 * wr + 16 * m + fr;
                        *(uint2*)(p.act + slot * DM + j0) = make_uint2(pack2(r[0], r[1]), pack2(r[2], r[3]));
                    }
            }
        },
        [&](int t) { const int mg = t >> 3, e = expert_of(mg); return cnt[e] - (mg - mpre[e]) * 256 <= 128; });
}

__device__ __forceinline__ void phase_moe2(const P& p, int layer, char* lds) {
    int* mpre = (int*)(lds + MPRE_OFF);
    const int* cnt = p.cnt + layer * NEXP;
    moe_prefix(cnt, mpre);
    const int total = mpre[NEXP] * 4;
    auto expert_of = [&](int mg) { int e = 0;
#pragma unroll 1
        while (mpre[e + 1] <= mg) ++e;
        return e; };
    gemm8_units<true>(RoundUnits{total}, DM, lds, p.act,
        [&](int t) { return g8_dense_a((t >> 2) * 256, DM); },
        [&](int t) { const int mg = t >> 2, nt = t & 3, e = expert_of(mg); return p.wb_w2 + ((size_t)(layer * NEXP + e) * 1024 + nt * 256) * DM; },
        [&](int t, Acc8& acc, int wr, int wc, int fr, int fq) {
            const int mg = t >> 2, nt = t & 3, e = expert_of(mg);
            const float* b2 = p.moe_b2 + (size_t)(layer * NEXP + e) * DM;
#pragma unroll
            for (int ai = 0; ai < 2; ++ai)
#pragma unroll
                for (int m = 0; m < 4; ++m)
#pragma unroll
                    for (int bj = 0; bj < 2; ++bj)
#pragma unroll
                        for (int n = 0; n < 2; ++n) {
                            const int col = nt * 256 + 64 * wc + 32 * bj + 16 * n + 4 * fq;
                            const f32x4 v = acc[ai][bj][m][n] + *(const f32x4*)(b2 + col);
                            const size_t slot = (size_t)mg * 256 + 128 * ai + 64 * wr + 16 * m + fr;
                            *(uint2*)(p.oslot + slot * DM + col) = make_uint2(pack2(v[0], v[1]), pack2(v[2], v[3]));
                        }
        },
        [&](int t) { const int mg = t >> 2, e = expert_of(mg); return cnt[e] - (mg - mpre[e]) * 256 <= 128; });
}

__device__ __forceinline__ void phase_combine_ln(const P& p, int layer, char* lds) {
    const int tid = otid(), lane = tid & 63, wid = tid >> 6;
    int* mpre = (int*)(lds + MPRE_OFF);
    moe_prefix(p.cnt + layer * NEXP, mpre);
    const float* g = p.ln_g + (size_t)(layer * 2 + 1) * DM;
    const float* b = p.ln_b + (size_t)(layer * 2 + 1) * DM;
#pragma unroll 1
    for (int tok = blockIdx.x * NWAVE + wid; tok < T_; tok += gridDim.x * NWAVE) {
        f32x4 v[4];
#pragma unroll
        for (int c = 0; c < 4; ++c) v[c] = *(const f32x4*)(p.x1 + (size_t)tok * DM + 4 * lane + 256 * c) * DN_ALPHA;
        f32x4 f[4];
#pragma unroll
        for (int c = 0; c < 4; ++c) f[c] = (f32x4){0.f, 0.f, 0.f, 0.f};
#pragma unroll
        for (int k = 0; k < 4; ++k) {
            const int e = p.sel_e[tok * 4 + k], pos = p.sel_pos[tok * 4 + k];
            const float gt = p.sel_g[tok * 4 + k];
            const bf16_t* row = p.oslot + ((size_t)mpre[e] * 256 + pos) * DM;
#pragma unroll
            for (int c = 0; c < 4; ++c) {
                const uint2 w = *(const uint2*)(row + 4 * lane + 256 * c);
                f[c][0] += gt * __uint_as_float(w.x << 16);
                f[c][1] += gt * __uint_as_float(w.x & 0xffff0000u);
                f[c][2] += gt * __uint_as_float(w.y << 16);
                f[c][3] += gt * __uint_as_float(w.y & 0xffff0000u);
            }
        }
#pragma unroll
        for (int c = 0; c < 4; ++c) v[c] = v[c] + f[c];
        ln_row(v, g, b, lane);
#pragma unroll
        for (int c = 0; c < 4; ++c) {
            *(f32x4*)(p.x2 + (size_t)tok * DM + 4 * lane + 256 * c) = v[c];
            *(uint2*)(p.x2b + (size_t)tok * DM + 4 * lane + 256 * c) = make_uint2(pack2(v[c][0], v[c][1]), pack2(v[c][2], v[c][3]));
        }
    }
}

__device__ __forceinline__ void phase_ple(const P& p, int layer, float* xout, char* lds) {
    const float* pp = p.pp + (size_t)layer * T_ * DM;
    gemm8_units<true>(RoundUnits{64 * 4}, DM, lds, p.x2b,
        [&](int t) { return g8_dense_a((t >> 2) * 256, DM); },
        [&](int t) { return p.wb_g + (size_t)layer * DM * DM + (size_t)(t & 3) * 256 * DM; },
        [&](int t, Acc8& acc, int wr, int wc, int fr, int fq) {
            const int mt = t >> 2, nt = t & 3;
#pragma unroll
            for (int ai = 0; ai < 2; ++ai)
#pragma unroll
                for (int m = 0; m < 4; ++m)
#pragma unroll
                    for (int bj = 0; bj < 2; ++bj)
#pragma unroll
                        for (int n = 0; n < 2; ++n) {
                            const size_t off = (size_t)(mt * 256 + 128 * ai + 64 * wr + 16 * m + fr) * DM + nt * 256 + 64 * wc + 32 * bj + 16 * n + 4 * fq;
                            const f32x4 x2v = *(const f32x4*)(p.x2 + off), ppv = *(const f32x4*)(pp + off);
                            f32x4 r;
#pragma unroll
                            for (int j = 0; j < 4; ++j) r[j] = x2v[j] + sigmoidf_(acc[ai][bj][m][n][j]) * ppv[j];
                            *(f32x4*)(xout + off) = r;
                            *(uint2*)(p.xb + off) = make_uint2(pack2(r[0], r[1]), pack2(r[2], r[3]));
                        }
        });
}
#define KROW 144
#define VROW 136
#define KTILE_B (64 * KROW)
#define VTILE_B (64 * VROW)
#define ABUF_B (KTILE_B + VTILE_B)

struct TileRegs { u32x4 k0, v0; };

__device__ __forceinline__ void tile_gload(TileRegs& r, const bf16_t* kbase  , const bf16_t* vtbase  , int k0) {
    const int ci = otid(), row = ci >> 3, cc = ci & 7;
    r.k0 = *(const u32x4*)(kbase + (size_t)(k0 + row) * 64 + cc * 8);
    r.v0 = *(const u32x4*)(vtbase + (size_t)row * T_ + k0 + cc * 8);
}
__device__ __forceinline__ void tile_swrite(const TileRegs& r, char* buf) {
    const int ci = otid(), row = ci >> 3, cc = ci & 7;
    *(u32x4*)(buf + row * KROW + cc * 16) = r.k0;
    *(uint2*)(buf + KTILE_B + row * VROW + cc * 16) = make_uint2(r.v0[0], r.v0[1]);
    *(uint2*)(buf + KTILE_B + row * VROW + cc * 16 + 8) = make_uint2(r.v0[2], r.v0[3]);
}

__device__ __forceinline__ void load_qfrag(bf16x8 (&qf)[4], const bf16_t* qrow  , int h) {
#pragma unroll
    for (int kk = 0; kk < 4; ++kk) qf[kk] = *(const bf16x8*)(qrow + 16 * kk + 8 * h);
}
__device__ __forceinline__ float qnorm2(const bf16x8 (&qf)[4]) {
    float s = 0.f;
#pragma unroll
    for (int kk = 0; kk < 4; ++kk)
#pragma unroll
        for (int j = 0; j < 8; ++j) { const float e = bf2f((bf16_t)qf[kk][j]); s += e * e; }
    return s + __shfl_xor(s, 32);
}

__device__ __forceinline__ f32x16 qk_subtile(const char* kbuf, int t2, const bf16x8 (&qf)[4], int c, int h) {
    f32x16 s;
#pragma unroll
    for (int i = 0; i < 16; ++i) s[i] = 0.f;
#pragma unroll
    for (int kk = 0; kk < 4; ++kk) {
        const bf16x8 kf = *(const bf16x8*)(kbuf + (32 * t2 + c) * KROW + (16 * kk + 8 * h) * 2);
        s = __builtin_amdgcn_mfma_f32_32x32x16_bf16(kf, qf[kk], s, 0, 0, 0);
    }
    return s;
}

__device__ __forceinline__ void pv_subtile(const char* vbuf, int t2, const float (&pr)[16], f32x16 (&o)[2], int c, int h) {
#pragma unroll
    for (int s = 0; s < 2; ++s) {
        u32x4 pbu;
#pragma unroll
        for (int j = 0; j < 4; ++j) pbu[j] = pack2(pr[8 * s + 2 * j], pr[8 * s + 2 * j + 1]);
        const bf16x8 pbv = __builtin_bit_cast(bf16x8, pbu);
#pragma unroll
        for (int dt = 0; dt < 2; ++dt) {
            const char* a = vbuf + (32 * dt + c) * VROW + (32 * t2 + 16 * s + 4 * h) * 2;
            const uint2 lo = *(const uint2*)a, hi = *(const uint2*)(a + 16);
            const u32x4 vfu = {lo.x, lo.y, hi.x, hi.y};
            o[dt] = __builtin_amdgcn_mfma_f32_32x32x16_bf16(__builtin_bit_cast(bf16x8, vfu), pbv, o[dt], 0, 0, 0);
        }
    }
}

__device__ __forceinline__ void store_o(bf16_t* orow  , const f32x16 (&o)[2], int h, float scale) {
#pragma unroll
    for (int dt = 0; dt < 2; ++dt)
#pragma unroll
        for (int g = 0; g < 4; ++g) {
            const int d = 32 * dt + 8 * g + 4 * h;
            *(uint2*)(orow + d) = make_uint2(pack2(o[dt][4 * g] * scale, o[dt][4 * g + 1] * scale), pack2(o[dt][4 * g + 2] * scale, o[dt][4 * g + 3] * scale));
        }
}

#define SB_STOP 32.0f
__device__ __forceinline__ void phase_sb(const P& p, char* lds) {
    const int tid = otid(), lane = tid & 63, w = tid >> 6, c = lane & 31, h = lane >> 5;
#pragma unroll 1
    for (int t = blockIdx.x; t < 8 * 64; t += gridDim.x) {
        const int head = t & 7, qb = 63 - (t >> 3);
        const int q0 = qb * 256, qw = q0 + 32 * w, query = qw + c;
        const bf16_t* kbase = p.k16 + (size_t)head * T_ * 64;
        const bf16_t* vtbase = p.vT16 + (size_t)head * 64 * T_;
        bf16x8 qf[4];
        load_qfrag(qf, p.q16 + ((size_t)head * T_ + query) * 64, h);
        f32x16 o[2];
#pragma unroll
        for (int i = 0; i < 16; ++i) { o[0][i] = 0.f; o[1][i] = 0.f; }
        float R = 0.f;
        int kt = (q0 + 255) >> 6;
        TileRegs tr;
        tile_gload(tr, kbase, vtbase, kt * 64);
        __syncthreads();
        tile_swrite(tr, lds);
        __syncthreads();
        int buf = 0;
#pragma unroll 1
        for (;;) {
            const bool more = kt > 0;
            if (more) tile_gload(tr, kbase, vtbase, (kt - 1) * 64);
            const char* kb = lds + buf * ABUF_B;
            const char* vb = kb + KTILE_B;
            const int k0 = kt * 64;
#pragma unroll
            for (int t2 = 1; t2 >= 0; --t2) {
                const int keybase = k0 + 32 * t2;
                if (keybase < qw + 31) {
                    const f32x16 s = qk_subtile(kb, t2, qf, c, h);
                    const bool need_mask = keybase + 31 >= qw;
                    float L[16], E[16];
#pragma unroll
                    for (int r = 0; r < 16; ++r) {
                        const float z2 = s[r] * LOG2E;
                        const int zb = __float_as_int(z2);
                        float l = __int_as_float(zb > 0 ? zb : 0) + flog2(1.0f + fexp2(-fabsf(z2)));
                        const int key = keybase + (r & 3) + 8 * (r >> 2) + 4 * h;
                        const bool valid = !need_mask || key < query;
                        l = valid ? l : 0.f;
                        L[r] = l;
                        E[r] = valid ? (z2 - l) : -1.0e30f;
                    }
                    float gs[4], tot[4], ps[4];
#pragma unroll
                    for (int g = 0; g < 4; ++g) {
                        gs[g] = (L[4 * g] + L[4 * g + 1]) + (L[4 * g + 2] + L[4 * g + 3]);
                        ps[g] = __shfl_xor(gs[g], 32);
                        tot[g] = gs[g] + ps[g];
                    }
                    float above[4];
                    above[3] = (h == 0 ? ps[3] : 0.f);
                    above[2] = tot[3] + (h == 0 ? ps[2] : 0.f);
                    above[1] = tot[3] + tot[2] + (h == 0 ? ps[1] : 0.f);
                    above[0] = tot[3] + tot[2] + tot[1] + (h == 0 ? ps[0] : 0.f);
                    float pr[16];
#pragma unroll
                    for (int g = 0; g < 4; ++g) {
                        float run = R + above[g];
#pragma unroll
                        for (int i = 3; i >= 0; --i) {
                            pr[4 * g + i] = fexp2(E[4 * g + i] - run);
                            run += L[4 * g + i];
                        }
                    }
                    R += (tot[0] + tot[1]) + (tot[2] + tot[3]);
                    pv_subtile(vb, t2, pr, o, c, h);
                }
            }
            const int done = __syncthreads_and(R > SB_STOP);
            if (!more || done) break;
            tile_swrite(tr, lds + (buf ^ 1) * ABUF_B);
            __syncthreads();
            buf ^= 1;
            --kt;
        }
        store_o(p.o + (size_t)query * DM + head * 64, o, h, 1.0f);
    }
}

__device__ __forceinline__ void softmax_subtile(const f32x16& s, unsigned W, float M2, float& l, f32x16 (&o)[2], const char* vb, int t2, int c, int h) {
    const unsigned Wh = W >> (4 * h);
    float pr[16];
    float ls = 0.f;
#pragma unroll
    for (int r = 0; r < 16; ++r) {
        const bool ok = (Wh >> ((r & 3) + 8 * (r >> 2))) & 1u;
        const float pv = ok ? fexp2(s[r] * LOG2E - M2) : 0.f;
        pr[r] = pv;
        ls += pv;
    }
    l += ls;
    pv_subtile(vb, t2, pr, o, c, h);
}

__device__ __forceinline__ unsigned causal_word(int query, int keybase) {
    const int nk = query - keybase + 1;
    return nk >= 32 ? 0xffffffffu : (nk <= 0 ? 0u : ((1u << nk) - 1u));
}
__device__ __forceinline__ float shift_bound_l2(float qn2, unsigned kmax2_bits) {
    return fminf(sqrtf(qn2 * __uint_as_float(kmax2_bits)) * 1.002f, 64.0f);
}
__device__ __forceinline__ float shift_bound(float qn2, unsigned kmax2_bits) {
    const float b = sqrtf(qn2 * __uint_as_float(kmax2_bits)) * (LOG2E * 1.002f);
    return fminf(b, 64.0f);
}

__device__ __forceinline__ void attn_tile64(const char* kb, const char* vb, const bf16x8 (&qf)[4], unsigned W0, unsigned W1, float M2, float& l, f32x16 (&o)[2], int c, int h) {
    bf16x8 k0[4], k1[4];
#pragma unroll
    for (int kk = 0; kk < 4; ++kk) {
        k0[kk] = *(const bf16x8*)(kb + c * KROW + (16 * kk + 8 * h) * 2);
        k1[kk] = *(const bf16x8*)(kb + (32 + c) * KROW + (16 * kk + 8 * h) * 2);
    }
    const unsigned Wh0 = W0 >> (4 * h), Wh1 = W1 >> (4 * h);
    f32x16 s0, s1;
#pragma unroll
    for (int r = 0; r < 16; ++r) {
        const int bit = (r & 3) + 8 * (r >> 2);
        s0[r] = ((Wh0 >> bit) & 1u) ? -M2 : -1.0e30f;
        s1[r] = ((Wh1 >> bit) & 1u) ? -M2 : -1.0e30f;
    }
#pragma unroll
    for (int kk = 0; kk < 4; ++kk) {
        s0 = __builtin_amdgcn_mfma_f32_32x32x16_bf16(k0[kk], qf[kk], s0, 0, 0, 0);
        s1 = __builtin_amdgcn_mfma_f32_32x32x16_bf16(k1[kk], qf[kk], s1, 0, 0, 0);
    }
    u32x4 vf[2][2][2];
#pragma unroll
    for (int t2 = 0; t2 < 2; ++t2)
#pragma unroll
        for (int sI = 0; sI < 2; ++sI)
#pragma unroll
            for (int dt = 0; dt < 2; ++dt) {
                const char* a = vb + (32 * dt + c) * VROW + (32 * t2 + 16 * sI + 4 * h) * 2;
                const uint2 lo = *(const uint2*)a, hi = *(const uint2*)(a + 16);
                vf[t2][sI][dt] = (u32x4){lo.x, lo.y, hi.x, hi.y};
            }
    u32x4 pb[2][2];
    f32v2_ ls2 = {0.f, 0.f};
#pragma unroll
    for (int sI = 0; sI < 2; ++sI) {
        f32v2_ pa[4], pc[4];
#pragma unroll
        for (int j = 0; j < 4; ++j) {
            const int r = 8 * sI + 2 * j;
            pa[j][0] = fexp2(s0[r]); pa[j][1] = fexp2(s0[r + 1]);
            pc[j][0] = fexp2(s1[r]); pc[j][1] = fexp2(s1[r + 1]);
            ls2 = ls2 + pa[j] + pc[j];
        }
        pb[0][sI] = (u32x4){pack2(pa[0][0], pa[0][1]), pack2(pa[1][0], pa[1][1]), pack2(pa[2][0], pa[2][1]), pack2(pa[3][0], pa[3][1])};
        pb[1][sI] = (u32x4){pack2(pc[0][0], pc[0][1]), pack2(pc[1][0], pc[1][1]), pack2(pc[2][0], pc[2][1]), pack2(pc[3][0], pc[3][1])};
    }
    l += ls2[0] + ls2[1];
#pragma unroll
    for (int t2 = 0; t2 < 2; ++t2)
#pragma unroll
        for (int sI = 0; sI < 2; ++sI)
#pragma unroll
            for (int dt = 0; dt < 2; ++dt)
                o[dt] = __builtin_amdgcn_mfma_f32_32x32x16_bf16(__builtin_bit_cast(bf16x8, vf[t2][sI][dt]), __builtin_bit_cast(bf16x8, pb[t2][sI]), o[dt], 0, 0, 0);
}

__device__ __forceinline__ void phase_moba_gate(const P& p, char* lds) {
    const int tid = otid(), lane = tid & 63, w = tid >> 6, c = lane & 31, h = lane >> 5;
#pragma unroll 1
    for (int t = blockIdx.x; t < 8 * 63; t += gridDim.x) {
        const int head = t & 7, cur = 63 - (t >> 3);
        const int query = cur * 256 + 32 * w + c;
        bf16x8 qf[4];
        load_qfrag(qf, p.q16 + ((size_t)(8 + head) * T_ + query) * 64, h);
        int sel0 = -1, sel1 = -1, sel2 = -1;
        __syncthreads();
        if (tid < 64) ((int*)(lds + 16384))[tid] = 0;
        {
            const int row = tid >> 3, cc = tid & 7;
            const float* ks = p.ksum + ((size_t)head * 64 + row) * 64 + cc * 8;
            const f32x4 a = *(const f32x4*)ks * (1.0f / 256.0f), b = *(const f32x4*)(ks + 4) * (1.0f / 256.0f);
            *(u32x4*)(lds + row * KROW + cc * 16) = (u32x4){pack2(a[0], a[1]), pack2(a[2], a[3]), pack2(b[0], b[1]), pack2(b[2], b[3])};
        }
        __syncthreads();
        float v0 = -3.0e38f, v1 = -3.0e38f, v2 = -3.0e38f;
#pragma unroll
        for (int t2 = 0; t2 < 2; ++t2) {
            const f32x16 s = qk_subtile(lds, t2, qf, c, h);
#pragma unroll
            for (int r = 0; r < 16; ++r) {
                const int n = 32 * t2 + (r & 3) + 8 * (r >> 2) + 4 * h;
                const float g = s[r];
                if (n < cur) {
                    if (g > v0) { v2 = v1; sel2 = sel1; v1 = v0; sel1 = sel0; v0 = g; sel0 = n; }
                    else if (g > v1) { v2 = v1; sel2 = sel1; v1 = g; sel1 = n; }
                    else if (g > v2) { v2 = g; sel2 = n; }
                }
            }
        }
        const float pv0 = __shfl_xor(v0, 32), pv1 = __shfl_xor(v1, 32), pv2 = __shfl_xor(v2, 32);
        const int pn0 = __shfl_xor(sel0, 32), pn1 = __shfl_xor(sel1, 32), pn2 = __shfl_xor(sel2, 32);
#pragma unroll
        for (int k = 0; k < 3; ++k) {
            const float g = k == 0 ? pv0 : (k == 1 ? pv1 : pv2);
            const int n = k == 0 ? pn0 : (k == 1 ? pn1 : pn2);
            if (n >= 0) {
                if (g > v0 || (g == v0 && n < sel0)) { v2 = v1; sel2 = sel1; v1 = v0; sel1 = sel0; v0 = g; sel0 = n; }
                else if (g > v1 || (g == v1 && n < sel1)) { v2 = v1; sel2 = sel1; v1 = g; sel1 = n; }
                else if (g > v2 || (g == v2 && n < sel2)) { v2 = g; sel2 = n; }
            }
        }
        int* lc = (int*)(lds + 16384);
        int* gb = lc + 64;
        int lp0 = 0, lp1 = 0, lp2 = 0;
        if (h == 0) {
            if (sel0 >= 0) lp0 = atomicAdd(lc + sel0, 1);
            if (sel1 >= 0) lp1 = atomicAdd(lc + sel1, 1);
            if (sel2 >= 0) lp2 = atomicAdd(lc + sel2, 1);
        }
        __syncthreads();
        if (tid < 64) gb[tid] = lc[tid] > 0 ? atomicAdd(p.mb_cnt + head * 64 + tid, lc[tid]) : 0;
        __syncthreads();
        if (h == 0) {
            if (sel0 >= 0) p.mb_list[((size_t)head * 64 + sel0) * T_ + gb[sel0] + lp0] = (query << 2) | 0;
            if (sel1 >= 0) p.mb_list[((size_t)head * 64 + sel1) * T_ + gb[sel1] + lp1] = (query << 2) | 1;
            if (sel2 >= 0) p.mb_list[((size_t)head * 64 + sel2) * T_ + gb[sel2] + lp2] = (query << 2) | 2;
        }
    }
}

#define MB_PRE_OFF (2 * ABUF_B)
__device__ __forceinline__ void phase_moba_sparse(const P& p, char* lds) {
    const int tid = otid(), lane = tid & 63, w = tid >> 6, c = lane & 31, h = lane >> 5;
    int* pre = (int*)(lds + MB_PRE_OFF);
    __syncthreads();
    if (tid < 64) {
        int loc[8]; int s = 0;
#pragma unroll
        for (int i = 0; i < 8; ++i) { loc[i] = (p.mb_cnt[tid * 8 + i] + 255) >> 8; s += loc[i]; }
        int incl = s;
#pragma unroll
        for (int o = 1; o < 64; o <<= 1) { const int v = __shfl_up(incl, o); if (tid >= o) incl += v; }
        int run = incl - s;
#pragma unroll
        for (int i = 0; i < 8; ++i) { pre[tid * 8 + i] = run; run += loc[i]; }
        if (tid == 63) pre[512] = run;
    }
    __syncthreads();
    const int total = pre[512];
#pragma unroll 1
    for (int u = blockIdx.x; u < total; u += gridDim.x) {
        int lo = 0, hi = 512;
#pragma unroll 1
        while (hi - lo > 1) { const int mid = (lo + hi) >> 1; if (pre[mid] <= u) lo = mid; else hi = mid; }
        const int li = lo, chunk = u - pre[li], head = li >> 6, n = li & 63;
        const int cnt = p.mb_cnt[li], idx = chunk * 256 + 32 * w + c;
        const bool valid = idx < cnt;
        const int ent = p.mb_list[(size_t)li * T_ + (valid ? idx : 0)];
        const int query = ent >> 2, slot = ent & 3;
        const bf16_t* kbase = p.k16 + (size_t)(8 + head) * T_ * 64;
        const bf16_t* vtbase = p.vT16 + (size_t)(8 + head) * 64 * T_;
        bf16x8 qf[4];
        load_qfrag(qf, p.q16 + ((size_t)(8 + head) * T_ + query) * 64, h);
        const float M2 = shift_bound_l2(qnorm2(qf), p.kmax2[8 + head]);
        f32x16 o[2];
#pragma unroll
        for (int i = 0; i < 16; ++i) { o[0][i] = 0.f; o[1][i] = 0.f; }
        float l = 0.f;
        TileRegs tr;
        tile_gload(tr, kbase, vtbase, n * 256);
        __syncthreads();
        tile_swrite(tr, lds);
        __syncthreads();
#pragma unroll 1
        for (int kt = 0; kt < 4; ++kt) {
            if (kt < 3) tile_gload(tr, kbase, vtbase, n * 256 + (kt + 1) * 64);
            const char* kb = lds + (kt & 1) * ABUF_B;
            attn_tile64(kb, kb + KTILE_B, qf, 0xffffffffu, 0xffffffffu, M2, l, o, c, h);
            if (kt < 3) {
                tile_swrite(tr, lds + ((kt + 1) & 1) * ABUF_B);
                __syncthreads();
            }
        }
        l += __shfl_xor(l, 32);
        if (valid) {
            float* po = p.mb_part + (((size_t)head * T_ + query) * 3 + slot) * 64;
#pragma unroll
            for (int dt = 0; dt < 2; ++dt)
#pragma unroll
                for (int g = 0; g < 4; ++g) *(f32x4*)(po + 32 * dt + 8 * g + 4 * h) = (f32x4){o[dt][4 * g], o[dt][4 * g + 1], o[dt][4 * g + 2], o[dt][4 * g + 3]};
            if (h == 0) p.mb_l[((size_t)head * T_ + query) * 3 + slot] = l;
        }
    }
}

__device__ __forceinline__ void phase_moba_own(const P& p, char* lds) {
    const int tid = otid(), lane = tid & 63, w = tid >> 6, c = lane & 31, h = lane >> 5;
#pragma unroll 1
    for (int t = blockIdx.x; t < 8 * 64; t += gridDim.x) {
        const int head = t & 7, cur = t >> 3;
        const int q0 = cur * 256, qw = q0 + 32 * w, query = qw + c;
        const bf16_t* kbase = p.k16 + (size_t)(8 + head) * T_ * 64;
        const bf16_t* vtbase = p.vT16 + (size_t)(8 + head) * 64 * T_;
        bf16x8 qf[4];
        load_qfrag(qf, p.q16 + ((size_t)(8 + head) * T_ + query) * 64, h);
        const float M2 = shift_bound_l2(qnorm2(qf), p.kmax2[8 + head]);
        f32x16 o[2];
#pragma unroll
        for (int i = 0; i < 16; ++i) { o[0][i] = 0.f; o[1][i] = 0.f; }
        float l = 0.f;
        TileRegs tr;
        tile_gload(tr, kbase, vtbase, q0);
        __syncthreads();
        tile_swrite(tr, lds);
        __syncthreads();
#pragma unroll 1
        for (int kt = 0; kt < 4; ++kt) {
            if (kt < 3) tile_gload(tr, kbase, vtbase, q0 + (kt + 1) * 64);
            const char* kb = lds + (kt & 1) * ABUF_B;
            const int keybase = q0 + kt * 64;
            const unsigned W0 = causal_word(query, keybase), W1 = causal_word(query, keybase + 32);
            if (__ballot((W0 | W1) != 0u) != 0ull) attn_tile64(kb, kb + KTILE_B, qf, W0, W1, M2, l, o, c, h);
            if (kt < 3) {
                tile_swrite(tr, lds + ((kt + 1) & 1) * ABUF_B);
                __syncthreads();
            }
        }
        l += __shfl_xor(l, 32);
        const int nsel = cur < 3 ? cur : 3;
#pragma unroll 1
        for (int sI = 0; sI < nsel; ++sI) {
            const float* po = p.mb_part + (((size_t)head * T_ + query) * 3 + sI) * 64;
#pragma unroll
            for (int dt = 0; dt < 2; ++dt)
#pragma unroll
                for (int g = 0; g < 4; ++g) {
                    const f32x4 v = *(const f32x4*)(po + 32 * dt + 8 * g + 4 * h);
                    o[dt][4 * g] += v[0]; o[dt][4 * g + 1] += v[1]; o[dt][4 * g + 2] += v[2]; o[dt][4 * g + 3] += v[3];
                }
            l += p.mb_l[((size_t)head * T_ + query) * 3 + sI];
        }
        store_o(p.o + (size_t)query * DM + 512 + head * 64, o, h, 1.0f / l);
    }
}

__device__ __forceinline__ void attn_tile64_2h(const char* kbA, const char* vbA, const char* kbB, const char* vbB,
                                               const bf16x8 (&qA)[4], const bf16x8 (&qB)[4], unsigned W0, unsigned W1, float MA, float MB,
                                               float& lA, float& lB, f32x16 (&oA)[2], f32x16 (&oB)[2], int c, int h) {
    u32x4 pA[2][2], pB[2][2];
    float lsA = 0.f, lsB = 0.f;
#pragma unroll
    for (int t2 = 0; t2 < 2; ++t2) {
        const unsigned Wh = (t2 ? W1 : W0) >> (4 * h);
        bool ok[16];
#pragma unroll
        for (int r = 0; r < 16; ++r) ok[r] = (Wh >> ((r & 3) + 8 * (r >> 2))) & 1u;
#pragma unroll
        for (int hd = 0; hd < 2; ++hd) {
            const char* kb = hd ? kbB : kbA;
            bf16x8 kf[4];
#pragma unroll
            for (int kk = 0; kk < 4; ++kk) kf[kk] = *(const bf16x8*)(kb + (32 * t2 + c) * KROW + (16 * kk + 8 * h) * 2);
            const float Mx = hd ? MB : MA;
            f32x16 sv;
#pragma unroll
            for (int i = 0; i < 16; ++i) sv[i] = ok[i] ? -Mx : -1.0e30f;
#pragma unroll
            for (int kk = 0; kk < 4; ++kk) sv = __builtin_amdgcn_mfma_f32_32x32x16_bf16(kf[kk], hd ? qB[kk] : qA[kk], sv, 0, 0, 0);
            f32v2_ ls2 = {0.f, 0.f};
#pragma unroll
            for (int sI = 0; sI < 2; ++sI) {
                f32v2_ a2[4];
#pragma unroll
                for (int j = 0; j < 4; ++j) {
                    a2[j][0] = fexp2(sv[8 * sI + 2 * j]);
                    a2[j][1] = fexp2(sv[8 * sI + 2 * j + 1]);
                    ls2 = ls2 + a2[j];
                }
                const u32x4 pk = (u32x4){pack2(a2[0][0], a2[0][1]), pack2(a2[1][0], a2[1][1]), pack2(a2[2][0], a2[2][1]), pack2(a2[3][0], a2[3][1])};
                if (hd) pB[t2][sI] = pk; else pA[t2][sI] = pk;
            }
            if (hd) lsB += ls2[0] + ls2[1]; else lsA += ls2[0] + ls2[1];
        }
    }
    lA += lsA;
    lB += lsB;
#pragma unroll
    for (int hd = 0; hd < 2; ++hd) {
        const char* vb = hd ? vbB : vbA;
#pragma unroll
        for (int t2 = 0; t2 < 2; ++t2) {
            u32x4 vf[2][2];
#pragma unroll
            for (int sI = 0; sI < 2; ++sI)
#pragma unroll
                for (int dt = 0; dt < 2; ++dt) {
                    const char* a = vb + (32 * dt + c) * VROW + (32 * t2 + 16 * sI + 4 * h) * 2;
                    const uint2 lo = *(const uint2*)a, hi = *(const uint2*)(a + 16);
                    vf[sI][dt] = (u32x4){lo.x, lo.y, hi.x, hi.y};
                }
#pragma unroll
            for (int sI = 0; sI < 2; ++sI)
#pragma unroll
                for (int dt = 0; dt < 2; ++dt) {
                    if (hd == 0) oA[dt] = __builtin_amdgcn_mfma_f32_32x32x16_bf16(__builtin_bit_cast(bf16x8, vf[sI][dt]), __builtin_bit_cast(bf16x8, pA[t2][sI]), oA[dt], 0, 0, 0);
                    else oB[dt] = __builtin_amdgcn_mfma_f32_32x32x16_bf16(__builtin_bit_cast(bf16x8, vf[sI][dt]), __builtin_bit_cast(bf16x8, pB[t2][sI]), oB[dt], 0, 0, 0);
                }
        }
    }
}

__device__ __forceinline__ void phase_dsa(const P& p, char* lds) {
    const int tid = otid(), lane = tid & 63, w = tid >> 6, c = lane & 31, h = lane >> 5;
    const int G = gridDim.x;
#pragma unroll 1
    for (int r = 0; r * G < 8 * 64; ++r) {
        const int t = zz_unit(r, blockIdx.x, G);
        if (t >= 8 * 64) continue;
        const int hA = (t & 7) * 2, hB = hA + 1, qb = 63 - (t >> 3);
        const int q0 = qb * 256, qw = q0 + 32 * w, query = qw + c;
        const bf16_t* kbaseA = p.k16 + (size_t)hA * T_ * 64;
        const bf16_t* vtbaseA = p.vT16 + (size_t)hA * 64 * T_;
        const bf16_t* kbaseB = p.k16 + (size_t)hB * T_ * 64;
        const bf16_t* vtbaseB = p.vT16 + (size_t)hB * 64 * T_;
        bf16x8 qA[4], qB[4];
        load_qfrag(qA, p.q16 + ((size_t)hA * T_ + query) * 64, h);
        load_qfrag(qB, p.q16 + ((size_t)hB * T_ + query) * 64, h);
        const float MA = shift_bound_l2(qnorm2(qA), p.kmax2[16 + hA]), MB = shift_bound_l2(qnorm2(qB), p.kmax2[16 + hB]);
        f32x16 oA[2], oB[2];
#pragma unroll
        for (int i = 0; i < 16; ++i) { oA[0][i] = 0.f; oA[1][i] = 0.f; oB[0][i] = 0.f; oB[1][i] = 0.f; }
        float lA = 0.f, lB = 0.f;
        const int ktend = (q0 + 255) >> 6;
        TileRegs trA, trB;
        const unsigned* bmq = p.bm + query;
        unsigned W0 = bmq[0], W1 = bmq[(size_t)T_];
        tile_gload(trA, kbaseA, vtbaseA, 0);
        tile_gload(trB, kbaseB, vtbaseB, 0);
        __syncthreads();
        tile_swrite(trA, lds);
        tile_swrite(trB, lds + ABUF_B);
        __syncthreads();
        int buf = 0;
#pragma unroll 1
        for (int kt = 0; kt <= ktend; ++kt) {
            const bool more = kt < ktend;
            const int ktn = more ? kt + 1 : kt;
            const unsigned Wn0 = bmq[(size_t)(2 * ktn) * T_], Wn1 = bmq[(size_t)(2 * ktn + 1) * T_];
            tile_gload(trA, kbaseA, vtbaseA, ktn * 64);
            tile_gload(trB, kbaseB, vtbaseB, ktn * 64);
            const char* kb = lds + buf * (2 * ABUF_B);
            attn_tile64_2h(kb, kb + KTILE_B, kb + ABUF_B, kb + ABUF_B + KTILE_B, qA, qB, W0, W1, MA, MB, lA, lB, oA, oB, c, h);
            if (!more) break;
            tile_swrite(trA, lds + (buf ^ 1) * (2 * ABUF_B));
            tile_swrite(trB, lds + (buf ^ 1) * (2 * ABUF_B) + ABUF_B);
            __syncthreads();
            buf ^= 1;
            W0 = Wn0; W1 = Wn1;
        }
        lA += __shfl_xor(lA, 32);
        lB += __shfl_xor(lB, 32);
        store_o(p.o + (size_t)query * DM + hA * 64, oA, h, 1.0f / lA);
        store_o(p.o + (size_t)query * DM + hB * 64, oB, h, 1.0f / lB);
    }
}
#ifndef FORCE_SLOW
#define FORCE_SLOW 0
#endif
#define IDX_ROWS 32
#define IDX_HIST_B (IDX_ROWS * 4096)
#define IDX_INFO_OFF IDX_HIST_B
#define IDX_CAND_OFF (IDX_HIST_B + 1024)
#define IDX_CAP 16
#define IDX_LDS_B (IDX_CAND_OFF + IDX_ROWS * IDX_CAP * 8)
#define IDX_FCAP 256

__device__ __forceinline__ unsigned fkey(float s) {
    const unsigned u = __float_as_uint(s + 0.0f);
    return (u & 0x80000000u) ? ~u : (u | 0x80000000u);
}
__device__ __forceinline__ unsigned sbin(float s) {
    const unsigned u = __float_as_uint(s + 0.0f);
    int t = (int)((u & 0x7fffffffu) >> 17) - (115 << 6);
    t = t < 0 ? 0 : (t > 1023 ? 1023 : t);
    return (u >> 31) ? (unsigned)(1023 - t) : (unsigned)(1024 + t);
}

__device__ __forceinline__ void find_bin(const unsigned* hrow, int need, int lane, int& bin_out, int& above_out) {
    unsigned wv[16];
    const int wbase = 1008 - 16 * lane;
#pragma unroll
    for (int i = 0; i < 4; ++i) {
        const u32x4 q = *(const u32x4*)(hrow + wbase + 4 * i);
        wv[4 * i] = q[0]; wv[4 * i + 1] = q[1]; wv[4 * i + 2] = q[2]; wv[4 * i + 3] = q[3];
    }
    int tot = 0;
#pragma unroll
    for (int i = 0; i < 16; ++i) tot += (int)(wv[i] >> 16) + (int)(wv[i] & 0xffffu);
    int incl = tot;
#pragma unroll
    for (int o = 1; o < 64; o <<= 1) {
        const int v = __shfl_up(incl, o);
        if (lane >= o) incl += v;
    }
    const unsigned long long bal = __ballot(incl >= need);
    const int fl = __ffsll(bal) - 1;
    int b = 0, ab = 0;
    if (lane == fl) {
        int cum = incl - tot;
        bool found = false;
#pragma unroll
        for (int i = 15; i >= 0; --i) {
            const int hi = (int)(wv[i] >> 16), lo = (int)(wv[i] & 0xffffu);
            if (!found) { if (cum + hi >= need) { found = true; b = 2 * (wbase + i) + 1; ab = cum; } else cum += hi; }
            if (!found) { if (cum + lo >= need) { found = true; b = 2 * (wbase + i); ab = cum; } else cum += lo; }
        }
    }
    bin_out = __shfl(b, fl < 0 ? 0 : fl);
    above_out = __shfl(ab, fl < 0 ? 0 : fl);
}

struct IdxCtx {
    bf16x8 af[4];
    float wq[2][8];
    int qabs[2], qloc[2];
};

__device__ __forceinline__ void idx_setup(const P& p, IdxCtx& x, int q0, int w, int c, int h) {
    const int u = ((c >> 4) & 1) + 2 * ((c >> 2) & 1), hd = (c & 3) + 4 * ((c >> 3) & 1);
    const bf16_t* qp = p.qi + ((size_t)(q0 + 4 * w + u) * 8 + hd) * 64;
#pragma unroll
    for (int kk = 0; kk < 4; ++kk) x.af[kk] = *(const bf16x8*)(qp + 16 * kk + 8 * h);
#pragma unroll
    for (int uu = 0; uu < 2; ++uu) {
        x.qloc[uu] = 4 * w + 2 * h + uu;
        x.qabs[uu] = q0 + x.qloc[uu];
        const f32x4 a = *(const f32x4*)(p.wi + (size_t)x.qabs[uu] * 8), b = *(const f32x4*)(p.wi + (size_t)x.qabs[uu] * 8 + 4);
        x.wq[uu][0] = a[0]; x.wq[uu][1] = a[1]; x.wq[uu][2] = a[2]; x.wq[uu][3] = a[3];
        x.wq[uu][4] = b[0]; x.wq[uu][5] = b[1]; x.wq[uu][6] = b[2]; x.wq[uu][7] = b[3];
    }
}
__device__ __forceinline__ void idx_load(const P& p, bf16x8 (&bk)[4], int kt, int c, int h) {
    const bf16_t* kp = p.ki + (size_t)(32 * kt + c) * 64 + 8 * h;
#pragma unroll
    for (int kk = 0; kk < 4; ++kk) bk[kk] = *(const bf16x8*)(kp + 16 * kk);
}
__device__ __forceinline__ void idx_scores(const IdxCtx& x, const bf16x8 (&bk)[4], float& s0, float& s1) {
    f32x16 s;
#pragma unroll
    for (int i = 0; i < 16; ++i) s[i] = 0.f;
#pragma unroll
    for (int kk = 0; kk < 4; ++kk) s = __builtin_amdgcn_mfma_f32_32x32x16_bf16(x.af[kk], bk[kk], s, 0, 0, 0);
    float r[16];
#pragma unroll
    for (int i = 0; i < 16; ++i) r[i] = fmaxf(s[i], 0.f);
    const float e0 = __builtin_fmaf(x.wq[0][6], r[6], __builtin_fmaf(x.wq[0][4], r[4], __builtin_fmaf(x.wq[0][2], r[2], x.wq[0][0] * r[0])));
    const float o0 = __builtin_fmaf(x.wq[0][7], r[7], __builtin_fmaf(x.wq[0][5], r[5], __builtin_fmaf(x.wq[0][3], r[3], x.wq[0][1] * r[1])));
    const float e1 = __builtin_fmaf(x.wq[1][6], r[14], __builtin_fmaf(x.wq[1][4], r[12], __builtin_fmaf(x.wq[1][2], r[10], x.wq[1][0] * r[8])));
    const float o1 = __builtin_fmaf(x.wq[1][7], r[15], __builtin_fmaf(x.wq[1][5], r[13], __builtin_fmaf(x.wq[1][3], r[11], x.wq[1][1] * r[9])));
    s0 = e0 + o0;
    s1 = e1 + o1;
}

__device__ __forceinline__ float relu1(float v) { const int b = __float_as_int(v); return __int_as_float(b > 0 ? b : 0); }
__device__ __forceinline__ void idx_scores2(const IdxCtx& x, const bf16x8 (&bk0)[4], const bf16x8 (&bk1)[4], float& a0, float& a1, float& b0, float& b1) {
    f32x16 s, t;
#pragma unroll
    for (int i = 0; i < 16; ++i) { s[i] = 0.f; t[i] = 0.f; }
#pragma unroll
    for (int kk = 0; kk < 4; ++kk) {
        s = __builtin_amdgcn_mfma_f32_32x32x16_bf16(x.af[kk], bk0[kk], s, 0, 0, 0);
        t = __builtin_amdgcn_mfma_f32_32x32x16_bf16(x.af[kk], bk1[kk], t, 0, 0, 0);
    }
    float r[16], q[16];
#pragma unroll
    for (int i = 0; i < 16; ++i) { r[i] = relu1(s[i]); q[i] = relu1(t[i]); }
    {
        const float e0 = __builtin_fmaf(x.wq[0][6], r[6], __builtin_fmaf(x.wq[0][4], r[4], __builtin_fmaf(x.wq[0][2], r[2], x.wq[0][0] * r[0])));
        const float o0 = __builtin_fmaf(x.wq[0][7], r[7], __builtin_fmaf(x.wq[0][5], r[5], __builtin_fmaf(x.wq[0][3], r[3], x.wq[0][1] * r[1])));
        const float e1 = __builtin_fmaf(x.wq[1][6], r[14], __builtin_fmaf(x.wq[1][4], r[12], __builtin_fmaf(x.wq[1][2], r[10], x.wq[1][0] * r[8])));
        const float o1 = __builtin_fmaf(x.wq[1][7], r[15], __builtin_fmaf(x.wq[1][5], r[13], __builtin_fmaf(x.wq[1][3], r[11], x.wq[1][1] * r[9])));
        a0 = e0 + o0; a1 = e1 + o1;
    }
    {
        const float e0 = __builtin_fmaf(x.wq[0][6], q[6], __builtin_fmaf(x.wq[0][4], q[4], __builtin_fmaf(x.wq[0][2], q[2], x.wq[0][0] * q[0])));
        const float o0 = __builtin_fmaf(x.wq[0][7], q[7], __builtin_fmaf(x.wq[0][5], q[5], __builtin_fmaf(x.wq[0][3], q[3], x.wq[0][1] * q[1])));
        const float e1 = __builtin_fmaf(x.wq[1][6], q[14], __builtin_fmaf(x.wq[1][4], q[12], __builtin_fmaf(x.wq[1][2], q[10], x.wq[1][0] * q[8])));
        const float o1 = __builtin_fmaf(x.wq[1][7], q[15], __builtin_fmaf(x.wq[1][5], q[13], __builtin_fmaf(x.wq[1][3], q[11], x.wq[1][1] * q[9])));
        b0 = e0 + o0; b1 = e1 + o1;
    }
}

#define IDX_RING_OFF IDX_LDS_B
#define IDX_RING_TILE_B (64 * 144)
#define IDX_TOTAL_LDS_B (IDX_RING_OFF + 2 * IDX_RING_TILE_B)
template <class F>
__device__ __forceinline__ void idx_sweep(const P& p, const IdxCtx& x, int ntile, int c, int h, char* lds, F body) {
    const int tid = otid(), row = tid >> 3, cc = tid & 7;
    char* ring = lds + IDX_RING_OFF;
    const int nt64 = (ntile + 1) >> 1;
    const bf16_t* src = p.ki + (size_t)row * 64 + cc * 8;
    u32x4 reg = *(const u32x4*)src;
    __syncthreads();
    *(u32x4*)(ring + row * 144 + cc * 16) = reg;
    __syncthreads();
#pragma unroll 1
    for (int t = 0; t < nt64; ++t) {
        const bool more = t + 1 < nt64;
        if (more) reg = *(const u32x4*)(src + (size_t)(t + 1) * 64 * 64);
        const char* rb = ring + (t & 1) * IDX_RING_TILE_B;
        bf16x8 bk0[4], bk1[4];
#pragma unroll
        for (int kk = 0; kk < 4; ++kk) {
            bk0[kk] = *(const bf16x8*)(rb + c * 144 + 32 * kk + 16 * h);
            bk1[kk] = *(const bf16x8*)(rb + (32 + c) * 144 + 32 * kk + 16 * h);
        }
        __builtin_amdgcn_sched_barrier(0);
        float sa0, sa1, sb0, sb1;
        idx_scores2(x, bk0, bk1, sa0, sa1, sb0, sb1);
        body(2 * t, sa0, sa1);
        body(2 * t + 1, sb0, sb1);
        if (more) *(u32x4*)(ring + ((t + 1) & 1) * IDX_RING_TILE_B + row * 144 + cc * 16) = reg;
        __syncthreads();
    }
}

__device__ __forceinline__ void idx_unit_slow(const P& p, const IdxCtx& x, char* lds, int q0, int ntile, int tid, int lane, int w, int c, int h) {
    unsigned* hist = (unsigned*)lds;
    int* info = (int*)(lds + IDX_INFO_OFF);
    uint2* cand = (uint2*)(lds + IDX_CAND_OFF);
    __syncthreads();
    if (tid < IDX_ROWS) {
        const int nk = q0 + tid + 1;
        info[tid] = nk < 256 ? nk : 256;
        info[5 * IDX_ROWS + tid] = 0;
    }
#pragma unroll 1
    for (int pass = 0; pass < 3; ++pass) {
        for (int i = tid; i < IDX_HIST_B / 16; i += NTHR) ((u32x4*)hist)[i] = (u32x4){0u, 0u, 0u, 0u};
        __syncthreads();
        int pb1[2], pb2[2];
#pragma unroll
        for (int uu = 0; uu < 2; ++uu) { pb1[uu] = info[IDX_ROWS + x.qloc[uu]]; pb2[uu] = info[3 * IDX_ROWS + x.qloc[uu]]; }
        idx_sweep(p, x, ntile, c, h, lds, [&](int kt, float s0, float s1) {
            const int key = 32 * kt + c;
#pragma unroll
            for (int uu = 0; uu < 2; ++uu) {
                const bool valid = key <= x.qabs[uu];
                const unsigned ku = fkey(uu == 0 ? s0 : s1);
                if (pass == 0) {
                    if (valid) { const unsigned bin = ku >> 21; atomicAdd(hist + x.qloc[uu] * 1024 + (bin >> 1), 1u << (16 * (bin & 1))); }
                } else if (pass == 1) {
                    if (valid && (int)(ku >> 21) == pb1[uu]) { const unsigned bin = (ku >> 10) & 2047u; atomicAdd(hist + x.qloc[uu] * 1024 + (bin >> 1), 1u << (16 * (bin & 1))); }
                } else {
                    const bool sa = x.qabs[uu] < 256;
                    const unsigned pfx = ku >> 10, P22 = ((unsigned)pb1[uu] << 11) | (unsigned)pb2[uu];
                    const bool gt = valid && (sa || pfx > P22);
                    const bool eq = valid && !sa && pfx == P22;
                    const unsigned long long bal = __ballot(gt);
                    if (c == 0) hist[kt * IDX_ROWS + x.qloc[uu]] = h ? (unsigned)(bal >> 32) : (unsigned)bal;
                    if (eq) {
                        const int ix = atomicAdd(info + 5 * IDX_ROWS + x.qloc[uu], 1);
                        if (ix < IDX_CAP) cand[x.qloc[uu] * IDX_CAP + ix] = make_uint2(ku, (unsigned)key);
                    }
                }
            }
        });
        __syncthreads();
        if (pass < 2) {
#pragma unroll 1
            for (int rr = 0; rr < 4; ++rr) {
                const int row = 4 * w + rr;
                const int need = pass == 0 ? info[row] : info[2 * IDX_ROWS + row];
                int b, ab;
                find_bin(hist + row * 1024, need, lane, b, ab);
                if (lane == 0) {
                    if (pass == 0) { info[IDX_ROWS + row] = b; info[2 * IDX_ROWS + row] = need - ab; }
                    else { info[3 * IDX_ROWS + row] = b; info[4 * IDX_ROWS + row] = need - ab; }
                }
            }
            __syncthreads();
        }
    }
    if (tid < IDX_ROWS) {
        const int row = tid, n = info[5 * IDX_ROWS + row] < IDX_CAP ? info[5 * IDX_ROWS + row] : IDX_CAP, need2 = info[4 * IDX_ROWS + row];
        for (int i = 0; i < n; ++i) {
            const uint2 ci = cand[row * IDX_CAP + i];
            int rank = 0;
            for (int j = 0; j < n; ++j) {
                const uint2 cj = cand[row * IDX_CAP + j];
                rank += (cj.x > ci.x || (cj.x == ci.x && cj.y < ci.y)) ? 1 : 0;
            }
            if (rank < need2) hist[(ci.y >> 5) * IDX_ROWS + row] |= 1u << (ci.y & 31u);
        }
    }
    __syncthreads();
}

__device__ __forceinline__ void phase_indexer(const P& p, char* lds) {
    const int tid = otid(), lane = tid & 63, w = tid >> 6, c = lane & 31, h = lane >> 5;
    unsigned* hist = (unsigned*)lds;
    int* info = (int*)(lds + IDX_INFO_OFF);
    uint2* fcand = (uint2*)(lds + 65536);
#pragma unroll 1
    for (int rnd = 0; rnd * (int)gridDim.x < T_ / IDX_ROWS; ++rnd) {
        const int t = zz_unit(rnd, blockIdx.x, gridDim.x);
        if (t >= T_ / IDX_ROWS) continue;
        const int qblk = (T_ / IDX_ROWS - 1) - t;
        const int q0 = qblk * IDX_ROWS;
        IdxCtx x;
        idx_setup(p, x, q0, w, c, h);
        const int ntile = (q0 + IDX_ROWS - 1) / 32 + 1;
        const bool selall_blk = (q0 + IDX_ROWS) <= 256;
        __syncthreads();
        if (tid < IDX_ROWS) {
            const int nk = q0 + tid + 1;
            info[tid] = nk < 256 ? nk : 256;
            info[IDX_ROWS + tid] = 0;
            info[2 * IDX_ROWS + tid] = 0;
            info[5 * IDX_ROWS + tid] = 0;
        }
        const int Lrow = ((ntile + 1) >> 1) * 64;
        unsigned short* bins = (unsigned short*)p.act + (size_t)32 * 64 * ((qblk & 1) ? ((qblk >> 1) + 1) * ((qblk >> 1) + 1) : (qblk >> 1) * ((qblk >> 1) + 1));
        unsigned short* brow0 = bins + (size_t)x.qloc[0] * Lrow;
        unsigned short* brow1 = bins + (size_t)x.qloc[1] * Lrow;
        if (!selall_blk) {
            for (int i = tid; i < IDX_HIST_B / 16; i += NTHR) ((u32x4*)hist)[i] = (u32x4){0u, 0u, 0u, 0u};
            __syncthreads();
            idx_sweep(p, x, ntile, c, h, lds, [&](int kt, float s0, float s1) {
                const int key = 32 * kt + c;
                const unsigned b0 = sbin(s0), b1_ = sbin(s1);
                const unsigned inc0 = key <= x.qabs[0] ? (1u << (16 * (b0 & 1))) : 0u, inc1 = key <= x.qabs[1] ? (1u << (16 * (b1_ & 1))) : 0u;
                atomicAdd(hist + x.qloc[0] * 1024 + (b0 >> 1), inc0);
                atomicAdd(hist + x.qloc[1] * 1024 + (b1_ >> 1), inc1);
                const unsigned p0 = b0 | ((unsigned)__builtin_amdgcn_update_dpp(0, (int)b0, 0x101, 0xF, 0xF, true) << 16);
                const unsigned p1 = b1_ | ((unsigned)__builtin_amdgcn_update_dpp(0, (int)b1_, 0x101, 0xF, 0xF, true) << 16);
                const unsigned p0h = (unsigned)__builtin_amdgcn_update_dpp(0, (int)p0, 0x102, 0xF, 0xF, true);
                const unsigned p1h = (unsigned)__builtin_amdgcn_update_dpp(0, (int)p1, 0x102, 0xF, 0xF, true);
                if ((c & 3) == 0) {
                    *(uint2*)(brow0 + key) = make_uint2(p0, p0h);
                    *(uint2*)(brow1 + key) = make_uint2(p1, p1h);
                }
            });
            __syncthreads();
#pragma unroll 1
            for (int rr = 0; rr < 4; ++rr) {
                const int row = 4 * w + rr;
                int b, ab;
                find_bin(hist + row * 1024, info[row], lane, b, ab);
                if (lane == 0) { info[IDX_ROWS + row] = b; info[2 * IDX_ROWS + row] = info[row] - ab; }
            }
            __syncthreads();
        }
        for (int i = tid; i < 65536 / 16; i += NTHR) ((u32x4*)hist)[i] = (u32x4){0u, 0u, 0u, 0u};
        __syncthreads();
        {
            const int row = 4 * w + (lane >> 4), kc = lane & 15, qrow = q0 + row;
            const int tb = info[IDX_ROWS + row];
            const bool sa = selall_blk;
            const unsigned short* br = bins + (size_t)row * Lrow + 8 * kc;
            const int nstep = (Lrow + 127) >> 7;
            u32x4 cur = {0u, 0u, 0u, 0u};
            if (!sa && 8 * kc < Lrow) cur = *(const u32x4*)br;
#pragma unroll 1
            for (int st = 0; st < nstep; ++st) {
                u32x4 nxt = {0u, 0u, 0u, 0u};
                if (!sa && st + 1 < nstep && (st + 1) * 128 + 8 * kc < Lrow) nxt = *(const u32x4*)(br + (st + 1) * 128);
                const int k0 = st * 128 + 8 * kc;
                unsigned m8 = 0u;
#pragma unroll
                for (int i = 0; i < 8; ++i) {
                    const int bn = (int)((cur[i >> 1] >> (16 * (i & 1))) & 0xffffu), key = k0 + i;
                    const bool v = key <= qrow;
                    if (v && (sa || bn > tb)) m8 |= 1u << i;
                    if (v && !sa && bn == tb) {
                        const int ix = atomicAdd(info + 5 * IDX_ROWS + row, 1);
                        if (ix < IDX_FCAP) fcand[row * IDX_FCAP + ix] = make_uint2(0u, (unsigned)key);
                    }
                }
                const unsigned w1 = __shfl_down(m8, 1), w2 = __shfl_down(m8, 2), w3 = __shfl_down(m8, 3);
                if ((kc & 3) == 0 && k0 < Lrow) hist[(st * 4 + (kc >> 2)) * IDX_ROWS + row] = m8 | (w1 << 8) | (w2 << 16) | (w3 << 24);
                cur = nxt;
            }
        }
        const int ovf = __syncthreads_or(FORCE_SLOW || (tid < IDX_ROWS && info[5 * IDX_ROWS + tid] > IDX_FCAP));
        if (ovf) {
            idx_unit_slow(p, x, lds, q0, ntile, tid, lane, w, c, h);
        } else {
#pragma unroll 1
            for (int rr = 0; rr < 4; ++rr) {
                const int row = 4 * w + rr, n = info[5 * IDX_ROWS + row], need1 = info[2 * IDX_ROWS + row];
                uint2* cl = fcand + row * IDX_FCAP;
                if (n > 0) {
                    const int hd = lane >> 3, dc = lane & 7;
                    const bf16x8 qv = *(const bf16x8*)(p.qi + ((size_t)(q0 + row) * 8 + hd) * 64 + 8 * dc);
                    const float wgt = p.wi[(size_t)(q0 + row) * 8 + hd];
#pragma unroll 1
                    for (int j0 = 0; j0 < n; j0 += 8) {
                        bf16x8 kv[8];
#pragma unroll
                        for (int u = 0; u < 8; ++u) {
                            const unsigned key = cl[j0 + u < n ? j0 + u : n - 1].y;
                            kv[u] = *(const bf16x8*)(p.ki + (size_t)key * 64 + 8 * dc);
                        }
#pragma unroll
                        for (int u = 0; u < 8; ++u) {
                            float d = 0.f;
#pragma unroll
                            for (int e = 0; e < 8; ++e) d = __builtin_fmaf(bf2f((bf16_t)qv[e]), bf2f((bf16_t)kv[u][e]), d);
                            d += __shfl_xor(d, 1); d += __shfl_xor(d, 2); d += __shfl_xor(d, 4);
                            float sc = wgt * fmaxf(d, 0.f);
                            sc += __shfl_xor(sc, 8); sc += __shfl_xor(sc, 16); sc += __shfl_xor(sc, 32);
                            if (lane == 0 && j0 + u < n) cl[j0 + u].x = fkey(sc);
                        }
                    }
                }
                __builtin_amdgcn_s_waitcnt(0xc07f);
                __builtin_amdgcn_wave_barrier();
#pragma unroll 1
                for (int i0 = 0; i0 < n; i0 += 64) {
                    const int i = i0 + lane;
                    const uint2 ci = cl[i < n ? i : 0];
                    int rank = 0;
#pragma unroll 1
                    for (int j = 0; j < n; ++j) {
                        const uint2 cj = cl[j];
                        rank += (cj.x > ci.x || (cj.x == ci.x && cj.y < ci.y)) ? 1 : 0;
                    }
                    if (i < n && rank < need1) atomicOr(hist + (ci.y >> 5) * IDX_ROWS + row, 1u << (ci.y & 31u));
                }
            }
            __syncthreads();
        }
        const int nw = (((q0 & ~255) >> 5) + 8) * IDX_ROWS;
        for (int i = tid; i < nw; i += NTHR) {
            const int kt = i / IDX_ROWS, r = i % IDX_ROWS;
            p.bm[(size_t)kt * T_ + q0 + r] = hist[i];
        }
    }
}
#define XB_TMO      128
#define XB_XCNT(j)  (256  + 64 * (j))
#define XB_XSUB(j)  (1280 + 64 * (j))
#define XB_XGEN(j)  (2304 + 64 * (j))
#define XB_TOP      3328
#define XB_TOPGEN   3392
#define XCD_BAR_WORDS 3456
#define XB_SPIN_CAP (1u << 22)
#define LAS __attribute__((address_space(3)))

__device__ __forceinline__ unsigned xb_ld(unsigned* p)              { return __hip_atomic_load(p, __ATOMIC_RELAXED, __HIP_MEMORY_SCOPE_AGENT); }
__device__ __forceinline__ unsigned xb_add(unsigned* p, unsigned v) { return __hip_atomic_fetch_add(p, v, __ATOMIC_RELAXED, __HIP_MEMORY_SCOPE_AGENT); }
__device__ __forceinline__ unsigned xb_xcc_id() { return (unsigned)__builtin_amdgcn_s_getreg((3 << 11) | 20) & 0xFu; }
#define XB_SPIN(cond, bar) do { unsigned _sp = 0; while (cond) { __builtin_amdgcn_s_sleep(1); \
    if ((++_sp & 255u) == 0u) { if (xb_ld(&(bar)[XB_TMO])) break; if (_sp > XB_SPIN_CAP) { atomicAdd(&(bar)[XB_TMO], 1u); break; } } } } while (0)

struct XcdBarrier { unsigned* bar; unsigned x; volatile LAS unsigned* st; };

__device__ __forceinline__ XcdBarrier xcd_barrier_post(unsigned* bar, volatile LAS unsigned* st) {
    XcdBarrier b; b.bar = bar; b.x = xb_xcc_id(); b.st = st;
    if (threadIdx.x == 0) (void)xb_add(&bar[XB_XCNT(b.x)], 1u);
    return b;
}
__device__ __forceinline__ void xcd_barrier_complete(unsigned* bar, unsigned x, unsigned& nloc, unsigned& nx) {
    const unsigned G = gridDim.x * gridDim.y * gridDim.z;
    unsigned sum, cnt, mine, sp = 0u;
    for (;;) {
        sum = 0u; cnt = 0u; mine = 0u;
#pragma unroll
        for (unsigned j = 0; j < 16; ++j) { const unsigned c = xb_ld(&bar[XB_XCNT(j)]); sum += c; cnt += (c > 0u) ? 1u : 0u; mine = (j == x) ? c : mine; }
        if (sum == G) break;
        __builtin_amdgcn_s_sleep(1);
        if ((++sp & 255u) == 0u) { if (xb_ld(&bar[XB_TMO])) break; if (sp > XB_SPIN_CAP) { atomicAdd(&bar[XB_TMO], 1u); break; } }
    }
    nloc = mine > 0u ? mine : 1u; nx = cnt > 0u ? cnt : 1u;
}
__device__ __forceinline__ void xcd_barrier(const XcdBarrier& b) {
    asm volatile("s_waitcnt vmcnt(0)" ::: "memory");
    __syncthreads();
    if (threadIdx.x == 0) {
        unsigned* bar = b.bar;
        __builtin_amdgcn_s_waitcnt(0);
        unsigned nloc = b.st[0], nx = b.st[1];
        if (nloc == 0u) { xcd_barrier_complete(bar, b.x, nloc, nx); b.st[0] = nloc; b.st[1] = nx; }
        const unsigned old = xb_add(&bar[XB_XSUB(b.x)], 1u);
        const unsigned gen = old / nloc;
        if (old + 1u == (gen + 1u) * nloc) {
            __builtin_amdgcn_fence(__ATOMIC_RELEASE, "agent");
            asm volatile("s_waitcnt vmcnt(0)" ::: "memory");
            const unsigned og = xb_add(&bar[XB_TOP], 1u);
            const unsigned tg = og / nx;
            if (og + 1u == (tg + 1u) * nx) xb_add(&bar[XB_TOPGEN], 1u);
            else XB_SPIN(xb_ld(&bar[XB_TOPGEN]) == tg, bar);
            __builtin_amdgcn_fence(__ATOMIC_ACQUIRE, "agent");
            xb_add(&bar[XB_XGEN(b.x)], 1u);
            asm volatile("s_waitcnt vmcnt(0)" ::: "memory");
        } else {
            XB_SPIN(xb_ld(&bar[XB_XGEN(b.x)]) == gen, bar);
            __builtin_amdgcn_fence(__ATOMIC_ACQUIRE, "agent");
            asm volatile("s_waitcnt vmcnt(0)" ::: "memory");
        }
    }
    __syncthreads();
}


#define GSYNC() xcd_barrier(xb)
#define MEGA_LDS_B (IDX_TOTAL_LDS_B > (RT_DEC_OFF + 4096) ? IDX_TOTAL_LDS_B : (RT_DEC_OFF + 4096))
template <int layer>
__device__ __forceinline__ void tail_phases(const P& p, char* lds, const XcdBarrier& xb) {
    phase_outproj(p, layer == 0 ? p.wb_ab_out : p.wb_c_out, layer == 0 ? p.x : p.x3, lds);
    GSYNC();
    phase_ln_router(p, layer, lds);
    GSYNC();
    phase_moe1(p, layer, lds);
    GSYNC();
    phase_moe2(p, layer, lds);
    GSYNC();
    phase_combine_ln(p, layer, lds);
    GSYNC();
    phase_ple(p, layer, layer == 0 ? p.x3 : p.out, lds);
    if (layer == 0) GSYNC();
}

__global__ void __launch_bounds__(512, 2) mega(P p) {
    extern __shared__ __attribute__((aligned(16))) char lds[];
    cg::grid_group grid = cg::this_grid();
    volatile LAS unsigned* st = (volatile LAS unsigned*)(lds + MEGA_LDS_B);
    if (threadIdx.x == 0) { st[0] = 0u; st[1] = 0u; }
    __syncthreads();
    const XcdBarrier xb = xcd_barrier_post(p.bar, st);
    phase_convert(p, lds);
    if (p.bar == nullptr) grid.sync();
    xcd_barrier(xb);
    phase_pp(p, lds);
    phase_inproj<0>(p, lds);
    GSYNC();
    phase_moba_gate(p, lds);
    phase_sb(p, lds);
    GSYNC();
    phase_moba_sparse(p, lds);
    GSYNC();
    phase_moba_own(p, lds);
    GSYNC();
#if defined(DEBUG_STAGE) && (DEBUG_STAGE == 2 || DEBUG_STAGE == 1)
    return;
#endif
    tail_phases<0>(p, lds, xb);
    phase_inproj<1>(p, lds);
    GSYNC();
    phase_indexer(p, lds);
    GSYNC();
    phase_dsa(p, lds);
    GSYNC();
    tail_phases<1>(p, lds, xb);
}

static inline char* carve(char*& cur, size_t bytes) { char* r = cur; cur += (bytes + 255) & ~(size_t)255; return r; }

static void make_params(P& p, void* const* d_in, void* d_out, void* d_ws) {
    p.x = (const float*)d_in[0]; p.p = (const float*)d_in[1]; p.ab_w_in = (const float*)d_in[2]; p.ab_w_out = (const float*)d_in[3];
    p.c_w_in = (const float*)d_in[4]; p.c_w_out = (const float*)d_in[5]; p.ln_g = (const float*)d_in[6]; p.ln_b = (const float*)d_in[7];
    p.router_w = (const float*)d_in[8]; p.router_b = (const float*)d_in[9]; p.moe_w1 = (const float*)d_in[10]; p.moe_b1 = (const float*)d_in[11];
    p.moe_w2 = (const float*)d_in[12]; p.moe_b2 = (const float*)d_in[13]; p.ple_w_proj = (const float*)d_in[14]; p.ple_w_gate = (const float*)d_in[15];
    p.out = (float*)d_out;
    char* cur = (char*)d_ws;
    const size_t T = T_;
    p.cnt = (int*)carve(cur, 256);
    p.dbg = (float*)carve(cur, 256);
    p.bar = (unsigned*)carve(cur, XCD_BAR_WORDS * sizeof(unsigned));
    p.wb_ab_in = (bf16_t*)carve(cur, (size_t)3072 * 1024 * 2);
    p.wb_ab_out = (bf16_t*)carve(cur, (size_t)1024 * 1024 * 2);
    p.wb_c_in = (bf16_t*)carve(cur, (size_t)C_INP * 1024 * 2);
    p.ksum = (float*)carve(cur, 8 * 64 * 64 * 4);
    p.kmax2 = (unsigned*)carve(cur, 256);
    p.mb_cnt = (int*)carve(cur, 512 * 4);
    p.mb_list = (int*)carve(cur, (size_t)512 * T * 4);
    p.mb_part = (float*)carve(cur, (size_t)8 * T * 3 * 64 * 4);
    p.mb_l = (float*)carve(cur, (size_t)8 * T * 3 * 4);
    p.wb_c_out = (bf16_t*)carve(cur, (size_t)1024 * 1024 * 2);
    p.wb_w1 = (bf16_t*)carve(cur, (size_t)64 * 2048 * 1024 * 2);
    p.wb_w2 = (bf16_t*)carve(cur, (size_t)64 * 1024 * 1024 * 2);
    p.wb_g = (bf16_t*)carve(cur, (size_t)2 * 1024 * 1024 * 2);
    p.wb_p = (bf16_t*)carve(cur, (size_t)2 * 1024 * 256 * 2);
    p.xb = (bf16_t*)carve(cur, T * DM * 2);
    p.pb = (bf16_t*)carve(cur, 2 * T * 256 * 2);
    p.pp = (float*)carve(cur, 2 * T * DM * 4);
    p.rope = (float*)carve(cur, T * 32 * 2 * 4);
    p.q16 = (bf16_t*)carve(cur, 16 * T * 64 * 2);
    p.k16 = (bf16_t*)carve(cur, 16 * T * 64 * 2);
    p.vT16 = (bf16_t*)carve(cur, 16 * T * 64 * 2);
    p.o = (bf16_t*)carve(cur, T * DM * 2);
    p.ypre = (float*)carve(cur, T * DM * 4);
    p.x1 = (float*)carve(cur, T * DM * 4);
    p.x1b = (bf16_t*)carve(cur, T * DM * 2);
    p.act = (bf16_t*)carve(cur, (size_t)(65536 + 32 * 256) * DM * 2);
    p.oslot = (bf16_t*)carve(cur, (size_t)(65536 + 32 * 256) * DM * 2);
    p.x2 = (float*)carve(cur, T * DM * 4);
    p.x2b = (bf16_t*)carve(cur, T * DM * 2);
    p.x3 = (float*)carve(cur, T * DM * 4);
    p.qi = (bf16_t*)carve(cur, T * 8 * 64 * 2);
    p.ki = (bf16_t*)carve(cur, T * 64 * 2);
    p.wi = (float*)carve(cur, T * 8 * 4);
    p.bm = (unsigned*)carve(cur, (size_t)512 * T * 4);
    p.tok_of = (int*)carve(cur, (size_t)32 * T * 4);
    p.sel_e = (int*)carve(cur, T * 4 * 4);
    p.sel_pos = (int*)carve(cur, T * 4 * 4);
    p.sel_g = (float*)carve(cur, T * 4 * 4);
}

extern "C" void kernel_launch(void* const* d_in, const int* in_sizes, int n_in, void* d_out, int out_size, void* d_ws, size_t ws_size, hipStream_t stream) {
    P p{};
    make_params(p, d_in, d_out, d_ws);
    constexpr size_t kDynLds = MEGA_LDS_B + 16;
    static int grid_blocks = 0;
    if (!grid_blocks) {
        int dev = 0, cus = 0, per_cu = 0;
        hipGetDevice(&dev);
        hipDeviceGetAttribute(&cus, hipDeviceAttributeMultiprocessorCount, dev);
        hipFuncSetAttribute((const void*)mega, hipFuncAttributeMaxDynamicSharedMemorySize, (int)kDynLds);
        hipOccupancyMaxActiveBlocksPerMultiprocessor(&per_cu, mega, NTHR, kDynLds);
        if (per_cu > 1) per_cu = 1;
        if (per_cu < 1) per_cu = 1;
        grid_blocks = cus * per_cu;
    }
    hipMemsetAsync(p.bar, 0, XCD_BAR_WORDS * sizeof(unsigned), stream);
    void* args[] = {&p};
    hipError_t e = hipLaunchCooperativeKernel((void*)mega, dim3(grid_blocks), dim3(NTHR), args, kDynLds, stream);
    if (e != hipSuccess) fprintf(stderr, "cooperative launch failed: %s (grid %d)\n", hipGetErrorString(e), grid_blocks);
#if defined(DEBUG_STAGE) && DEBUG_STAGE == 1
    k_dbg_zero<<<1, 64, 0, stream>>>(p);
    k_chk_sb<<<512, 64, 0, stream>>>(p);
    k_report<<<1024, 256, 0, stream>>>(p, 0, 100.0f);
#endif
#if defined(DEBUG_STAGE) && DEBUG_STAGE == 5
    k_dbg_zero<<<1, 64, 0, stream>>>(p);
    k_chk_moe<<<128, 256, 0, stream>>>(p);
    k_report<<<1024, 256, 0, stream>>>(p, 0, 100.0f);
#endif
#if defined(DEBUG_STAGE) && DEBUG_STAGE == 4
    k_dbg_zero<<<1, 64, 0, stream>>>(p);
    k_chk_dsa<<<512, 64, 0, stream>>>(p);
    k_report<<<1024, 256, 0, stream>>>(p, 0, 100.0f);
#endif
#if defined(DEBUG_STAGE) && DEBUG_STAGE == 3
    k_dbg_zero<<<1, 64, 0, stream>>>(p);
    k_chk_idx<<<32, 256, 65536, stream>>>(p);
    k_report<<<1024, 256, 0, stream>>>(p, 1, 1.0f / 32.0f);
#endif
#if defined(DEBUG_STAGE) && DEBUG_STAGE == 2
    k_dbg_zero<<<1, 64, 0, stream>>>(p);
    k_chk_moba<<<512, 64, 0, stream>>>(p);
    k_report<<<1024, 256, 0, stream>>>(p, 1, 1.0f);
#endif
}
```

```cpp
#include <hip/hip_runtime.h>
#include <hip/hip_cooperative_groups.h>
#include <stdint.h>
#include <cstdio>
namespace cg = cooperative_groups;

typedef unsigned short bf16_t;
typedef short bf16x8 __attribute__((ext_vector_type(8)));
typedef float f32x4 __attribute__((ext_vector_type(4)));
typedef float f32x16 __attribute__((ext_vector_type(16)));
typedef unsigned u32x4 __attribute__((ext_vector_type(4)));

#define T_ 16384
#define DM 1024
#define NEXP 32
#define C_IN_ 3656
#define C_INP 3840
#define LOG2E 1.4426950408889634f
#define DN_ALPHA 1.4142135623730951f
#define NTHR 512
#define NWAVE 8

__device__ __forceinline__ int otid() { int t = threadIdx.x; asm volatile("" : "+v"(t)); return t; }
__device__ __forceinline__ bf16_t f2bf(float f) { unsigned u = __float_as_uint(f); u += 0x7FFFu + ((u >> 16) & 1u); return (bf16_t)(u >> 16); }
__device__ __forceinline__ float bf2f(bf16_t b) { return __uint_as_float(((unsigned)b) << 16); }
typedef __bf16 bf16v2_ __attribute__((ext_vector_type(2)));
typedef float f32v2_ __attribute__((ext_vector_type(2)));
__device__ __forceinline__ unsigned pack2(float lo, float hi) { const f32v2_ v = {lo, hi}; return __builtin_bit_cast(unsigned, __builtin_convertvector(v, bf16v2_)); }
__device__ __forceinline__ float fexp2(float x) { return __builtin_amdgcn_exp2f(x); }
__device__ __forceinline__ float flog2(float x) { return __builtin_amdgcn_logf(x); }
__device__ __forceinline__ float sigmoidf_(float x) { return __builtin_amdgcn_rcpf(1.0f + __builtin_amdgcn_exp2f(-LOG2E * x)); }
__device__ __forceinline__ float wave_sum(float v) {
#pragma unroll
    for (int o = 32; o > 0; o >>= 1) v += __shfl_xor(v, o);
    return v;
}

struct P {
    const float *x, *p, *ab_w_in, *ab_w_out, *c_w_in, *c_w_out, *ln_g, *ln_b, *router_w, *router_b, *moe_w1, *moe_b1, *moe_w2, *moe_b2, *ple_w_proj, *ple_w_gate;
    float* out;
    bf16_t *wb_ab_in, *wb_ab_out, *wb_c_in, *wb_c_out, *wb_w1, *wb_w2, *wb_g, *wb_p;
    bf16_t *xb, *pb;
    float* pp;
    float* rope;
    bf16_t *q16, *k16, *vT16, *o;
    float* ksum;
    unsigned* kmax2;
    int* mb_cnt;
    int* mb_list;
    float* mb_part;
    float* mb_l;
    float *ypre, *x1;
    bf16_t* x1b;
    bf16_t *act, *oslot;
    float* x2;
    bf16_t* x2b;
    float* x3;
    bf16_t *qi, *ki;
    float* wi;
    unsigned* bm;
    int *cnt, *tok_of, *sel_e, *sel_pos;
    float* sel_g;
    float* dbg;
    unsigned* bar;
};

__device__ __forceinline__ int zz_unit(int r, int b, int G) { return (r & 1) ? (r * G + (G - 1 - b)) : (r * G + b); }

__device__ __forceinline__ int w1map(int n) {
    const int is_up = n & 1, j = n >> 1, tile = j >> 7, jj = j & 127, wc = jj >> 5, jl = jj & 31;
    return tile * 256 + wc * 64 + is_up * 32 + jl;
}

__device__ __forceinline__ void conv_job(const float* __restrict__ src, bf16_t* __restrict__ dst, int K, int N, int dst_rows, int mode, int batch) {
    const int tid = otid(), lane = tid & 63, wid = tid >> 6, kg = lane & 7, ng = lane >> 3;
    const int tkn = K / 64, tnn = dst_rows / 32, per = tkn * tnn, total = per * batch;
    const int stride = gridDim.x * NWAVE;
    int u = blockIdx.x * NWAVE + wid;
    if (u >= total) return;
    f32x4 v[8], w[8];
    auto coords = [&](int uu, const float*& S, bf16_t*& D, int& k0, int& n) {
        const int bt = uu / per, r = uu % per, tn = r / tkn, tk = r % tkn;
        S = src + (size_t)bt * K * N; D = dst + (size_t)bt * dst_rows * K; k0 = tk * 64 + 8 * kg; n = tn * 32 + 4 * ng;
    };
    auto load = [&](f32x4 (&x)[8], const float* S, int k0, int n) {
#pragma unroll
        for (int j = 0; j < 8; ++j) { x[j] = (f32x4){0.f, 0.f, 0.f, 0.f}; if (n < N) x[j] = *(const f32x4*)(S + (size_t)(k0 + j) * N + n); }
    };
    auto store = [&](const f32x4 (&x)[8], bf16_t* D, int k0, int n) {
#pragma unroll
        for (int i = 0; i < 4; ++i) {
            const int drow = (mode == 1) ? w1map(n + i) : (n + i);
            *(u32x4*)(D + (size_t)drow * K + k0) = (u32x4){pack2(x[0][i], x[1][i]), pack2(x[2][i], x[3][i]), pack2(x[4][i], x[5][i]), pack2(x[6][i], x[7][i])};
        }
    };
    const float* S0; bf16_t* D0; int k00, n0;
    coords(u, S0, D0, k00, n0);
    load(v, S0, k00, n0);
#pragma unroll 1
    for (;;) {
        const int u1 = u + stride;
        const float* S1 = S0; bf16_t* D1 = D0; int k01 = k00, n1 = n0;
        if (u1 < total) { coords(u1, S1, D1, k01, n1); load(w, S1, k01, n1); }
        store(v, D0, k00, n0);
        if (u1 >= total) break;
        const int u2 = u1 + stride;
        if (u2 < total) { coords(u2, S0, D0, k00, n0); load(v, S0, k00, n0); }
        store(w, D1, k01, n1);
        if (u2 >= total) break;
        u = u2;
    }
}

__device__ __forceinline__ void phase_convert(const P& p, char* lds) {
    conv_job(p.ab_w_in, p.wb_ab_in, 1024, 3072, 3072, 0, 1);
    conv_job(p.ab_w_out, p.wb_ab_out, 1024, 1024, 1024, 0, 1);
    conv_job(p.c_w_in, p.wb_c_in, 1024, C_IN_, C_INP, 0, 1);
    conv_job(p.c_w_out, p.wb_c_out, 1024, 1024, 1024, 0, 1);
    conv_job(p.moe_w1, p.wb_w1, 1024, 2048, 2048, 1, 64);
    conv_job(p.moe_w2, p.wb_w2, 1024, 1024, 1024, 0, 64);
    conv_job(p.ple_w_gate, p.wb_g, 1024, 1024, 1024, 0, 2);
    conv_job(p.ple_w_proj, p.wb_p, 256, 1024, 1024, 0, 2);
    const size_t gtid = (size_t)blockIdx.x * NTHR + otid(), gsz = (size_t)gridDim.x * NTHR;
    for (size_t i = gtid; i < (size_t)T_ * DM / 4; i += gsz) {
        const f32x4 v = *(const f32x4*)(p.x + 4 * i);
        *(uint2*)(p.xb + 4 * i) = make_uint2(pack2(v[0], v[1]), pack2(v[2], v[3]));
    }
    for (size_t i = gtid; i < (size_t)2 * T_ * 256 / 4; i += gsz) {
        const f32x4 v = *(const f32x4*)(p.p + 4 * i);
        *(uint2*)(p.pb + 4 * i) = make_uint2(pack2(v[0], v[1]), pack2(v[2], v[3]));
    }
    for (size_t i = gtid; i < (size_t)T_ * 32; i += gsz) {
        const int pos = (int)(i >> 5), k = (int)(i & 31);
        const double inv = exp2(-(double)k * (13.287712379549449 / 32.0));
        const double ang = (double)pos * inv;
        const double red = ang - 6.283185307179586 * floor(ang * 0.15915494309189535);
        float sn_, cs_;
        sincosf((float)red, &sn_, &cs_);
        p.rope[2 * i] = cs_;
        p.rope[2 * i + 1] = sn_;
    }
    for (size_t i = gtid; i < 8 * 64 * 64; i += gsz) p.ksum[i] = 0.f;
    if (blockIdx.x == 0 && otid() < 64) p.cnt[otid()] = 0;
    if (blockIdx.x == 0 && otid() < 32) p.kmax2[otid()] = 0u;
    if (blockIdx.x == 1) p.mb_cnt[otid()] = 0;
}

#define G_TILE_B 32768
#define G_STAGE_B 65536
#define G_LDS_B 131072
__device__ __forceinline__ int g_lds_byte(int r, int c) {
    const int st = (r >> 4) * 2 + (c >> 5), ob = (r & 15) * 64 + (c & 31) * 2;
    return st * 1024 + (ob ^ (((ob >> 9) & 1) << 5));
}
__device__ __forceinline__ void g_stage_rc(int b, int& R, int& C) {
    const int st = b >> 10, sb = b & 1023, swz = sb ^ (((sb >> 9) & 1) << 5);
    R = (st >> 1) * 16 + swz / 64;
    C = (st & 1) * 32 + (swz % 64) / 2;
}
__device__ __forceinline__ int xcd_remap(int l, int C) {
    const int chunk = (C + 7) >> 3, j = l >> 3, x = l & 7, ul = x * chunk + j;
    return (j < chunk && ul < C) ? ul : -1;
}
struct RoundUnits {
    int total;
    __device__ __forceinline__ int operator()(int k) const {
        const int G = gridDim.x, C = total - k * G;
        if (C <= 0) return -1;
        const int ul = xcd_remap(blockIdx.x, C < G ? C : G);
        return ul < 0 ? -1 : k * G + ul;
    }
};
#define G8_LAS __attribute__((address_space(3)))
#define G8_HTB 16384
struct AOff { unsigned o[2][2]; };

__device__ __forceinline__ void g8_rc(int i, int& R, int& C) { g_stage_rc(otid() * 16 + i * 8192, R, C); }
__device__ __forceinline__ AOff g8_dense_a(int row0, int ld) {
    AOff a; int R, C;
#pragma unroll
    for (int i = 0; i < 2; ++i) {
        g8_rc(i, R, C);
        a.o[0][i] = (unsigned)(((size_t)(row0 + R) * ld + C) * 2);
        a.o[1][i] = (unsigned)(((size_t)(row0 + 128 + R) * ld + C) * 2);
    }
    return a;
}

struct NoHalf { __device__ __forceinline__ bool operator()(int) const { return false; } };
template <bool TR, class UnitFn, class AFn, class BFn, class EpiFn, class HalfFn = NoHalf>
__device__ __forceinline__ void gemm8_units(UnitFn unit_of, int K, char* lds_, const bf16_t* Abase, AFn aoff_of, BFn bbase_of, EpiFn epi, HalfFn half_of = HalfFn()) {
    G8_LAS unsigned char* lds = (G8_LAS unsigned char*)lds_;
    const int tid = otid(), wid = __builtin_amdgcn_readfirstlane(tid >> 6), lane = tid & 63, wr = wid >> 2, wc = wid & 3, fr = lane & 15, fq = lane >> 4;
    const int nt = K / 64;
    int cur = unit_of(0);
    if (cur < 0) return;
    unsigned voffB[2];
#pragma unroll
    for (int i = 0; i < 2; ++i) { int R, C; g8_rc(i, R, C); voffB[i] = (unsigned)(((64 * (R >> 5) + (R & 31)) * K + C) * 2); }
    const size_t kstep = 128;
    const size_t hstepB = (size_t)32 * K * 2;
    const unsigned ldsw = (unsigned)wid * 1024u;
    const int aoffl = g_lds_byte(wr * 64 + fr, fq * 8), boffl = g_lds_byte(wc * 32 + fr, fq * 8);
#define G8_SA(b, h) (((b) * 2 + (h)) * G8_HTB)
#define G8_SB(b, h) ((4 + (b) * 2 + (h)) * G8_HTB)
#define G8_STAGE_A(bufoff, AO, h, kb) do { _Pragma("unroll") for (int _i = 0; _i < 2; ++_i) \
        __builtin_amdgcn_global_load_lds((const unsigned*)((const char*)Abase + (kb) + (AO).o[h][_i]), (G8_LAS unsigned*)(lds + (bufoff) + ldsw + _i * 8192), 16, 0, 0); } while (0)
#define G8_STAGE_B(bufoff, gbase) do { _Pragma("unroll") for (int _i = 0; _i < 2; ++_i) \
        __builtin_amdgcn_global_load_lds((const unsigned*)((const char*)(gbase) + voffB[_i]), (G8_LAS unsigned*)(lds + (bufoff) + ldsw + _i * 8192), 16, 0, 0); } while (0)
#define G8_LDA(dst, b, h) do { _Pragma("unroll") for (int m = 0; m < 4; ++m) _Pragma("unroll") for (int k = 0; k < 2; ++k) dst[m][k] = *(const G8_LAS bf16x8*)(lds + G8_SA(b, h) + aoffl + m * 2048 + k * 1024); } while (0)
#define G8_LDB(dst, b, h) do { _Pragma("unroll") for (int n = 0; n < 2; ++n) _Pragma("unroll") for (int k = 0; k < 2; ++k) dst[n][k] = *(const G8_LAS bf16x8*)(lds + G8_SB(b, h) + boffl + n * 2048 + k * 1024); } while (0)
#define G8_MMA(ai, bj, At_, Bt_) do { __builtin_amdgcn_s_setprio(1); _Pragma("unroll") for (int m = 0; m < 4; ++m) _Pragma("unroll") for (int n = 0; n < 2; ++n) _Pragma("unroll") for (int k = 0; k < 2; ++k) \
        acc[ai][bj][m][n] = TR ? __builtin_amdgcn_mfma_f32_16x16x32_bf16(Bt_[n][k], At_[m][k], acc[ai][bj][m][n], 0, 0, 0) \
                               : __builtin_amdgcn_mfma_f32_16x16x32_bf16(At_[m][k], Bt_[n][k], acc[ai][bj][m][n], 0, 0, 0); __builtin_amdgcn_s_setprio(0); } while (0)
#define G8_WAIT_V(n) asm volatile("s_waitcnt vmcnt(" #n ")" ::: "memory")
#define G8_WAIT_L(n) asm volatile("s_waitcnt lgkmcnt(" #n ")" ::: "memory")
#define G8_BAR __builtin_amdgcn_s_barrier()
#define G8_SCHED __builtin_amdgcn_sched_barrier(0)
    f32x4 acc[2][2][4][2];
#pragma unroll
    for (int a = 0; a < 2; ++a)
#pragma unroll
        for (int b = 0; b < 2; ++b)
#pragma unroll
            for (int m = 0; m < 4; ++m)
#pragma unroll
                for (int n = 0; n < 2; ++n) acc[a][b][m][n] = (f32x4){0.f, 0.f, 0.f, 0.f};
    bf16x8 At[4][2], B0[2][2], B1[2][2];
    AOff cA = aoff_of(cur), nA = cA;
    const char* cB = (const char*)bbase_of(cur);
    __syncthreads();
    G8_STAGE_B(G8_SB(0, 0), cB); G8_STAGE_A(G8_SA(0, 0), cA, 0, 0); G8_STAGE_B(G8_SB(0, 1), cB + hstepB); G8_STAGE_A(G8_SA(0, 1), cA, 1, 0);
    if (wr == 1) G8_BAR;
    G8_WAIT_V(4); G8_BAR;
    G8_STAGE_B(G8_SB(1, 0), cB + kstep); G8_STAGE_A(G8_SA(1, 0), cA, 0, kstep); G8_STAGE_B(G8_SB(1, 1), cB + hstepB + kstep);
    G8_WAIT_V(6); G8_BAR;
    for (int ui = 0;; ++ui) {
        const int nxt = unit_of(ui + 1);
        const bool has_next = nxt >= 0;
        const char* nB = cB;
        if (has_next) { nA = aoff_of(nxt); nB = (const char*)bbase_of(nxt); } else nA = cA;
        for (int t = 0; t < nt; t += 2) {
            const bool last = (t == nt - 2);
            const size_t k1 = (size_t)(t + 1) * kstep;
            AOff a2;
#pragma unroll
            for (int hh = 0; hh < 2; ++hh)
#pragma unroll
                for (int i = 0; i < 2; ++i) a2.o[hh][i] = last ? nA.o[hh][i] : cA.o[hh][i];
            const size_t k2 = last ? 0 : (size_t)(t + 2) * kstep, k3 = k2 + kstep;
            const char* b2 = last ? nB : cB + (size_t)(t + 2) * kstep;
            const char* b3 = b2 + kstep;
            G8_LDB(B0, 0, 0); G8_SCHED; G8_LDA(At, 0, 0); G8_STAGE_A(G8_SA(1, 1), cA, 1, k1);
            G8_WAIT_L(8); G8_BAR; G8_WAIT_L(0); G8_MMA(0, 0, At, B0); G8_BAR; G8_SCHED;
            G8_LDB(B1, 0, 1); G8_STAGE_B(G8_SB(0, 0), b2);
            G8_BAR; G8_WAIT_L(0); G8_MMA(0, 1, At, B1); G8_BAR;
            G8_LDA(At, 0, 1); G8_STAGE_A(G8_SA(0, 0), a2, 0, k2);
            G8_BAR; G8_WAIT_L(0); G8_MMA(1, 0, At, B0); G8_BAR; G8_SCHED;
            G8_STAGE_B(G8_SB(0, 1), b2 + hstepB);
            G8_WAIT_V(6); G8_BAR; G8_MMA(1, 1, At, B1); G8_BAR;
            G8_LDB(B0, 1, 0); G8_SCHED; G8_LDA(At, 1, 0); G8_STAGE_A(G8_SA(0, 1), a2, 1, k2);
            G8_WAIT_L(8); G8_BAR; G8_WAIT_L(0); G8_MMA(0, 0, At, B0); G8_BAR; G8_SCHED;
            G8_LDB(B1, 1, 1); G8_STAGE_B(G8_SB(1, 0), b3);
            G8_BAR; G8_WAIT_L(0); G8_MMA(0, 1, At, B1); G8_BAR;
            G8_LDA(At, 1, 1); G8_STAGE_A(G8_SA(1, 0), a2, 0, k3);
            G8_BAR; G8_WAIT_L(0); G8_MMA(1, 0, At, B0); G8_BAR; G8_SCHED;
            G8_STAGE_B(G8_SB(1, 1), b3 + hstepB);
            G8_WAIT_V(6); G8_BAR; G8_MMA(1, 1, At, B1); G8_BAR;
        }
        epi(cur, acc, wr, wc, fr, fq);
        if (!has_next) break;
#pragma unroll
        for (int a = 0; a < 2; ++a)
#pragma unroll
            for (int b = 0; b < 2; ++b)
#pragma unroll
                for (int m = 0; m < 4; ++m)
#pragma unroll
                    for (int n = 0; n < 2; ++n) acc[a][b][m][n] = (f32x4){0.f, 0.f, 0.f, 0.f};
        cur = nxt; cA = nA; cB = nB;
    }
    G8_WAIT_V(0);
    if (wr == 0) G8_BAR;
    G8_BAR;
#undef G8_SA
#undef G8_SB
#undef G8_STAGE_A
#undef G8_STAGE_B
#undef G8_LDA
#undef G8_LDB
#undef G8_MMA
#undef G8_WAIT_V
#undef G8_WAIT_L
#undef G8_BAR
#undef G8_SCHED
}
typedef f32x4 Acc8[2][2][4][2];
__device__ __forceinline__ void phase_pp(const P& p, char* lds) {
    gemm8_units<true>(RoundUnits{2 * 64 * 4}, 256, lds, p.pb,
        [&](int t) { const int l = t >> 8, mt = (t & 255) >> 2; return g8_dense_a(l * T_ + mt * 256, 256); },
        [&](int t) { const int l = t >> 8, nt = t & 3; return p.wb_p + ((size_t)l * 1024 + nt * 256) * 256; },
        [&](int t, Acc8& acc, int wr, int wc, int fr, int fq) {
            const int l = t >> 8, mt = (t & 255) >> 2, nt = t & 3;
            float* O = p.pp + (size_t)l * T_ * DM;
#pragma unroll
            for (int ai = 0; ai < 2; ++ai)
#pragma unroll
                for (int m = 0; m < 4; ++m)
#pragma unroll
                    for (int bj = 0; bj < 2; ++bj)
#pragma unroll
                        for (int n = 0; n < 2; ++n) {
                            const int tok = mt * 256 + 128 * ai + 64 * wr + 16 * m + fr, col = nt * 256 + 64 * wc + 32 * bj + 16 * n + 4 * fq;
                            *(f32x4*)(O + (size_t)tok * DM + col) = acc[ai][bj][m][n];
                        }
        });
}

template <bool ROPE>
__device__ __forceinline__ void epi_rows(const P& p, bf16_t* dst, int stride, Acc8& acc, int tok0, int wr, int fr, int fq, float scale) {
#pragma unroll
    for (int ai = 0; ai < 2; ++ai)
#pragma unroll
        for (int m = 0; m < 4; ++m) {
            const int tok = tok0 + 128 * ai + 64 * wr + 16 * m + fr;
            if (ROPE) {
#pragma unroll
                for (int n = 0; n < 2; ++n) {
                    const float* rt = p.rope + ((size_t)tok * 32 + n * 16 + 4 * fq) * 2;
                    const f32x4 cs0 = *(const f32x4*)rt, cs1 = *(const f32x4*)(rt + 4);
                    const float c[4] = {cs0[0], cs0[2], cs1[0], cs1[2]}, sn[4] = {cs0[1], cs0[3], cs1[1], cs1[3]};
#pragma unroll
                    for (int j = 0; j < 4; ++j) {
                        const float x1 = acc[ai][0][m][n][j], x2 = acc[ai][1][m][n][j];
                        acc[ai][0][m][n][j] = x1 * c[j] - x2 * sn[j];
                        acc[ai][1][m][n][j] = x2 * c[j] + x1 * sn[j];
                    }
                }
            }
#pragma unroll
            for (int bj = 0; bj < 2; ++bj)
#pragma unroll
                for (int n = 0; n < 2; ++n) {
                    const f32x4 v = acc[ai][bj][m][n] * scale;
                    *(uint2*)(dst + (size_t)tok * stride + 32 * bj + 16 * n + 4 * fq) = make_uint2(pack2(v[0], v[1]), pack2(v[2], v[3]));
                }
            __builtin_amdgcn_sched_barrier(0);
        }
}
template <bool KSUM>
__device__ __forceinline__ void epi_key(const P& p, bf16_t* dst, Acc8& acc, int tok0, int wr, int fr, int fq, unsigned* kmax2, float* ks) {
    f32x4 sum[2][2];
#pragma unroll
    for (int bj = 0; bj < 2; ++bj)
#pragma unroll
        for (int n = 0; n < 2; ++n) sum[bj][n] = (f32x4){0.f, 0.f, 0.f, 0.f};
    float mx = 0.f;
#pragma unroll
    for (int ai = 0; ai < 2; ++ai)
#pragma unroll
        for (int m = 0; m < 4; ++m) {
            const int tok = tok0 + 128 * ai + 64 * wr + 16 * m + fr;
#pragma unroll
            for (int n = 0; n < 2; ++n) {
                const float* rt = p.rope + ((size_t)tok * 32 + n * 16 + 4 * fq) * 2;
                const f32x4 cs0 = *(const f32x4*)rt, cs1 = *(const f32x4*)(rt + 4);
                const float c[4] = {cs0[0], cs0[2], cs1[0], cs1[2]}, sn[4] = {cs0[1], cs0[3], cs1[1], cs1[3]};
#pragma unroll
                for (int j = 0; j < 4; ++j) {
                    const float x1 = acc[ai][0][m][n][j], x2 = acc[ai][1][m][n][j];
                    acc[ai][0][m][n][j] = x1 * c[j] - x2 * sn[j];
                    acc[ai][1][m][n][j] = x2 * c[j] + x1 * sn[j];
                }
            }
            float ss = 0.f;
#pragma unroll
            for (int bj = 0; bj < 2; ++bj)
#pragma unroll
                for (int n = 0; n < 2; ++n) {
                    const f32x4 a = acc[ai][bj][m][n];
                    const unsigned w0 = pack2(a[0], a[1]), w1 = pack2(a[2], a[3]);
                    *(uint2*)(dst + (size_t)tok * 64 + 32 * bj + 16 * n + 4 * fq) = make_uint2(w0, w1);
                    const float e0 = __uint_as_float(w0 << 16), e1 = __uint_as_float(w0 & 0xffff0000u), e2 = __uint_as_float(w1 << 16), e3 = __uint_as_float(w1 & 0xffff0000u);
                    ss += (e0 * e0 + e1 * e1) + (e2 * e2 + e3 * e3);
                    if (KSUM) sum[bj][n] = sum[bj][n] + a;
                }
            ss += __shfl_xor(ss, 16);
            ss += __shfl_xor(ss, 32);
            mx = fmaxf(mx, ss);
            __builtin_amdgcn_sched_barrier(0);
        }
#pragma unroll
    for (int o = 8; o > 0; o >>= 1) mx = fmaxf(mx, __shfl_xor(mx, o));
    if ((otid() & 63) == 0) atomicMax(kmax2, __float_as_uint(mx));
    if (KSUM) {
#pragma unroll
        for (int bj = 0; bj < 2; ++bj)
#pragma unroll
            for (int n = 0; n < 2; ++n) {
                f32x4 sv = sum[bj][n];
#pragma unroll
                for (int o = 1; o < 16; o <<= 1) { sv[0] += __shfl_xor(sv[0], o); sv[1] += __shfl_xor(sv[1], o); sv[2] += __shfl_xor(sv[2], o); sv[3] += __shfl_xor(sv[3], o); }
                if (fr == 0) {
#pragma unroll
                    for (int j = 0; j < 4; ++j) atomicAdd(ks + 32 * bj + 16 * n + 4 * fq + j, sv[j]);
                }
            }
    }
}
__device__ __forceinline__ void epi_vT(bf16_t* dst  , Acc8& acc, int tok0, int wr, int fr, int fq) {
#pragma unroll
    for (int ai = 0; ai < 2; ++ai)
#pragma unroll
        for (int m = 0; m < 4; ++m)
#pragma unroll
            for (int bj = 0; bj < 2; ++bj)
#pragma unroll
                for (int n = 0; n < 2; ++n) {
                    const f32x4 v = acc[ai][bj][m][n];
                    *(uint2*)(dst + (size_t)(32 * bj + 16 * n + fr) * T_ + tok0 + 128 * ai + 64 * wr + 16 * m + 4 * fq) = make_uint2(pack2(v[0], v[1]), pack2(v[2], v[3]));
                }
}

template <bool TR, class NtFn, class EpiFn>
__device__ __forceinline__ void typed_loop(const P& p, char* lds, const bf16_t* W, int& base, int count, NtFn ntile_of, EpiFn epi) {
    const int G = gridDim.x, bidx = blockIdx.x, b0 = base;
    const int l = (((bidx - b0) % G) + G) % G;
    const int ul = l < count ? xcd_remap(l, count) : -1;
    gemm8_units<TR>([&](int k) { return (k == 0 && ul >= 0) ? ul : -1; }, DM, lds, p.xb,
        [&](int t) { int mt, nt; ntile_of(t, mt, nt); return g8_dense_a(mt * 256, DM); },
        [&](int t) { int mt, nt; ntile_of(t, mt, nt); return W + (size_t)nt * 256 * DM; },
        [&](int t, Acc8& acc, int wr, int wc, int fr, int fq) { int mt, nt; ntile_of(t, mt, nt); epi(acc, mt, nt, mt * 256, wr, wc, fr, fq); });
    base += count;
}

template <int LAYER>
__device__ __forceinline__ void phase_inproj(const P& p, char* lds) {
    int base = 0;
    if (LAYER == 0) {
        const bf16_t* W = p.wb_ab_in;
        typed_loop<true>(p, lds, W, base, 128, [](int i, int& mt, int& nt) { mt = i >> 1; nt = i & 1; },
            [&](Acc8& acc, int mt, int nt, int tok0, int wr, int wc, int fr, int fq) {
                epi_rows<false>(p, p.q16 + (size_t)(nt * 4 + wc) * T_ * 64, 64, acc, tok0, wr, fr, fq, 0.125f); });
        typed_loop<true>(p, lds, W, base, 128, [](int i, int& mt, int& nt) { mt = i >> 1; nt = 2 + (i & 1); },
            [&](Acc8& acc, int mt, int nt, int tok0, int wr, int wc, int fr, int fq) {
                epi_rows<false>(p, p.k16 + (size_t)((nt - 2) * 4 + wc) * T_ * 64, 64, acc, tok0, wr, fr, fq, 1.0f); });
        typed_loop<false>(p, lds, W, base, 256, [](int i, int& mt, int& nt) { mt = i >> 2; const int vi = i & 3; nt = (vi < 2 ? 4 : 8) + vi; },
            [&](Acc8& acc, int mt, int nt, int tok0, int wr, int wc, int fr, int fq) {
                const int head = (nt < 6 ? 0 : 8) + (nt & 1) * 4 + wc;
                epi_vT(p.vT16 + (size_t)head * 64 * T_, acc, tok0, wr, fr, fq); });
        typed_loop<true>(p, lds, W, base, 128, [](int i, int& mt, int& nt) { mt = i >> 1; nt = 6 + (i & 1); },
            [&](Acc8& acc, int mt, int nt, int tok0, int wr, int wc, int fr, int fq) {
                epi_rows<true>(p, p.q16 + (size_t)(8 + (nt - 6) * 4 + wc) * T_ * 64, 64, acc, tok0, wr, fr, fq, 0.125f * LOG2E); });
        typed_loop<true>(p, lds, W, base, 128, [](int i, int& mt, int& nt) { mt = i >> 1; nt = 8 + (i & 1); },
            [&](Acc8& acc, int mt, int nt, int tok0, int wr, int wc, int fr, int fq) {
                const int hd = (nt - 8) * 4 + wc;
                epi_key<true>(p, p.k16 + (size_t)(8 + hd) * T_ * 64, acc, tok0, wr, fr, fq, p.kmax2 + 8 + hd, p.ksum + ((size_t)hd * 64 + mt) * 64); });
    } else {
        const bf16_t* W = p.wb_c_in;
        typed_loop<true>(p, lds, W, base, 256, [](int i, int& mt, int& nt) { mt = i >> 2; nt = i & 3; },
            [&](Acc8& acc, int mt, int nt, int tok0, int wr, int wc, int fr, int fq) {
                epi_rows<true>(p, p.q16 + (size_t)(nt * 4 + wc) * T_ * 64, 64, acc, tok0, wr, fr, fq, 0.125f * LOG2E); });
        typed_loop<true>(p, lds, W, base, 256, [](int i, int& mt, int& nt) { mt = i >> 2; nt = 4 + (i & 3); },
            [&](Acc8& acc, int mt, int nt, int tok0, int wr, int wc, int fr, int fq) {
                const int hd = (nt - 4) * 4 + wc;
                epi_key<false>(p, p.k16 + (size_t)hd * T_ * 64, acc, tok0, wr, fr, fq, p.kmax2 + 16 + hd, nullptr); });
        typed_loop<false>(p, lds, W, base, 256, [](int i, int& mt, int& nt) { mt = i >> 2; nt = 8 + (i & 3); },
            [&](Acc8& acc, int mt, int nt, int tok0, int wr, int wc, int fr, int fq) {
                epi_vT(p.vT16 + (size_t)((nt - 8) * 4 + wc) * 64 * T_, acc, tok0, wr, fr, fq); });
        typed_loop<true>(p, lds, W, base, 128, [](int i, int& mt, int& nt) { mt = i >> 1; nt = 12 + (i & 1); },
            [&](Acc8& acc, int mt, int nt, int tok0, int wr, int wc, int fr, int fq) {
                const int hd = (nt - 12) * 4 + wc;
                epi_rows<true>(p, p.qi + (size_t)hd * 64, 512, acc, tok0, wr, fr, fq, 0.125f); });
        typed_loop<true>(p, lds, W, base, 64, [](int i, int& mt, int& nt) { mt = i; nt = 14; },
            [&](Acc8& acc, int mt, int nt, int tok0, int wr, int wc, int fr, int fq) {
                if (wc == 0) {
                    epi_rows<true>(p, p.ki, 64, acc, tok0, wr, fr, fq, 1.0f);
                } else if (wc == 1 && fq < 2) {
#pragma unroll
                    for (int ai = 0; ai < 2; ++ai)
#pragma unroll
                        for (int m = 0; m < 4; ++m)
                            *(f32x4*)(p.wi + (size_t)(tok0 + 128 * ai + 64 * wr + 16 * m + fr) * 8 + 4 * fq) = acc[ai][0][m][0] * 0.35355339059327373f;
                } });
    }
}
__device__ __forceinline__ void phase_outproj(const P& p, const bf16_t* W, const float* xres, char* lds) {
    gemm8_units<true>(RoundUnits{64 * 4}, DM, lds, p.o,
        [&](int t) { return g8_dense_a((t >> 2) * 256, DM); },
        [&](int t) { return W + (size_t)(t & 3) * 256 * DM; },
        [&](int t, Acc8& acc, int wr, int wc, int fr, int fq) {
            const int mt = t >> 2, nt = t & 3;
#pragma unroll
            for (int ai = 0; ai < 2; ++ai)
#pragma unroll
                for (int m = 0; m < 4; ++m)
#pragma unroll
                    for (int bj = 0; bj < 2; ++bj)
#pragma unroll
                        for (int n = 0; n < 2; ++n) {
                            const size_t off = (size_t)(mt * 256 + 128 * ai + 64 * wr + 16 * m + fr) * DM + nt * 256 + 64 * wc + 32 * bj + 16 * n + 4 * fq;
                            const f32x4 xr = *(const f32x4*)(xres + off);
                            *(f32x4*)(p.ypre + off) = xr * DN_ALPHA + acc[ai][bj][m][n];
                        }
        });
}

__device__ __forceinline__ void ln_row(f32x4 (&v)[4], const float* g, const float* b, int lane) {
    float s = 0.f;
#pragma unroll
    for (int c = 0; c < 4; ++c) s += (v[c][0] + v[c][1]) + (v[c][2] + v[c][3]);
    const float mu = wave_sum(s) * (1.0f / DM);
    float q = 0.f;
#pragma unroll
    for (int c = 0; c < 4; ++c) {
        v[c] = v[c] - mu;
        q += (v[c][0] * v[c][0] + v[c][1] * v[c][1]) + (v[c][2] * v[c][2] + v[c][3] * v[c][3]);
    }
    const float rstd = 1.0f / sqrtf(wave_sum(q) * (1.0f / DM) + 1e-5f);
#pragma unroll
    for (int c = 0; c < 4; ++c) {
        const f32x4 gg = *(const f32x4*)(g + 4 * lane + 256 * c), bb = *(const f32x4*)(b + 4 * lane + 256 * c);
        v[c] = v[c] * rstd * gg + bb;
    }
}

#define RT_XS_STRIDE 1025
#define RT_RED_OFF (32 * RT_XS_STRIDE * 4)
#define RT_DEC_OFF (RT_RED_OFF + 16384)
__device__ __forceinline__ void phase_ln_router(const P& p, int layer, char* lds) {
    const int tid = otid(), lane = tid & 63, wid = tid >> 6;
    float* xs = (float*)lds;
    float* red = (float*)(lds + RT_RED_OFF);
    int* dec = (int*)(lds + RT_DEC_OFF);
    float* decg = (float*)(lds + RT_DEC_OFF + 1024);
    int* lcnt = (int*)(lds + RT_DEC_OFF + 2048);
    int* gbase = lcnt + 32;
    const float* g = p.ln_g + (size_t)(layer * 2 + 0) * DM;
    const float* b = p.ln_b + (size_t)(layer * 2 + 0) * DM;
    const float* wr_ = p.router_w + (size_t)layer * DM * NEXP;
    const float* br_ = p.router_b + layer * NEXP;
    int* cnt = p.cnt + layer * NEXP;
#pragma unroll 1
    for (int itb = 0; (blockIdx.x + itb * gridDim.x) * 32 < T_; itb += 2) {
    __syncthreads();
    if (tid < 32) lcnt[tid] = 0;
#pragma unroll 1
    for (int it = 0; it < 2; ++it) {
        const int t0 = (blockIdx.x + (itb + it) * gridDim.x) * 32;
        if (t0 >= T_) break;
#pragma unroll 1
        for (int r = 0; r < 4; ++r) {
            const int tl_ = wid * 4 + r, tok = t0 + tl_;
            f32x4 v[4];
#pragma unroll
            for (int c = 0; c < 4; ++c) v[c] = *(const f32x4*)(p.ypre + (size_t)tok * DM + 4 * lane + 256 * c);
            ln_row(v, g, b, lane);
#pragma unroll
            for (int c = 0; c < 4; ++c) {
                *(f32x4*)(p.x1 + (size_t)tok * DM + 4 * lane + 256 * c) = v[c];
                *(uint2*)(p.x1b + (size_t)tok * DM + 4 * lane + 256 * c) = make_uint2(pack2(v[c][0], v[c][1]), pack2(v[c][2], v[c][3]));
                float* xr = xs + tl_ * RT_XS_STRIDE + 4 * lane + 256 * c;
                xr[0] = v[c][0]; xr[1] = v[c][1]; xr[2] = v[c][2]; xr[3] = v[c][3];
            }
        }
        __syncthreads();
        f32x16 d;
#pragma unroll
        for (int i = 0; i < 16; ++i) d[i] = 0.f;
        {
            const int i_ = lane & 31, kk = lane >> 5;
            const float* xa = xs + i_ * RT_XS_STRIDE + wid * 128 + kk;
            const float* wb = wr_ + (size_t)(wid * 128 + kk) * NEXP + i_;
#pragma unroll 8
            for (int s = 0; s < 64; ++s) d = __builtin_amdgcn_mfma_f32_32x32x2f32(xa[2 * s], wb[(size_t)(2 * s) * NEXP], d, 0, 0, 0);
        }
#pragma unroll
        for (int step = 4; step >= 1; step >>= 1) {
            if (wid >= step && wid < 2 * step) {
                float* rb = red + (wid - step) * 1024;
#pragma unroll
                for (int i = 0; i < 16; ++i) rb[i * 64 + lane] = d[i];
            }
            __syncthreads();
            if (wid < step) {
                const float* rb = red + wid * 1024;
#pragma unroll
                for (int i = 0; i < 16; ++i) d[i] += rb[i * 64 + lane];
            }
            __syncthreads();
        }
        if (wid == 0) {
#pragma unroll
            for (int i = 0; i < 16; ++i) red[((i & 3) + 8 * (i >> 2) + 4 * (lane >> 5)) * 32 + (lane & 31)] = d[i];
        }
        __syncthreads();
#pragma unroll
        for (int r = 0; r < 2; ++r) {
            const int e = lane & 31, hf = lane >> 5, tl_ = wid * 4 + 2 * r + hf;
            float cur = red[tl_ * 32 + e] + br_[e];
            float tv[4]; int ti[4];
#pragma unroll
            for (int k = 0; k < 4; ++k) {
                float mv = cur;
#pragma unroll
                for (int o = 16; o > 0; o >>= 1) mv = fmaxf(mv, __shfl_xor(mv, o));
                const unsigned long long bal = __ballot(cur == mv);
                const unsigned bh = hf ? (unsigned)(bal >> 32) : (unsigned)bal;
                const int idx = __ffs(bh) - 1;
                tv[k] = mv; ti[k] = idx;
                if (e == idx) cur = -3.0e38f;
            }
            const float e1 = __expf(tv[1] - tv[0]), e2 = __expf(tv[2] - tv[0]), e3 = __expf(tv[3] - tv[0]);
            const float inv = 1.0f / (1.0f + e1 + e2 + e3);
            if (e < 4) {
                const int ee = e == 0 ? ti[0] : e == 1 ? ti[1] : e == 2 ? ti[2] : ti[3];
                const float gg = e == 0 ? inv : e == 1 ? e1 * inv : e == 2 ? e2 * inv : e3 * inv;
                const int lpos = atomicAdd(lcnt + ee, 1);
                dec[(it * 32 + tl_) * 4 + e] = ee | (lpos << 8);
                decg[(it * 32 + tl_) * 4 + e] = gg;
            }
        }
        __syncthreads();
    }
    if (tid < 32) gbase[tid] = lcnt[tid] > 0 ? atomicAdd(cnt + tid, lcnt[tid]) : 0;
    __syncthreads();
    if (tid < 256) {
        const int it = tid >> 7, t0 = (blockIdx.x + (itb + it) * gridDim.x) * 32;
        if (t0 < T_) {
            const int tok = t0 + ((tid >> 2) & 31), k = tid & 3;
            const int dv = dec[tid], ee = dv & 255, pos = gbase[ee] + (dv >> 8);
            p.tok_of[(size_t)ee * T_ + pos] = tok;
            p.sel_e[tok * 4 + k] = ee;
            p.sel_pos[tok * 4 + k] = pos;
            p.sel_g[tok * 4 + k] = decg[tid];
        }
    }
    }
    __syncthreads();
}

__device__ __forceinline__ void moe_prefix(const int* cnt, int* mpre) {
    if (otid() == 0) {
        int s = 0;
        for (int e = 0; e < NEXP; ++e) { mpre[e] = s; s += (cnt[e] + 255) >> 8; }
        mpre[NEXP] = s;
    }
    __syncthreads();
}
#define MPRE_OFF G_LDS_B

__device__ __forceinline__ void phase_moe1(const P& p, int layer, char* lds) {
    int* mpre = (int*)(lds + MPRE_OFF);
    const int* cnt = p.cnt + layer * NEXP;
    moe_prefix(cnt, mpre);
    const int total = mpre[NEXP] * 8;
    auto expert_of = [&](int mg) { int e = 0;
#pragma unroll 1
        while (mpre[e + 1] <= mg) ++e;
        return e; };
    gemm8_units<true>(RoundUnits{total}, DM, lds, p.x1b,
        [&](int t) {
            const int mg = t >> 3, e = expert_of(mg), i = mg - mpre[e], ce_ = cnt[e];
            const int* tk = p.tok_of + (size_t)e * T_;
            AOff a; int R, C;
#pragma unroll
            for (int ii = 0; ii < 2; ++ii) {
                g8_rc(ii, R, C);
                const int p0 = i * 256 + R, p1 = p0 + 128;
                a.o[0][ii] = (unsigned)(((size_t)tk[p0 < ce_ ? p0 : 0] * DM + C) * 2);
                a.o[1][ii] = (unsigned)(((size_t)tk[p1 < ce_ ? p1 : 0] * DM + C) * 2);
            }
            return a;
        },
        [&](int t) { const int mg = t >> 3, nt = t & 7, e = expert_of(mg); return p.wb_w1 + ((size_t)(layer * NEXP + e) * 2048 + nt * 256) * DM; },
        [&](int t, Acc8& acc, int wr, int wc, int fr, int fq) {
            const int mg = t >> 3, nt = t & 7, e = expert_of(mg);
            const float* b1 = p.moe_b1 + (size_t)(layer * NEXP + e) * 2048;
#pragma unroll
            for (int n = 0; n < 2; ++n) {
                const int j0 = nt * 128 + wc * 32 + n * 16 + 4 * fq;
                float bg[4], bu[4];
#pragma unroll
                for (int j = 0; j < 4; ++j) { bg[j] = b1[2 * (j0 + j)]; bu[j] = b1[2 * (j0 + j) + 1]; }
#pragma unroll
                for (int ai = 0; ai < 2; ++ai)
#pragma unroll
                    for (int m = 0; m < 4; ++m) {
                        float r[4];
#pragma unroll
                        for (int j = 0; j < 4; ++j) {
                            const float gv = fminf(acc[ai][0][m][n][j] + bg[j], 7.0f);
                            const float uv = fminf(fmaxf(acc[ai][1][m][n][j] + bu[j], -7.0f), 7.0f);
                            const float glu = gv * sigmoidf_(1.702f * gv);
                            r[j] = (uv + 1.0f) * glu;
                        }
                        const size_t slot = (size_t)mg * 256 + 128 * ai + 64 * wr + 16 * m + fr;
                        *(uint2*)(p.act + slot * DM + j0) = make_uint2(pack2(r[0], r[1]), pack2(r[2], r[3]));
                    }
            }
        },
        [&](int t) { const int mg = t >> 3, e = expert_of(mg); return cnt[e] - (mg - mpre[e]) * 256 <= 128; });
}

__device__ __forceinline__ void phase_moe2(const P& p, int layer, char* lds) {
    int* mpre = (int*)(lds + MPRE_OFF);
    const int* cnt = p.cnt + layer * NEXP;
    moe_prefix(cnt, mpre);
    const int total = mpre[NEXP] * 4;
    auto expert_of = [&](int mg) { int e = 0;
#pragma unroll 1
        while (mpre[e + 1] <= mg) ++e;
        return e; };
    gemm8_units<true>(RoundUnits{total}, DM, lds, p.act,
        [&](int t) { return g8_dense_a((t >> 2) * 256, DM); },
        [&](int t) { const int mg = t >> 2, nt = t & 3, e = expert_of(mg); return p.wb_w2 + ((size_t)(layer * NEXP + e) * 1024 + nt * 256) * DM; },
        [&](int t, Acc8& acc, int wr, int wc, int fr, int fq) {
            const int mg = t >> 2, nt = t & 3, e = expert_of(mg);
            const float* b2 = p.moe_b2 + (size_t)(layer * NEXP + e) * DM;
#pragma unroll
            for (int ai = 0; ai < 2; ++ai)
#pragma unroll
                for (int m = 0; m < 4; ++m)
#pragma unroll
                    for (int bj = 0; bj < 2; ++bj)
#pragma unroll
                        for (int n = 0; n < 2; ++n) {
                            const int col = nt * 256 + 64 * wc + 32 * bj + 16 * n + 4 * fq;
                            const f32x4 v = acc[ai][bj][m][n] + *(const f32x4*)(b2 + col);
                            const size_t slot = (size_t)mg * 256 + 128 * ai + 64 * wr + 16 * m + fr;
                            *(uint2*)(p.oslot + slot * DM + col) = make_uint2(pack2(v[0], v[1]), pack2(v[2], v[3]));
                        }
        },
        [&](int t) { const int mg = t >> 2, e = expert_of(mg); return cnt[e] - (mg - mpre[e]) * 256 <= 128; });
}

__device__ __forceinline__ void phase_combine_ln(const P& p, int layer, char* lds) {
    const int tid = otid(), lane = tid & 63, wid = tid >> 6;
    int* mpre = (int*)(lds + MPRE_OFF);
    moe_prefix(p.cnt + layer * NEXP, mpre);
    const float* g = p.ln_g + (size_t)(layer * 2 + 1) * DM;
    const float* b = p.ln_b + (size_t)(layer * 2 + 1) * DM;
#pragma unroll 1
    for (int tok = blockIdx.x * NWAVE + wid; tok < T_; tok += gridDim.x * NWAVE) {
        f32x4 v[4];
#pragma unroll
        for (int c = 0; c < 4; ++c) v[c] = *(const f32x4*)(p.x1 + (size_t)tok * DM + 4 * lane + 256 * c) * DN_ALPHA;
        f32x4 f[4];
#pragma unroll
        for (int c = 0; c < 4; ++c) f[c] = (f32x4){0.f, 0.f, 0.f, 0.f};
#pragma unroll
        for (int k = 0; k < 4; ++k) {
            const int e = p.sel_e[tok * 4 + k], pos = p.sel_pos[tok * 4 + k];
            const float gt = p.sel_g[tok * 4 + k];
            const bf16_t* row = p.oslot + ((size_t)mpre[e] * 256 + pos) * DM;
#pragma unroll
            for (int c = 0; c < 4; ++c) {
                const uint2 w = *(const uint2*)(row + 4 * lane + 256 * c);
                f[c][0] += gt * __uint_as_float(w.x << 16);
                f[c][1] += gt * __uint_as_float(w.x & 0xffff0000u);
                f[c][2] += gt * __uint_as_float(w.y << 16);
                f[c][3] += gt * __uint_as_float(w.y & 0xffff0000u);
            }
        }
#pragma unroll
        for (int c = 0; c < 4; ++c) v[c] = v[c] + f[c];
        ln_row(v, g, b, lane);
#pragma unroll
        for (int c = 0; c < 4; ++c) {
            *(f32x4*)(p.x2 + (size_t)tok * DM + 4 * lane + 256 * c) = v[c];
            *(uint2*)(p.x2b + (size_t)tok * DM + 4 * lane + 256 * c) = make_uint2(pack2(v[c][0], v[c][1]), pack2(v[c][2], v[c][3]));
        }
    }
}

__device__ __forceinline__ void phase_ple(const P& p, int layer, float* xout, char* lds) {
    const float* pp = p.pp + (size_t)layer * T_ * DM;
    gemm8_units<true>(RoundUnits{64 * 4}, DM, lds, p.x2b,
        [&](int t) { return g8_dense_a((t >> 2) * 256, DM); },
        [&](int t) { return p.wb_g + (size_t)layer * DM * DM + (size_t)(t & 3) * 256 * DM; },
        [&](int t, Acc8& acc, int wr, int wc, int fr, int fq) {
            const int mt = t >> 2, nt = t & 3;
#pragma unroll
            for (int ai = 0; ai < 2; ++ai)
#pragma unroll
                for (int m = 0; m < 4; ++m)
#pragma unroll
                    for (int bj = 0; bj < 2; ++bj)
#pragma unroll
                        for (int n = 0; n < 2; ++n) {
                            const size_t off = (size_t)(mt * 256 + 128 * ai + 64 * wr + 16 * m + fr) * DM + nt * 256 + 64 * wc + 32 * bj + 16 * n + 4 * fq;
                            const f32x4 x2v = *(const f32x4*)(p.x2 + off), ppv = *(const f32x4*)(pp + off);
                            f32x4 r;
#pragma unroll
                            for (int j = 0; j < 4; ++j) r[j] = x2v[j] + sigmoidf_(acc[ai][bj][m][n][j]) * ppv[j];
                            *(f32x4*)(xout + off) = r;
                            *(uint2*)(p.xb + off) = make_uint2(pack2(r[0], r[1]), pack2(r[2], r[3]));
                        }
        });
}
#define KROW 144
#define VROW 136
#define KTILE_B (64 * KROW)
#define VTILE_B (64 * VROW)
#define ABUF_B (KTILE_B + VTILE_B)

struct TileRegs { u32x4 k0, v0; };

__device__ __forceinline__ void tile_gload(TileRegs& r, const bf16_t* kbase  , const bf16_t* vtbase  , int k0) {
    const int ci = otid(), row = ci >> 3, cc = ci & 7;
    r.k0 = *(const u32x4*)(kbase + (size_t)(k0 + row) * 64 + cc * 8);
    r.v0 = *(const u32x4*)(vtbase + (size_t)row * T_ + k0 + cc * 8);
}
__device__ __forceinline__ void tile_swrite(const TileRegs& r, char* buf) {
    const int ci = otid(), row = ci >> 3, cc = ci & 7;
    *(u32x4*)(buf + row * KROW + cc * 16) = r.k0;
    *(uint2*)(buf + KTILE_B + row * VROW + cc * 16) = make_uint2(r.v0[0], r.v0[1]);
    *(uint2*)(buf + KTILE_B + row * VROW + cc * 16 + 8) = make_uint2(r.v0[2], r.v0[3]);
}

__device__ __forceinline__ void load_qfrag(bf16x8 (&qf)[4], const bf16_t* qrow  , int h) {
#pragma unroll
    for (int kk = 0; kk < 4; ++kk) qf[kk] = *(const bf16x8*)(qrow + 16 * kk + 8 * h);
}
__device__ __forceinline__ float qnorm2(const bf16x8 (&qf)[4]) {
    float s = 0.f;
#pragma unroll
    for (int kk = 0; kk < 4; ++kk)
#pragma unroll
        for (int j = 0; j < 8; ++j) { const float e = bf2f((bf16_t)qf[kk][j]); s += e * e; }
    return s + __shfl_xor(s, 32);
}

__device__ __forceinline__ f32x16 qk_subtile(const char* kbuf, int t2, const bf16x8 (&qf)[4], int c, int h) {
    f32x16 s;
#pragma unroll
    for (int i = 0; i < 16; ++i) s[i] = 0.f;
#pragma unroll
    for (int kk = 0; kk < 4; ++kk) {
        const bf16x8 kf = *(const bf16x8*)(kbuf + (32 * t2 + c) * KROW + (16 * kk + 8 * h) * 2);
        s = __builtin_amdgcn_mfma_f32_32x32x16_bf16(kf, qf[kk], s, 0, 0, 0);
    }
    return s;
}

__device__ __forceinline__ void pv_subtile(const char* vbuf, int t2, const float (&pr)[16], f32x16 (&o)[2], int c, int h) {
#pragma unroll
    for (int s = 0; s < 2; ++s) {
        u32x4 pbu;
#pragma unroll
        for (int j = 0; j < 4; ++j) pbu[j] = pack2(pr[8 * s + 2 * j], pr[8 * s + 2 * j + 1]);
        const bf16x8 pbv = __builtin_bit_cast(bf16x8, pbu);
#pragma unroll
        for (int dt = 0; dt < 2; ++dt) {
            const char* a = vbuf + (32 * dt + c) * VROW + (32 * t2 + 16 * s + 4 * h) * 2;
            const uint2 lo = *(const uint2*)a, hi = *(const uint2*)(a + 16);
            const u32x4 vfu = {lo.x, lo.y, hi.x, hi.y};
            o[dt] = __builtin_amdgcn_mfma_f32_32x32x16_bf16(__builtin_bit_cast(bf16x8, vfu), pbv, o[dt], 0, 0, 0);
        }
    }
}

__device__ __forceinline__ void store_o(bf16_t* orow  , const f32x16 (&o)[2], int h, float scale) {
#pragma unroll
    for (int dt = 0; dt < 2; ++dt)
#pragma unroll
        for (int g = 0; g < 4; ++g) {
            const int d = 32 * dt + 8 * g + 4 * h;
            *(uint2*)(orow + d) = make_uint2(pack2(o[dt][4 * g] * scale, o[dt][4 * g + 1] * scale), pack2(o[dt][4 * g + 2] * scale, o[dt][4 * g + 3] * scale));
        }
}

#define SB_STOP 32.0f
__device__ __forceinline__ void phase_sb(const P& p, char* lds) {
    const int tid = otid(), lane = tid & 63, w = tid >> 6, c = lane & 31, h = lane >> 5;
#pragma unroll 1
    for (int t = blockIdx.x; t < 8 * 64; t += gridDim.x) {
        const int head = t & 7, qb = 63 - (t >> 3);
        const int q0 = qb * 256, qw = q0 + 32 * w, query = qw + c;
        const bf16_t* kbase = p.k16 + (size_t)head * T_ * 64;
        const bf16_t* vtbase = p.vT16 + (size_t)head * 64 * T_;
        bf16x8 qf[4];
        load_qfrag(qf, p.q16 + ((size_t)head * T_ + query) * 64, h);
        f32x16 o[2];
#pragma unroll
        for (int i = 0; i < 16; ++i) { o[0][i] = 0.f; o[1][i] = 0.f; }
        float R = 0.f;
        int kt = (q0 + 255) >> 6;
        TileRegs tr;
        tile_gload(tr, kbase, vtbase, kt * 64);
        __syncthreads();
        tile_swrite(tr, lds);
        __syncthreads();
        int buf = 0;
#pragma unroll 1
        for (;;) {
            const bool more = kt > 0;
            if (more) tile_gload(tr, kbase, vtbase, (kt - 1) * 64);
            const char* kb = lds + buf * ABUF_B;
            const char* vb = kb + KTILE_B;
            const int k0 = kt * 64;
#pragma unroll
            for (int t2 = 1; t2 >= 0; --t2) {
                const int keybase = k0 + 32 * t2;
                if (keybase < qw + 31) {
                    const f32x16 s = qk_subtile(kb, t2, qf, c, h);
                    const bool need_mask = keybase + 31 >= qw;
                    float L[16], E[16];
#pragma unroll
                    for (int r = 0; r < 16; ++r) {
                        const float z2 = s[r] * LOG2E;
                        const int zb = __float_as_int(z2);
                        float l = __int_as_float(zb > 0 ? zb : 0) + flog2(1.0f + fexp2(-fabsf(z2)));
                        const int key = keybase + (r & 3) + 8 * (r >> 2) + 4 * h;
                        const bool valid = !need_mask || key < query;
                        l = valid ? l : 0.f;
                        L[r] = l;
                        E[r] = valid ? (z2 - l) : -1.0e30f;
                    }
                    float gs[4], tot[4], ps[4];
#pragma unroll
                    for (int g = 0; g < 4; ++g) {
                        gs[g] = (L[4 * g] + L[4 * g + 1]) + (L[4 * g + 2] + L[4 * g + 3]);
                        ps[g] = __shfl_xor(gs[g], 32);
                        tot[g] = gs[g] + ps[g];
                    }
                    float above[4];
                    above[3] = (h == 0 ? ps[3] : 0.f);
                    above[2] = tot[3] + (h == 0 ? ps[2] : 0.f);
                    above[1] = tot[3] + tot[2] + (h == 0 ? ps[1] : 0.f);
                    above[0] = tot[3] + tot[2] + tot[1] + (h == 0 ? ps[0] : 0.f);
                    float pr[16];
#pragma unroll
                    for (int g = 0; g < 4; ++g) {
                        float run = R + above[g];
#pragma unroll
                        for (int i = 3; i >= 0; --i) {
                            pr[4 * g + i] = fexp2(E[4 * g + i] - run);
                            run += L[4 * g + i];
                        }
                    }
                    R += (tot[0] + tot[1]) + (tot[2] + tot[3]);
                    pv_subtile(vb, t2, pr, o, c, h);
                }
            }
            const int done = __syncthreads_and(R > SB_STOP);
            if (!more || done) break;
            tile_swrite(tr, lds + (buf ^ 1) * ABUF_B);
            __syncthreads();
            buf ^= 1;
            --kt;
        }
        store_o(p.o + (size_t)query * DM + head * 64, o, h, 1.0f);
    }
}

__device__ __forceinline__ void softmax_subtile(const f32x16& s, unsigned W, float M2, float& l, f32x16 (&o)[2], const char* vb, int t2, int c, int h) {
    const unsigned Wh = W >> (4 * h);
    float pr[16];
    float ls = 0.f;
#pragma unroll
    for (int r = 0; r < 16; ++r) {
        const bool ok = (Wh >> ((r & 3) + 8 * (r >> 2))) & 1u;
        const float pv = ok ? fexp2(s[r] * LOG2E - M2) : 0.f;
        pr[r] = pv;
        ls += pv;
    }
    l += ls;
    pv_subtile(vb, t2, pr, o, c, h);
}

__device__ __forceinline__ unsigned causal_word(int query, int keybase) {
    const int nk = query - keybase + 1;
    return nk >= 32 ? 0xffffffffu : (nk <= 0 ? 0u : ((1u << nk) - 1u));
}
__device__ __forceinline__ float shift_bound_l2(float qn2, unsigned kmax2_bits) {
    return fminf(sqrtf(qn2 * __uint_as_float(kmax2_bits)) * 1.002f, 64.0f);
}
__device__ __forceinline__ float shift_bound(float qn2, unsigned kmax2_bits) {
    const float b = sqrtf(qn2 * __uint_as_float(kmax2_bits)) * (LOG2E * 1.002f);
    return fminf(b, 64.0f);
}

__device__ __forceinline__ void attn_tile64(const char* kb, const char* vb, const bf16x8 (&qf)[4], unsigned W0, unsigned W1, float M2, float& l, f32x16 (&o)[2], int c, int h) {
    bf16x8 k0[4], k1[4];
#pragma unroll
    for (int kk = 0; kk < 4; ++kk) {
        k0[kk] = *(const bf16x8*)(kb + c * KROW + (16 * kk + 8 * h) * 2);
        k1[kk] = *(const bf16x8*)(kb + (32 + c) * KROW + (16 * kk + 8 * h) * 2);
    }
    const unsigned Wh0 = W0 >> (4 * h), Wh1 = W1 >> (4 * h);
    f32x16 s0, s1;
#pragma unroll
    for (int r = 0; r < 16; ++r) {
        const int bit = (r & 3) + 8 * (r >> 2);
        s0[r] = ((Wh0 >> bit) & 1u) ? -M2 : -1.0e30f;
        s1[r] = ((Wh1 >> bit) & 1u) ? -M2 : -1.0e30f;
    }
#pragma unroll
    for (int kk = 0; kk < 4; ++kk) {
        s0 = __builtin_amdgcn_mfma_f32_32x32x16_bf16(k0[kk], qf[kk], s0, 0, 0, 0);
        s1 = __builtin_amdgcn_mfma_f32_32x32x16_bf16(k1[kk], qf[kk], s1, 0, 0, 0);
    }
    u32x4 vf[2][2][2];
#pragma unroll
    for (int t2 = 0; t2 < 2; ++t2)
#pragma unroll
        for (int sI = 0; sI < 2; ++sI)
#pragma unroll
            for (int dt = 0; dt < 2; ++dt) {
                const char* a = vb + (32 * dt + c) * VROW + (32 * t2 + 16 * sI + 4 * h) * 2;
                const uint2 lo = *(const uint2*)a, hi = *(const uint2*)(a + 16);
                vf[t2][sI][dt] = (u32x4){lo.x, lo.y, hi.x, hi.y};
            }
    u32x4 pb[2][2];
    f32v2_ ls2 = {0.f, 0.f};
#pragma unroll
    for (int sI = 0; sI < 2; ++sI) {
        f32v2_ pa[4], pc[4];
#pragma unroll
        for (int j = 0; j < 4; ++j) {
            const int r = 8 * sI + 2 * j;
            pa[j][0] = fexp2(s0[r]); pa[j][1] = fexp2(s0[r + 1]);
            pc[j][0] = fexp2(s1[r]); pc[j][1] = fexp2(s1[r + 1]);
            ls2 = ls2 + pa[j] + pc[j];
        }
        pb[0][sI] = (u32x4){pack2(pa[0][0], pa[0][1]), pack2(pa[1][0], pa[1][1]), pack2(pa[2][0], pa[2][1]), pack2(pa[3][0], pa[3][1])};
        pb[1][sI] = (u32x4){pack2(pc[0][0], pc[0][1]), pack2(pc[1][0], pc[1][1]), pack2(pc[2][0], pc[2][1]), pack2(pc[3][0], pc[3][1])};
    }
    l += ls2[0] + ls2[1];
#pragma unroll
    for (int t2 = 0; t2 < 2; ++t2)
#pragma unroll
        for (int sI = 0; sI < 2; ++sI)
#pragma unroll
            for (int dt = 0; dt < 2; ++dt)
                o[dt] = __builtin_amdgcn_mfma_f32_32x32x16_bf16(__builtin_bit_cast(bf16x8, vf[t2][sI][dt]), __builtin_bit_cast(bf16x8, pb[t2][sI]), o[dt], 0, 0, 0);
}

__device__ __forceinline__ void phase_moba_gate(const P& p, char* lds) {
    const int tid = otid(), lane = tid & 63, w = tid >> 6, c = lane & 31, h = lane >> 5;
#pragma unroll 1
    for (int t = blockIdx.x; t < 8 * 63; t += gridDim.x) {
        const int head = t & 7, cur = 63 - (t >> 3);
        const int query = cur * 256 + 32 * w + c;
        bf16x8 qf[4];
        load_qfrag(qf, p.q16 + ((size_t)(8 + head) * T_ + query) * 64, h);
        int sel0 = -1, sel1 = -1, sel2 = -1;
        __syncthreads();
        if (tid < 64) ((int*)(lds + 16384))[tid] = 0;
        {
            const int row = tid >> 3, cc = tid & 7;
            const float* ks = p.ksum + ((size_t)head * 64 + row) * 64 + cc * 8;
            const f32x4 a = *(const f32x4*)ks * (1.0f / 256.0f), b = *(const f32x4*)(ks + 4) * (1.0f / 256.0f);
            *(u32x4*)(lds + row * KROW + cc * 16) = (u32x4){pack2(a[0], a[1]), pack2(a[2], a[3]), pack2(b[0], b[1]), pack2(b[2], b[3])};
        }
        __syncthreads();
        float v0 = -3.0e38f, v1 = -3.0e38f, v2 = -3.0e38f;
#pragma unroll
        for (int t2 = 0; t2 < 2; ++t2) {
            const f32x16 s = qk_subtile(lds, t2, qf, c, h);
#pragma unroll
            for (int r = 0; r < 16; ++r) {
                const int n = 32 * t2 + (r & 3) + 8 * (r >> 2) + 4 * h;
                const float g = s[r];
                if (n < cur) {
                    if (g > v0) { v2 = v1; sel2 = sel1; v1 = v0; sel1 = sel0; v0 = g; sel0 = n; }
                    else if (g > v1) { v2 = v1; sel2 = sel1; v1 = g; sel1 = n; }
                    else if (g > v2) { v2 = g; sel2 = n; }
                }
            }
        }
        const float pv0 = __shfl_xor(v0, 32), pv1 = __shfl_xor(v1, 32), pv2 = __shfl_xor(v2, 32);
        const int pn0 = __shfl_xor(sel0, 32), pn1 = __shfl_xor(sel1, 32), pn2 = __shfl_xor(sel2, 32);
#pragma unroll
        for (int k = 0; k < 3; ++k) {
            const float g = k == 0 ? pv0 : (k == 1 ? pv1 : pv2);
            const int n = k == 0 ? pn0 : (k == 1 ? pn1 : pn2);
            if (n >= 0) {
                if (g > v0 || (g == v0 && n < sel0)) { v2 = v1; sel2 = sel1; v1 = v0; sel1 = sel0; v0 = g; sel0 = n; }
                else if (g > v1 || (g == v1 && n < sel1)) { v2 = v1; sel2 = sel1; v1 = g; sel1 = n; }
                else if (g > v2 || (g == v2 && n < sel2)) { v2 = g; sel2 = n; }
            }
        }
        int* lc = (int*)(lds + 16384);
        int* gb = lc + 64;
        int lp0 = 0, lp1 = 0, lp2 = 0;
        if (h == 0) {
            if (sel0 >= 0) lp0 = atomicAdd(lc + sel0, 1);
            if (sel1 >= 0) lp1 = atomicAdd(lc + sel1, 1);
            if (sel2 >= 0) lp2 = atomicAdd(lc + sel2, 1);
        }
        __syncthreads();
        if (tid < 64) gb[tid] = lc[tid] > 0 ? atomicAdd(p.mb_cnt + head * 64 + tid, lc[tid]) : 0;
        __syncthreads();
        if (h == 0) {
            if (sel0 >= 0) p.mb_list[((size_t)head * 64 + sel0) * T_ + gb[sel0] + lp0] = (query << 2) | 0;
            if (sel1 >= 0) p.mb_list[((size_t)head * 64 + sel1) * T_ + gb[sel1] + lp1] = (query << 2) | 1;
            if (sel2 >= 0) p.mb_list[((size_t)head * 64 + sel2) * T_ + gb[sel2] + lp2] = (query << 2) | 2;
        }
    }
}

#define MB_PRE_OFF (2 * ABUF_B)
__device__ __forceinline__ void phase_moba_sparse(const P& p, char* lds) {
    const int tid = otid(), lane = tid & 63, w = tid >> 6, c = lane & 31, h = lane >> 5;
    int* pre = (int*)(lds + MB_PRE_OFF);
    __syncthreads();
    if (tid < 64) {
        int loc[8]; int s = 0;
#pragma unroll
        for (int i = 0; i < 8; ++i) { loc[i] = (p.mb_cnt[tid * 8 + i] + 255) >> 8; s += loc[i]; }
        int incl = s;
#pragma unroll
        for (int o = 1; o < 64; o <<= 1) { const int v = __shfl_up(incl, o); if (tid >= o) incl += v; }
        int run = incl - s;
#pragma unroll
        for (int i = 0; i < 8; ++i) { pre[tid * 8 + i] = run; run += loc[i]; }
        if (tid == 63) pre[512] = run;
    }
    __syncthreads();
    const int total = pre[512];
#pragma unroll 1
    for (int u = blockIdx.x; u < total; u += gridDim.x) {
        int lo = 0, hi = 512;
#pragma unroll 1
        while (hi - lo > 1) { const int mid = (lo + hi) >> 1; if (pre[mid] <= u) lo = mid; else hi = mid; }
        const int li = lo, chunk = u - pre[li], head = li >> 6, n = li & 63;
        const int cnt = p.mb_cnt[li], idx = chunk * 256 + 32 * w + c;
        const bool valid = idx < cnt;
        const int ent = p.mb_list[(size_t)li * T_ + (valid ? idx : 0)];
        const int query = ent >> 2, slot = ent & 3;
        const bf16_t* kbase = p.k16 + (size_t)(8 + head) * T_ * 64;
        const bf16_t* vtbase = p.vT16 + (size_t)(8 + head) * 64 * T_;
        bf16x8 qf[4];
        load_qfrag(qf, p.q16 + ((size_t)(8 + head) * T_ + query) * 64, h);
        const float M2 = shift_bound_l2(qnorm2(qf), p.kmax2[8 + head]);
        f32x16 o[2];
#pragma unroll
        for (int i = 0; i < 16; ++i) { o[0][i] = 0.f; o[1][i] = 0.f; }
        float l = 0.f;
        TileRegs tr;
        tile_gload(tr, kbase, vtbase, n * 256);
        __syncthreads();
        tile_swrite(tr, lds);
        __syncthreads();
#pragma unroll 1
        for (int kt = 0; kt < 4; ++kt) {
            if (kt < 3) tile_gload(tr, kbase, vtbase, n * 256 + (kt + 1) * 64);
            const char* kb = lds + (kt & 1) * ABUF_B;
            attn_tile64(kb, kb + KTILE_B, qf, 0xffffffffu, 0xffffffffu, M2, l, o, c, h);
            if (kt < 3) {
                tile_swrite(tr, lds + ((kt + 1) & 1) * ABUF_B);
                __syncthreads();
            }
        }
        l += __shfl_xor(l, 32);
        if (valid) {
            float* po = p.mb_part + (((size_t)head * T_ + query) * 3 + slot) * 64;
#pragma unroll
            for (int dt = 0; dt < 2; ++dt)
#pragma unroll
                for (int g = 0; g < 4; ++g) *(f32x4*)(po + 32 * dt + 8 * g + 4 * h) = (f32x4){o[dt][4 * g], o[dt][4 * g + 1], o[dt][4 * g + 2], o[dt][4 * g + 3]};
            if (h == 0) p.mb_l[((size_t)head * T_ + query) * 3 + slot] = l;
        }
    }
}

__device__ __forceinline__ void phase_moba_own(const P& p, char* lds) {
    const int tid = otid(), lane = tid & 63, w = tid >> 6, c = lane & 31, h = lane >> 5;
#pragma unroll 1
    for (int t = blockIdx.x; t < 8 * 64; t += gridDim.x) {
        const int head = t & 7, cur = t >> 3;
        const int q0 = cur * 256, qw = q0 + 32 * w, query = qw + c;
        const bf16_t* kbase = p.k16 + (size_t)(8 + head) * T_ * 64;
        const bf16_t* vtbase = p.vT16 + (size_t)(8 + head) * 64 * T_;
        bf16x8 qf[4];
        load_qfrag(qf, p.q16 + ((size_t)(8 + head) * T_ + query) * 64, h);
        const float M2 = shift_bound_l2(qnorm2(qf), p.kmax2[8 + head]);
        f32x16 o[2];
#pragma unroll
        for (int i = 0; i < 16; ++i) { o[0][i] = 0.f; o[1][i] = 0.f; }
        float l = 0.f;
        TileRegs tr;
        tile_gload(tr, kbase, vtbase, q0);
        __syncthreads();
        tile_swrite(tr, lds);
        __syncthreads();
#pragma unroll 1
        for (int kt = 0; kt < 4; ++kt) {
            if (kt < 3) tile_gload(tr, kbase, vtbase, q0 + (kt + 1) * 64);
            const char* kb = lds + (kt & 1) * ABUF_B;
            const int keybase = q0 + kt * 64;
            const unsigned W0 = causal_word(query, keybase), W1 = causal_word(query, keybase + 32);
            if (__ballot((W0 | W1) != 0u) != 0ull) attn_tile64(kb, kb + KTILE_B, qf, W0, W1, M2, l, o, c, h);
            if (kt < 3) {
                tile_swrite(tr, lds + ((kt + 1) & 1) * ABUF_B);
                __syncthreads();
            }
        }
        l += __shfl_xor(l, 32);
        const int nsel = cur < 3 ? cur : 3;
#pragma unroll 1
        for (int sI = 0; sI < nsel; ++sI) {
            const float* po = p.mb_part + (((size_t)head * T_ + query) * 3 + sI) * 64;
#pragma unroll
            for (int dt = 0; dt < 2; ++dt)
#pragma unroll
                for (int g = 0; g < 4; ++g) {
                    const f32x4 v = *(const f32x4*)(po + 32 * dt + 8 * g + 4 * h);
                    o[dt][4 * g] += v[0]; o[dt][4 * g + 1] += v[1]; o[dt][4 * g + 2] += v[2]; o[dt][4 * g + 3] += v[3];
                }
            l += p.mb_l[((size_t)head * T_ + query) * 3 + sI];
        }
        store_o(p.o + (size_t)query * DM + 512 + head * 64, o, h, 1.0f / l);
    }
}

__device__ __forceinline__ void attn_tile64_2h(const char* kbA, const char* vbA, const char* kbB, const char* vbB,
                                               const bf16x8 (&qA)[4], const bf16x8 (&qB)[4], unsigned W0, unsigned W1, float MA, float MB,
                                               float& lA, float& lB, f32x16 (&oA)[2], f32x16 (&oB)[2], int c, int h) {
    u32x4 pA[2][2], pB[2][2];
    float lsA = 0.f, lsB = 0.f;
#pragma unroll
    for (int t2 = 0; t2 < 2; ++t2) {
        const unsigned Wh = (t2 ? W1 : W0) >> (4 * h);
        bool ok[16];
#pragma unroll
        for (int r = 0; r < 16; ++r) ok[r] = (Wh >> ((r & 3) + 8 * (r >> 2))) & 1u;
#pragma unroll
        for (int hd = 0; hd < 2; ++hd) {
            const char* kb = hd ? kbB : kbA;
            bf16x8 kf[4];
#pragma unroll
            for (int kk = 0; kk < 4; ++kk) kf[kk] = *(const bf16x8*)(kb + (32 * t2 + c) * KROW + (16 * kk + 8 * h) * 2);
            const float Mx = hd ? MB : MA;
            f32x16 sv;
#pragma unroll
            for (int i = 0; i < 16; ++i) sv[i] = ok[i] ? -Mx : -1.0e30f;
#pragma unroll
            for (int kk = 0; kk < 4; ++kk) sv = __builtin_amdgcn_mfma_f32_32x32x16_bf16(kf[kk], hd ? qB[kk] : qA[kk], sv, 0, 0, 0);
            f32v2_ ls2 = {0.f, 0.f};
#pragma unroll
            for (int sI = 0; sI < 2; ++sI) {
                f32v2_ a2[4];
#pragma unroll
                for (int j = 0; j < 4; ++j) {
                    a2[j][0] = fexp2(sv[8 * sI + 2 * j]);
                    a2[j][1] = fexp2(sv[8 * sI + 2 * j + 1]);
                    ls2 = ls2 + a2[j];
                }
                const u32x4 pk = (u32x4){pack2(a2[0][0], a2[0][1]), pack2(a2[1][0], a2[1][1]), pack2(a2[2][0], a2[2][1]), pack2(a2[3][0], a2[3][1])};
                if (hd) pB[t2][sI] = pk; else pA[t2][sI] = pk;
            }
            if (hd) lsB += ls2[0] + ls2[1]; else lsA += ls2[0] + ls2[1];
        }
    }
    lA += lsA;
    lB += lsB;
#pragma unroll
    for (int hd = 0; hd < 2; ++hd) {
        const char* vb = hd ? vbB : vbA;
#pragma unroll
        for (int t2 = 0; t2 < 2; ++t2) {
            u32x4 vf[2][2];
#pragma unroll
            for (int sI = 0; sI < 2; ++sI)
#pragma unroll
                for (int dt = 0; dt < 2; ++dt) {
                    const char* a = vb + (32 * dt + c) * VROW + (32 * t2 + 16 * sI + 4 * h) * 2;
                    const uint2 lo = *(const uint2*)a, hi = *(const uint2*)(a + 16);
                    vf[sI][dt] = (u32x4){lo.x, lo.y, hi.x, hi.y};
                }
#pragma unroll
            for (int sI = 0; sI < 2; ++sI)
#pragma unroll
                for (int dt = 0; dt < 2; ++dt) {
                    if (hd == 0) oA[dt] = __builtin_amdgcn_mfma_f32_32x32x16_bf16(__builtin_bit_cast(bf16x8, vf[sI][dt]), __builtin_bit_cast(bf16x8, pA[t2][sI]), oA[dt], 0, 0, 0);
                    else oB[dt] = __builtin_amdgcn_mfma_f32_32x32x16_bf16(__builtin_bit_cast(bf16x8, vf[sI][dt]), __builtin_bit_cast(bf16x8, pB[t2][sI]), oB[dt], 0, 0, 0);
                }
        }
    }
}

__device__ __forceinline__ void phase_dsa(const P& p, char* lds) {
    const int tid = otid(), lane = tid & 63, w = tid >> 6, c = lane & 31, h = lane >> 5;
    const int G = gridDim.x;
#pragma unroll 1
    for (int r = 0; r * G < 8 * 64; ++r) {
        const int t = zz_unit(r, blockIdx.x, G);
        if (t >= 8 * 64) continue;
        const int hA = (t & 7) * 2, hB = hA + 1, qb = 63 - (t >> 3);
        const int q0 = qb * 256, qw = q0 + 32 * w, query = qw + c;
        const bf16_t* kbaseA = p.k16 + (size_t)hA * T_ * 64;
        const bf16_t* vtbaseA = p.vT16 + (size_t)hA * 64 * T_;
        const bf16_t* kbaseB = p.k16 + (size_t)hB * T_ * 64;
        const bf16_t* vtbaseB = p.vT16 + (size_t)hB * 64 * T_;
        bf16x8 qA[4], qB[4];
        load_qfrag(qA, p.q16 + ((size_t)hA * T_ + query) * 64, h);
        load_qfrag(qB, p.q16 + ((size_t)hB * T_ + query) * 64, h);
        const float MA = shift_bound_l2(qnorm2(qA), p.kmax2[16 + hA]), MB = shift_bound_l2(qnorm2(qB), p.kmax2[16 + hB]);
        f32x16 oA[2], oB[2];
#pragma unroll
        for (int i = 0; i < 16; ++i) { oA[0][i] = 0.f; oA[1][i] = 0.f; oB[0][i] = 0.f; oB[1][i] = 0.f; }
        float lA = 0.f, lB = 0.f;
        const int ktend = (q0 + 255) >> 6;
        TileRegs trA, trB;
        const unsigned* bmq = p.bm + query;
        unsigned W0 = bmq[0], W1 = bmq[(size_t)T_];
        tile_gload(trA, kbaseA, vtbaseA, 0);
        tile_gload(trB, kbaseB, vtbaseB, 0);
        __syncthreads();
        tile_swrite(trA, lds);
        tile_swrite(trB, lds + ABUF_B);
        __syncthreads();
        int buf = 0;
#pragma unroll 1
        for (int kt = 0; kt <= ktend; ++kt) {
            const bool more = kt < ktend;
            const int ktn = more ? kt + 1 : kt;
            const unsigned Wn0 = bmq[(size_t)(2 * ktn) * T_], Wn1 = bmq[(size_t)(2 * ktn + 1) * T_];
            tile_gload(trA, kbaseA, vtbaseA, ktn * 64);
            tile_gload(trB, kbaseB, vtbaseB, ktn * 64);
            const char* kb = lds + buf * (2 * ABUF_B);
            attn_tile64_2h(kb, kb + KTILE_B, kb + ABUF_B, kb + ABUF_B + KTILE_B, qA, qB, W0, W1, MA, MB, lA, lB, oA, oB, c, h);
            if (!more) break;
            tile_swrite(trA, lds + (buf ^ 1) * (2 * ABUF_B));
            tile_swrite(trB, lds + (buf ^ 1) * (2 * ABUF_B) + ABUF_B);
            __syncthreads();
            buf ^= 1;
            W0 = Wn0; W1 = Wn1;
        }
        lA += __shfl_xor(lA, 32);
        lB += __shfl_xor(lB, 32);
        store_o(p.o + (size_t)query * DM + hA * 64, oA, h, 1.0f / lA);
        store_o(p.o + (size_t)query * DM + hB * 64, oB, h, 1.0f / lB);
    }
}
#ifndef FORCE_SLOW
#define FORCE_SLOW 0
#endif
#define IDX_ROWS 32
#define IDX_HIST_B (IDX_ROWS * 4096)
#define IDX_INFO_OFF IDX_HIST_B
#define IDX_CAND_OFF (IDX_HIST_B + 1024)
#define IDX_CAP 16
#define IDX_LDS_B (IDX_CAND_OFF + IDX_ROWS * IDX_CAP * 8)
#define IDX_FCAP 256

__device__ __forceinline__ unsigned fkey(float s) {
    const unsigned u = __float_as_uint(s + 0.0f);
    return (u & 0x80000000u) ? ~u : (u | 0x80000000u);
}
__device__ __forceinline__ unsigned sbin(float s) {
    const unsigned u = __float_as_uint(s + 0.0f);
    int t = (int)((u & 0x7fffffffu) >> 17) - (115 << 6);
    t = t < 0 ? 0 : (t > 1023 ? 1023 : t);
    return (u >> 31) ? (unsigned)(1023 - t) : (unsigned)(1024 + t);
}

__device__ __forceinline__ void find_bin(const unsigned* hrow, int need, int lane, int& bin_out, int& above_out) {
    unsigned wv[16];
    const int wbase = 1008 - 16 * lane;
#pragma unroll
    for (int i = 0; i < 4; ++i) {
        const u32x4 q = *(const u32x4*)(hrow + wbase + 4 * i);
        wv[4 * i] = q[0]; wv[4 * i + 1] = q[1]; wv[4 * i + 2] = q[2]; wv[4 * i + 3] = q[3];
    }
    int tot = 0;
#pragma unroll
    for (int i = 0; i < 16; ++i) tot += (int)(wv[i] >> 16) + (int)(wv[i] & 0xffffu);
    int incl = tot;
#pragma unroll
    for (int o = 1; o < 64; o <<= 1) {
        const int v = __shfl_up(incl, o);
        if (lane >= o) incl += v;
    }
    const unsigned long long bal = __ballot(incl >= need);
    const int fl = __ffsll(bal) - 1;
    int b = 0, ab = 0;
    if (lane == fl) {
        int cum = incl - tot;
        bool found = false;
#pragma unroll
        for (int i = 15; i >= 0; --i) {
            const int hi = (int)(wv[i] >> 16), lo = (int)(wv[i] & 0xffffu);
            if (!found) { if (cum + hi >= need) { found = true; b = 2 * (wbase + i) + 1; ab = cum; } else cum += hi; }
            if (!found) { if (cum + lo >= need) { found = true; b = 2 * (wbase + i); ab = cum; } else cum += lo; }
        }
    }
    bin_out = __shfl(b, fl < 0 ? 0 : fl);
    above_out = __shfl(ab, fl < 0 ? 0 : fl);
}

struct IdxCtx {
    bf16x8 af[4];
    float wq[2][8];
    int qabs[2], qloc[2];
};

__device__ __forceinline__ void idx_setup(const P& p, IdxCtx& x, int q0, int w, int c, int h) {
    const int u = ((c >> 4) & 1) + 2 * ((c >> 2) & 1), hd = (c & 3) + 4 * ((c >> 3) & 1);
    const bf16_t* qp = p.qi + ((size_t)(q0 + 4 * w + u) * 8 + hd) * 64;
#pragma unroll
    for (int kk = 0; kk < 4; ++kk) x.af[kk] = *(const bf16x8*)(qp + 16 * kk + 8 * h);
#pragma unroll
    for (int uu = 0; uu < 2; ++uu) {
        x.qloc[uu] = 4 * w + 2 * h + uu;
        x.qabs[uu] = q0 + x.qloc[uu];
        const f32x4 a = *(const f32x4*)(p.wi + (size_t)x.qabs[uu] * 8), b = *(const f32x4*)(p.wi + (size_t)x.qabs[uu] * 8 + 4);
        x.wq[uu][0] = a[0]; x.wq[uu][1] = a[1]; x.wq[uu][2] = a[2]; x.wq[uu][3] = a[3];
        x.wq[uu][4] = b[0]; x.wq[uu][5] = b[1]; x.wq[uu][6] = b[2]; x.wq[uu][7] = b[3];
    }
}
__device__ __forceinline__ void idx_load(const P& p, bf16x8 (&bk)[4], int kt, int c, int h) {
    const bf16_t* kp = p.ki + (size_t)(32 * kt + c) * 64 + 8 * h;
#pragma unroll
    for (int kk = 0; kk < 4; ++kk) bk[kk] = *(const bf16x8*)(kp + 16 * kk);
}
__device__ __forceinline__ void idx_scores(const IdxCtx& x, const bf16x8 (&bk)[4], float& s0, float& s1) {
    f32x16 s;
#pragma unroll
    for (int i = 0; i < 16; ++i) s[i] = 0.f;
#pragma unroll
    for (int kk = 0; kk < 4; ++kk) s = __builtin_amdgcn_mfma_f32_32x32x16_bf16(x.af[kk], bk[kk], s, 0, 0, 0);
    float r[16];
#pragma unroll
    for (int i = 0; i < 16; ++i) r[i] = fmaxf(s[i], 0.f);
    const float e0 = __builtin_fmaf(x.wq[0][6], r[6], __builtin_fmaf(x.wq[0][4], r[4], __builtin_fmaf(x.wq[0][2], r[2], x.wq[0][0] * r[0])));
    const float o0 = __builtin_fmaf(x.wq[0][7], r[7], __builtin_fmaf(x.wq[0][5], r[5], __builtin_fmaf(x.wq[0][3], r[3], x.wq[0][1] * r[1])));
    const float e1 = __builtin_fmaf(x.wq[1][6], r[14], __builtin_fmaf(x.wq[1][4], r[12], __builtin_fmaf(x.wq[1][2], r[10], x.wq[1][0] * r[8])));
    const float o1 = __builtin_fmaf(x.wq[1][7], r[15], __builtin_fmaf(x.wq[1][5], r[13], __builtin_fmaf(x.wq[1][3], r[11], x.wq[1][1] * r[9])));
    s0 = e0 + o0;
    s1 = e1 + o1;
}

__device__ __forceinline__ float relu1(float v) { const int b = __float_as_int(v); return __int_as_float(b > 0 ? b : 0); }
__device__ __forceinline__ void idx_scores2(const IdxCtx& x, const bf16x8 (&bk0)[4], const bf16x8 (&bk1)[4], float& a0, float& a1, float& b0, float& b1) {
    f32x16 s, t;
#pragma unroll
    for (int i = 0; i < 16; ++i) { s[i] = 0.f; t[i] = 0.f; }
#pragma unroll
    for (int kk = 0; kk < 4; ++kk) {
        s = __builtin_amdgcn_mfma_f32_32x32x16_bf16(x.af[kk], bk0[kk], s, 0, 0, 0);
        t = __builtin_amdgcn_mfma_f32_32x32x16_bf16(x.af[kk], bk1[kk], t, 0, 0, 0);
    }
    float r[16], q[16];
#pragma unroll
    for (int i = 0; i < 16; ++i) { r[i] = relu1(s[i]); q[i] = relu1(t[i]); }
    {
        const float e0 = __builtin_fmaf(x.wq[0][6], r[6], __builtin_fmaf(x.wq[0][4], r[4], __builtin_fmaf(x.wq[0][2], r[2], x.wq[0][0] * r[0])));
        const float o0 = __builtin_fmaf(x.wq[0][7], r[7], __builtin_fmaf(x.wq[0][5], r[5], __builtin_fmaf(x.wq[0][3], r[3], x.wq[0][1] * r[1])));
        const float e1 = __builtin_fmaf(x.wq[1][6], r[14], __builtin_fmaf(x.wq[1][4], r[12], __builtin_fmaf(x.wq[1][2], r[10], x.wq[1][0] * r[8])));
        const float o1 = __builtin_fmaf(x.wq[1][7], r[15], __builtin_fmaf(x.wq[1][5], r[13], __builtin_fmaf(x.wq[1][3], r[11], x.wq[1][1] * r[9])));
        a0 = e0 + o0; a1 = e1 + o1;
    }
    {
        const float e0 = __builtin_fmaf(x.wq[0][6], q[6], __builtin_fmaf(x.wq[0][4], q[4], __builtin_fmaf(x.wq[0][2], q[2], x.wq[0][0] * q[0])));
        const float o0 = __builtin_fmaf(x.wq[0][7], q[7], __builtin_fmaf(x.wq[0][5], q[5], __builtin_fmaf(x.wq[0][3], q[3], x.wq[0][1] * q[1])));
        const float e1 = __builtin_fmaf(x.wq[1][6], q[14], __builtin_fmaf(x.wq[1][4], q[12], __builtin_fmaf(x.wq[1][2], q[10], x.wq[1][0] * q[8])));
        const float o1 = __builtin_fmaf(x.wq[1][7], q[15], __builtin_fmaf(x.wq[1][5], q[13], __builtin_fmaf(x.wq[1][3], q[11], x.wq[1][1] * q[9])));
        b0 = e0 + o0; b1 = e1 + o1;
    }
}

#define IDX_RING_OFF IDX_LDS_B
#define IDX_RING_TILE_B (64 * 144)
#define IDX_TOTAL_LDS_B (IDX_RING_OFF + 2 * IDX_RING_TILE_B)
template <class F>
__device__ __forceinline__ void idx_sweep(const P& p, const IdxCtx& x, int ntile, int c, int h, char* lds, F body) {
    const int tid = otid(), row = tid >> 3, cc = tid & 7;
    char* ring = lds + IDX_RING_OFF;
    const int nt64 = (ntile + 1) >> 1;
    const bf16_t* src = p.ki + (size_t)row * 64 + cc * 8;
    u32x4 reg = *(const u32x4*)src;
    __syncthreads();
    *(u32x4*)(ring + row * 144 + cc * 16) = reg;
    __syncthreads();
#pragma unroll 1
    for (int t = 0; t < nt64; ++t) {
        const bool more = t + 1 < nt64;
        if (more) reg = *(const u32x4*)(src + (size_t)(t + 1) * 64 * 64);
        const char* rb = ring + (t & 1) * IDX_RING_TILE_B;
        bf16x8 bk0[4], bk1[4];
#pragma unroll
        for (int kk = 0; kk < 4; ++kk) {
            bk0[kk] = *(const bf16x8*)(rb + c * 144 + 32 * kk + 16 * h);
            bk1[kk] = *(const bf16x8*)(rb + (32 + c) * 144 + 32 * kk + 16 * h);
        }
        __builtin_amdgcn_sched_barrier(0);
        float sa0, sa1, sb0, sb1;
        idx_scores2(x, bk0, bk1, sa0, sa1, sb0, sb1);
        body(2 * t, sa0, sa1);
        body(2 * t + 1, sb0, sb1);
        if (more) *(u32x4*)(ring + ((t + 1) & 1) * IDX_RING_TILE_B + row * 144 + cc * 16) = reg;
        __syncthreads();
    }
}

__device__ __forceinline__ void idx_unit_slow(const P& p, const IdxCtx& x, char* lds, int q0, int ntile, int tid, int lane, int w, int c, int h) {
    unsigned* hist = (unsigned*)lds;
    int* info = (int*)(lds + IDX_INFO_OFF);
    uint2* cand = (uint2*)(lds + IDX_CAND_OFF);
    __syncthreads();
    if (tid < IDX_ROWS) {
        const int nk = q0 + tid + 1;
        info[tid] = nk < 256 ? nk : 256;
        info[5 * IDX_ROWS + tid] = 0;
    }
#pragma unroll 1
    for (int pass = 0; pass < 3; ++pass) {
        for (int i = tid; i < IDX_HIST_B / 16; i += NTHR) ((u32x4*)hist)[i] = (u32x4){0u, 0u, 0u, 0u};
        __syncthreads();
        int pb1[2], pb2[2];
#pragma unroll
        for (int uu = 0; uu < 2; ++uu) { pb1[uu] = info[IDX_ROWS + x.qloc[uu]]; pb2[uu] = info[3 * IDX_ROWS + x.qloc[uu]]; }
        idx_sweep(p, x, ntile, c, h, lds, [&](int kt, float s0, float s1) {
            const int key = 32 * kt + c;
#pragma unroll
            for (int uu = 0; uu < 2; ++uu) {
                const bool valid = key <= x.qabs[uu];
                const unsigned ku = fkey(uu == 0 ? s0 : s1);
                if (pass == 0) {
                    if (valid) { const unsigned bin = ku >> 21; atomicAdd(hist + x.qloc[uu] * 1024 + (bin >> 1), 1u << (16 * (bin & 1))); }
                } else if (pass == 1) {
                    if (valid && (int)(ku >> 21) == pb1[uu]) { const unsigned bin = (ku >> 10) & 2047u; atomicAdd(hist + x.qloc[uu] * 1024 + (bin >> 1), 1u << (16 * (bin & 1))); }
                } else {
                    const bool sa = x.qabs[uu] < 256;
                    const unsigned pfx = ku >> 10, P22 = ((unsigned)pb1[uu] << 11) | (unsigned)pb2[uu];
                    const bool gt = valid && (sa || pfx > P22);
                    const bool eq = valid && !sa && pfx == P22;
                    const unsigned long long bal = __ballot(gt);
                    if (c == 0) hist[kt * IDX_ROWS + x.qloc[uu]] = h ? (unsigned)(bal >> 32) : (unsigned)bal;
                    if (eq) {
                        const int ix = atomicAdd(info + 5 * IDX_ROWS + x.qloc[uu], 1);
                        if (ix < IDX_CAP) cand[x.qloc[uu] * IDX_CAP + ix] = make_uint2(ku, (unsigned)key);
                    }
                }
            }
        });
        __syncthreads();
        if (pass < 2) {
#pragma unroll 1
            for (int rr = 0; rr < 4; ++rr) {
                const int row = 4 * w + rr;
                const int need = pass == 0 ? info[row] : info[2 * IDX_ROWS + row];
                int b, ab;
                find_bin(hist + row * 1024, need, lane, b, ab);
                if (lane == 0) {
                    if (pass == 0) { info[IDX_ROWS + row] = b; info[2 * IDX_ROWS + row] = need - ab; }
                    else { info[3 * IDX_ROWS + row] = b; info[4 * IDX_ROWS + row] = need - ab; }
                }
            }
            __syncthreads();
        }
    }
    if (tid < IDX_ROWS) {
        const int row = tid, n = info[5 * IDX_ROWS + row] < IDX_CAP ? info[5 * IDX_ROWS + row] : IDX_CAP, need2 = info[4 * IDX_ROWS + row];
        for (int i = 0; i < n; ++i) {
            const uint2 ci = cand[row * IDX_CAP + i];
            int rank = 0;
            for (int j = 0; j < n; ++j) {
                const uint2 cj = cand[row * IDX_CAP + j];
                rank += (cj.x > ci.x || (cj.x == ci.x && cj.y < ci.y)) ? 1 : 0;
            }
            if (rank < need2) hist[(ci.y >> 5) * IDX_ROWS + row] |= 1u << (ci.y & 31u);
        }
    }
    __syncthreads();
}

__device__ __forceinline__ void phase_indexer(const P& p, char* lds) {
    const int tid = otid(), lane = tid & 63, w = tid >> 6, c = lane & 31, h = lane >> 5;
    unsigned* hist = (unsigned*)lds;
    int* info = (int*)(lds + IDX_INFO_OFF);
    uint2* fcand = (uint2*)(lds + 65536);
#pragma unroll 1
    for (int rnd = 0; rnd * (int)gridDim.x < T_ / IDX_ROWS; ++rnd) {
        const int t = zz_unit(rnd, blockIdx.x, gridDim.x);
        if (t >= T_ / IDX_ROWS) continue;
        const int qblk = (T_ / IDX_ROWS - 1) - t;
        const int q0 = qblk * IDX_ROWS;
        IdxCtx x;
        idx_setup(p, x, q0, w, c, h);
        const int ntile = (q0 + IDX_ROWS - 1) / 32 + 1;
        const bool selall_blk = (q0 + IDX_ROWS) <= 256;
        __syncthreads();
        if (tid < IDX_ROWS) {
            const int nk = q0 + tid + 1;
            info[tid] = nk < 256 ? nk : 256;
            info[IDX_ROWS + tid] = 0;
            info[2 * IDX_ROWS + tid] = 0;
            info[5 * IDX_ROWS + tid] = 0;
        }
        const int Lrow = ((ntile + 1) >> 1) * 64;
        unsigned short* bins = (unsigned short*)p.act + (size_t)32 * 64 * ((qblk & 1) ? ((qblk >> 1) + 1) * ((qblk >> 1) + 1) : (qblk >> 1) * ((qblk >> 1) + 1));
        unsigned short* brow0 = bins + x.qloc[0] * 64;
        unsigned short* brow1 = bins + x.qloc[1] * 64;
        if (!selall_blk) {
            for (int i = tid; i < IDX_HIST_B / 16; i += NTHR) ((u32x4*)hist)[i] = (u32x4){0u, 0u, 0u, 0u};
            __syncthreads();
            idx_sweep(p, x, ntile, c, h, lds, [&](int kt, float s0, float s1) {
                const int key = 32 * kt + c;
                const unsigned b0 = sbin(s0), b1_ = sbin(s1);
                const unsigned inc0 = key <= x.qabs[0] ? (1u << (16 * (b0 & 1))) : 0u, inc1 = key <= x.qabs[1] ? (1u << (16 * (b1_ & 1))) : 0u;
                atomicAdd(hist + x.qloc[0] * 1024 + (b0 >> 1), inc0);
                atomicAdd(hist + x.qloc[1] * 1024 + (b1_ >> 1), inc1);
                const unsigned p0 = b0 | ((unsigned)__builtin_amdgcn_update_dpp(0, (int)b0, 0x101, 0xF, 0xF, true) << 16);
                const unsigned p1 = b1_ | ((unsigned)__builtin_amdgcn_update_dpp(0, (int)b1_, 0x101, 0xF, 0xF, true) << 16);
                const unsigned p0h = (unsigned)__builtin_amdgcn_update_dpp(0, (int)p0, 0x102, 0xF, 0xF, true);
                const unsigned p1h = (unsigned)__builtin_amdgcn_update_dpp(0, (int)p1, 0x102, 0xF, 0xF, true);
                if ((c & 3) == 0) {
                    const int off = (key >> 6) * 2048 + (key & 63);
                    *(uint2*)(brow0 + off) = make_uint2(p0, p0h);
                    *(uint2*)(brow1 + off) = make_uint2(p1, p1h);
                }
            });
            __syncthreads();
#pragma unroll 1
            for (int rr = 0; rr < 4; ++rr) {
                const int row = 4 * w + rr;
                int b, ab;
                find_bin(hist + row * 1024, info[row], lane, b, ab);
                if (lane == 0) { info[IDX_ROWS + row] = b; info[2 * IDX_ROWS + row] = info[row] - ab; }
            }
            __syncthreads();
        }
        for (int i = tid; i < 65536 / 16; i += NTHR) ((u32x4*)hist)[i] = (u32x4){0u, 0u, 0u, 0u};
        __syncthreads();
        {
            const int row = 4 * w + ((lane >> 3) & 3), kc = lane & 7, th = lane >> 5, qrow = q0 + row;
            const int tb = info[IDX_ROWS + row];
            const bool sa = selall_blk;
            const int nt64 = Lrow >> 6;
            const unsigned short* br = bins + row * 64 + 8 * kc;
            const int nstep = (nt64 + 1) >> 1;
            u32x4 cur = {0u, 0u, 0u, 0u};
            if (!sa && th < nt64) cur = *(const u32x4*)(br + th * 2048);
#pragma unroll 1
            for (int st = 0; st < nstep; ++st) {
                u32x4 nxt = {0u, 0u, 0u, 0u};
                if (!sa && 2 * (st + 1) + th < nt64) nxt = *(const u32x4*)(br + (2 * (st + 1) + th) * 2048);
                const int tile = 2 * st + th, k0 = tile * 64 + 8 * kc;
                unsigned m8 = 0u;
#pragma unroll
                for (int i = 0; i < 8; ++i) {
                    const int bn = (int)((cur[i >> 1] >> (16 * (i & 1))) & 0xffffu), key = k0 + i;
                    const bool v = key <= qrow && tile < nt64;
                    if (v && (sa || bn > tb)) m8 |= 1u << i;
                    if (v && !sa && bn == tb) {
                        const int ix = atomicAdd(info + 5 * IDX_ROWS + row, 1);
                        if (ix < IDX_FCAP) fcand[row * IDX_FCAP + ix] = make_uint2(0u, (unsigned)key);
                    }
                }
                const unsigned w1 = (unsigned)__builtin_amdgcn_update_dpp(0, (int)m8, 0x101, 0xF, 0xF, true);
                const unsigned w2 = (unsigned)__builtin_amdgcn_update_dpp(0, (int)m8, 0x102, 0xF, 0xF, true);
                const unsigned w3 = (unsigned)__builtin_amdgcn_update_dpp(0, (int)m8, 0x103, 0xF, 0xF, true);
                if ((kc & 3) == 0 && tile < nt64) hist[(tile * 2 + (kc >> 2)) * IDX_ROWS + row] = m8 | (w1 << 8) | (w2 << 16) | (w3 << 24);
                cur = nxt;
            }
        }
        const int ovf = __syncthreads_or(FORCE_SLOW || (tid < IDX_ROWS && info[5 * IDX_ROWS + tid] > IDX_FCAP));
        if (ovf) {
            idx_unit_slow(p, x, lds, q0, ntile, tid, lane, w, c, h);
        } else {
#pragma unroll 1
            for (int rr = 0; rr < 4; ++rr) {
                const int row = 4 * w + rr, n = info[5 * IDX_ROWS + row], need1 = info[2 * IDX_ROWS + row];
                uint2* cl = fcand + row * IDX_FCAP;
                if (n > 0) {
                    const int hd = lane >> 3, dc = lane & 7;
                    const bf16x8 qv = *(const bf16x8*)(p.qi + ((size_t)(q0 + row) * 8 + hd) * 64 + 8 * dc);
                    const float wgt = p.wi[(size_t)(q0 + row) * 8 + hd];
#pragma unroll 1
                    for (int j0 = 0; j0 < n; j0 += 8) {
                        bf16x8 kv[8];
#pragma unroll
                        for (int u = 0; u < 8; ++u) {
                            const unsigned key = cl[j0 + u < n ? j0 + u : n - 1].y;
                            kv[u] = *(const bf16x8*)(p.ki + (size_t)key * 64 + 8 * dc);
                        }
#pragma unroll
                        for (int u = 0; u < 8; ++u) {
                            float d = 0.f;
#pragma unroll
                            for (int e = 0; e < 8; ++e) d = __builtin_fmaf(bf2f((bf16_t)qv[e]), bf2f((bf16_t)kv[u][e]), d);
                            d += __shfl_xor(d, 1); d += __shfl_xor(d, 2); d += __shfl_xor(d, 4);
                            float sc = wgt * fmaxf(d, 0.f);
                            sc += __shfl_xor(sc, 8); sc += __shfl_xor(sc, 16); sc += __shfl_xor(sc, 32);
                            if (lane == 0 && j0 + u < n) cl[j0 + u].x = fkey(sc);
                        }
                    }
                }
                __builtin_amdgcn_s_waitcnt(0xc07f);
                __builtin_amdgcn_wave_barrier();
#pragma unroll 1
                for (int i0 = 0; i0 < n; i0 += 64) {
                    const int i = i0 + lane;
                    const uint2 ci = cl[i < n ? i : 0];
                    int rank = 0;
#pragma unroll 1
                    for (int j = 0; j < n; ++j) {
                        const uint2 cj = cl[j];
                        rank += (cj.x > ci.x || (cj.x == ci.x && cj.y < ci.y)) ? 1 : 0;
                    }
                    if (i < n && rank < need1) atomicOr(hist + (ci.y >> 5) * IDX_ROWS + row, 1u << (ci.y & 31u));
                }
            }
            __syncthreads();
        }
        const int nw = (((q0 & ~255) >> 5) + 8) * IDX_ROWS;
        for (int i = tid; i < nw; i += NTHR) {
            const int kt = i / IDX_ROWS, r = i % IDX_ROWS;
            p.bm[(size_t)kt * T_ + q0 + r] = hist[i];
        }
    }
}
#define XB_TMO      128
#define XB_XCNT(j)  (256  + 64 * (j))
#define XB_XSUB(j)  (1280 + 64 * (j))
#define XB_XGEN(j)  (2304 + 64 * (j))
#define XB_TOP      3328
#define XB_TOPGEN   3392
#define XCD_BAR_WORDS 3456
#define XB_SPIN_CAP (1u << 22)
#define LAS __attribute__((address_space(3)))

__device__ __forceinline__ unsigned xb_ld(unsigned* p)              { return __hip_atomic_load(p, __ATOMIC_RELAXED, __HIP_MEMORY_SCOPE_AGENT); }
__device__ __forceinline__ unsigned xb_add(unsigned* p, unsigned v) { return __hip_atomic_fetch_add(p, v, __ATOMIC_RELAXED, __HIP_MEMORY_SCOPE_AGENT); }
__device__ __forceinline__ unsigned xb_xcc_id() { return (unsigned)__builtin_amdgcn_s_getreg((3 << 11) | 20) & 0xFu; }
#define XB_SPIN(cond, bar) do { unsigned _sp = 0; while (cond) { __builtin_amdgcn_s_sleep(1); \
    if ((++_sp & 255u) == 0u) { if (xb_ld(&(bar)[XB_TMO])) break; if (_sp > XB_SPIN_CAP) { atomicAdd(&(bar)[XB_TMO], 1u); break; } } } } while (0)

struct XcdBarrier { unsigned* bar; unsigned x; volatile LAS unsigned* st; };

__device__ __forceinline__ XcdBarrier xcd_barrier_post(unsigned* bar, volatile LAS unsigned* st) {
    XcdBarrier b; b.bar = bar; b.x = xb_xcc_id(); b.st = st;
    if (threadIdx.x == 0) (void)xb_add(&bar[XB_XCNT(b.x)], 1u);
    return b;
}
__device__ __forceinline__ void xcd_barrier_complete(unsigned* bar, unsigned x, unsigned& nloc, unsigned& nx) {
    const unsigned G = gridDim.x * gridDim.y * gridDim.z;
    unsigned sum, cnt, mine, sp = 0u;
    for (;;) {
        sum = 0u; cnt = 0u; mine = 0u;
#pragma unroll
        for (unsigned j = 0; j < 16; ++j) { const unsigned c = xb_ld(&bar[XB_XCNT(j)]); sum += c; cnt += (c > 0u) ? 1u : 0u; mine = (j == x) ? c : mine; }
        if (sum == G) break;
        __builtin_amdgcn_s_sleep(1);
        if ((++sp & 255u) == 0u) { if (xb_ld(&bar[XB_TMO])) break; if (sp > XB_SPIN_CAP) { atomicAdd(&bar[XB_TMO], 1u); break; } }
    }
    nloc = mine > 0u ? mine : 1u; nx = cnt > 0u ? cnt : 1u;
}
__device__ __forceinline__ void xcd_barrier(const XcdBarrier& b) {
    asm volatile("s_waitcnt vmcnt(0)" ::: "memory");
    __syncthreads();
    if (threadIdx.x == 0) {
        unsigned* bar = b.bar;
        __builtin_amdgcn_s_waitcnt(0);
        unsigned nloc = b.st[0], nx = b.st[1];
        if (nloc == 0u) { xcd_barrier_complete(bar, b.x, nloc, nx); b.st[0] = nloc; b.st[1] = nx; }
        const unsigned old = xb_add(&bar[XB_XSUB(b.x)], 1u);
        const unsigned gen = old / nloc;
        if (old + 1u == (gen + 1u) * nloc) {
            __builtin_amdgcn_fence(__ATOMIC_RELEASE, "agent");
            asm volatile("s_waitcnt vmcnt(0)" ::: "memory");
            const unsigned og = xb_add(&bar[XB_TOP], 1u);
            const unsigned tg = og / nx;
            if (og + 1u == (tg + 1u) * nx) xb_add(&bar[XB_TOPGEN], 1u);
            else XB_SPIN(xb_ld(&bar[XB_TOPGEN]) == tg, bar);
            __builtin_amdgcn_fence(__ATOMIC_ACQUIRE, "agent");
            xb_add(&bar[XB_XGEN(b.x)], 1u);
            asm volatile("s_waitcnt vmcnt(0)" ::: "memory");
        } else {
            XB_SPIN(xb_ld(&bar[XB_XGEN(b.x)]) == gen, bar);
            __builtin_amdgcn_fence(__ATOMIC_ACQUIRE, "agent");
            asm volatile("s_waitcnt vmcnt(0)" ::: "memory");
        }
    }
    __syncthreads();
}


#define GSYNC() xcd_barrier(xb)
#define MEGA_LDS_B (IDX_TOTAL_LDS_B > (RT_DEC_OFF + 4096) ? IDX_TOTAL_LDS_B : (RT_DEC_OFF + 4096))
template <int layer>
__device__ __forceinline__ void tail_phases(const P& p, char* lds, const XcdBarrier& xb) {
    phase_outproj(p, layer == 0 ? p.wb_ab_out : p.wb_c_out, layer == 0 ? p.x : p.x3, lds);
    GSYNC();
    phase_ln_router(p, layer, lds);
    GSYNC();
    phase_moe1(p, layer, lds);
    GSYNC();
    phase_moe2(p, layer, lds);
    GSYNC();
    phase_combine_ln(p, layer, lds);
    GSYNC();
    phase_ple(p, layer, layer == 0 ? p.x3 : p.out, lds);
    if (layer == 0) GSYNC();
}

__global__ void __launch_bounds__(512, 2) mega(P p) {
    extern __shared__ __attribute__((aligned(16))) char lds[];
    cg::grid_group grid = cg::this_grid();
    volatile LAS unsigned* st = (volatile LAS unsigned*)(lds + MEGA_LDS_B);
    if (threadIdx.x == 0) { st[0] = 0u; st[1] = 0u; }
    __syncthreads();
    const XcdBarrier xb = xcd_barrier_post(p.bar, st);
    phase_convert(p, lds);
    if (p.bar == nullptr) grid.sync();
    xcd_barrier(xb);
    phase_pp(p, lds);
    phase_inproj<0>(p, lds);
    GSYNC();
    phase_moba_gate(p, lds);
    phase_sb(p, lds);
    GSYNC();
    phase_moba_sparse(p, lds);
    GSYNC();
    phase_moba_own(p, lds);
    GSYNC();
#if defined(DEBUG_STAGE) && (DEBUG_STAGE == 2 || DEBUG_STAGE == 1)
    return;
#endif
    tail_phases<0>(p, lds, xb);
    phase_inproj<1>(p, lds);
    GSYNC();
    phase_indexer(p, lds);
    GSYNC();
    phase_dsa(p, lds);
    GSYNC();
    tail_phases<1>(p, lds, xb);
}

static inline char* carve(char*& cur, size_t bytes) { char* r = cur; cur += (bytes + 255) & ~(size_t)255; return r; }

static void make_params(P& p, void* const* d_in, void* d_out, void* d_ws) {
    p.x = (const float*)d_in[0]; p.p = (const float*)d_in[1]; p.ab_w_in = (const float*)d_in[2]; p.ab_w_out = (const float*)d_in[3];
    p.c_w_in = (const float*)d_in[4]; p.c_w_out = (const float*)d_in[5]; p.ln_g = (const float*)d_in[6]; p.ln_b = (const float*)d_in[7];
    p.router_w = (const float*)d_in[8]; p.router_b = (const float*)d_in[9]; p.moe_w1 = (const float*)d_in[10]; p.moe_b1 = (const float*)d_in[11];
    p.moe_w2 = (const float*)d_in[12]; p.moe_b2 = (const float*)d_in[13]; p.ple_w_proj = (const float*)d_in[14]; p.ple_w_gate = (const float*)d_in[15];
    p.out = (float*)d_out;
    char* cur = (char*)d_ws;
    const size_t T = T_;
    p.cnt = (int*)carve(cur, 256);
    p.dbg = (float*)carve(cur, 256);
    p.bar = (unsigned*)carve(cur, XCD_BAR_WORDS * sizeof(unsigned));
    p.wb_ab_in = (bf16_t*)carve(cur, (size_t)3072 * 1024 * 2);
    p.wb_ab_out = (bf16_t*)carve(cur, (size_t)1024 * 1024 * 2);
    p.wb_c_in = (bf16_t*)carve(cur, (size_t)C_INP * 1024 * 2);
    p.ksum = (float*)carve(cur, 8 * 64 * 64 * 4);
    p.kmax2 = (unsigned*)carve(cur, 256);
    p.mb_cnt = (int*)carve(cur, 512 * 4);
    p.mb_list = (int*)carve(cur, (size_t)512 * T * 4);
    p.mb_part = (float*)carve(cur, (size_t)8 * T * 3 * 64 * 4);
    p.mb_l = (float*)carve(cur, (size_t)8 * T * 3 * 4);
    p.wb_c_out = (bf16_t*)carve(cur, (size_t)1024 * 1024 * 2);
    p.wb_w1 = (bf16_t*)carve(cur, (size_t)64 * 2048 * 1024 * 2);
    p.wb_w2 = (bf16_t*)carve(cur, (size_t)64 * 1024 * 1024 * 2);
    p.wb_g = (bf16_t*)carve(cur, (size_t)2 * 1024 * 1024 * 2);
    p.wb_p = (bf16_t*)carve(cur, (size_t)2 * 1024 * 256 * 2);
    p.xb = (bf16_t*)carve(cur, T * DM * 2);
    p.pb = (bf16_t*)carve(cur, 2 * T * 256 * 2);
    p.pp = (float*)carve(cur, 2 * T * DM * 4);
    p.rope = (float*)carve(cur, T * 32 * 2 * 4);
    p.q16 = (bf16_t*)carve(cur, 16 * T * 64 * 2);
    p.k16 = (bf16_t*)carve(cur, 16 * T * 64 * 2);
    p.vT16 = (bf16_t*)carve(cur, 16 * T * 64 * 2);
    p.o = (bf16_t*)carve(cur, T * DM * 2);
    p.ypre = (float*)carve(cur, T * DM * 4);
    p.x1 = (float*)carve(cur, T * DM * 4);
    p.x1b = (bf16_t*)carve(cur, T * DM * 2);
    p.act = (bf16_t*)carve(cur, (size_t)(65536 + 32 * 256) * DM * 2);
    p.oslot = (bf16_t*)carve(cur, (size_t)(65536 + 32 * 256) * DM * 2);
    p.x2 = (float*)carve(cur, T * DM * 4);
    p.x2b = (bf16_t*)carve(cur, T * DM * 2);
    p.x3 = (float*)carve(cur, T * DM * 4);
    p.qi = (bf16_t*)carve(cur, T * 8 * 64 * 2);
    p.ki = (bf16_t*)carve(cur, T * 64 * 2);
    p.wi = (float*)carve(cur, T * 8 * 4);
    p.bm = (unsigned*)carve(cur, (size_t)512 * T * 4);
    p.tok_of = (int*)carve(cur, (size_t)32 * T * 4);
    p.sel_e = (int*)carve(cur, T * 4 * 4);
    p.sel_pos = (int*)carve(cur, T * 4 * 4);
    p.sel_g = (float*)carve(cur, T * 4 * 4);
}

extern "C" void kernel_launch(void* const* d_in, const int* in_sizes, int n_in, void* d_out, int out_size, void* d_ws, size_t ws_size, hipStream_t stream) {
    P p{};
    make_params(p, d_in, d_out, d_ws);
    constexpr size_t kDynLds = MEGA_LDS_B + 16;
    static int grid_blocks = 0;
    if (!grid_blocks) {
        int dev = 0, cus = 0, per_cu = 0;
        hipGetDevice(&dev);
        hipDeviceGetAttribute(&cus, hipDeviceAttributeMultiprocessorCount, dev);
        hipFuncSetAttribute((const void*)mega, hipFuncAttributeMaxDynamicSharedMemorySize, (int)kDynLds);
        hipOccupancyMaxActiveBlocksPerMultiprocessor(&per_cu, mega, NTHR, kDynLds);
        if (per_cu > 1) per_cu = 1;
        if (per_cu < 1) per_cu = 1;
        grid_blocks = cus * per_cu;
    }
    hipMemsetAsync(p.bar, 0, XCD_BAR_WORDS * sizeof(unsigned), stream);
    void* args[] = {&p};
    hipError_t e = hipLaunchCooperativeKernel((void*)mega, dim3(grid_blocks), dim3(NTHR), args, kDynLds, stream);
    if (e != hipSuccess) fprintf(stderr, "cooperative launch failed: %s (grid %d)\n", hipGetErrorString(e), grid_blocks);
#if defined(DEBUG_STAGE) && DEBUG_STAGE == 1
    k_dbg_zero<<<1, 64, 0, stream>>>(p);
    k_chk_sb<<<512, 64, 0, stream>>>(p);
    k_report<<<1024, 256, 0, stream>>>(p, 0, 100.0f);
#endif
#if defined(DEBUG_STAGE) && DEBUG_STAGE == 5
    k_dbg_zero<<<1, 64, 0, stream>>>(p);
    k_chk_moe<<<128, 256, 0, stream>>>(p);
    k_report<<<1024, 256, 0, stream>>>(p, 0, 100.0f);
#endif
#if defined(DEBUG_STAGE) && DEBUG_STAGE == 4
    k_dbg_zero<<<1, 64, 0, stream>>>(p);
    k_chk_dsa<<<512, 64, 0, stream>>>(p);
    k_report<<<1024, 256, 0, stream>>>(p, 0, 100.0f);
#endif
#if defined(DEBUG_STAGE) && DEBUG_STAGE == 3
    k_dbg_zero<<<1, 64, 0, stream>>>(p);
    k_chk_idx<<<32, 256, 65536, stream>>>(p);
    k_report<<<1024, 256, 0, stream>>>(p, 1, 1.0f / 32.0f);
#endif
#if defined(DEBUG_STAGE) && DEBUG_STAGE == 2
    k_dbg_zero<<<1, 64, 0, stream>>>(p);
    k_chk_moba<<<512, 64, 0, stream>>>(p);
    k_report<<<1024, 256, 0, stream>>>(p, 1, 1.0f);
#endif
}
```

```cpp
#include <hip/hip_runtime.h>
#include <hip/hip_cooperative_groups.h>
#include <stdint.h>
#include <cstdio>
namespace cg = cooperative_groups;

typedef unsigned short bf16_t;
typedef short bf16x8 __attribute__((ext_vector_type(8)));
typedef float f32x4 __attribute__((ext_vector_type(4)));
typedef float f32x16 __attribute__((ext_vector_type(16)));
typedef unsigned u32x4 __attribute__((ext_vector_type(4)));

#define T_ 16384
#define DM 1024
#define NEXP 32
#define C_IN_ 3656
#define C_INP 3840
#define LOG2E 1.4426950408889634f
#define DN_ALPHA 1.4142135623730951f
#define NTHR 512
#define NWAVE 8

__device__ __forceinline__ int otid() { int t = threadIdx.x; asm volatile("" : "+v"(t)); return t; }
__device__ __forceinline__ bf16_t f2bf(float f) { unsigned u = __float_as_uint(f); u += 0x7FFFu + ((u >> 16) & 1u); return (bf16_t)(u >> 16); }
__device__ __forceinline__ float bf2f(bf16_t b) { return __uint_as_float(((unsigned)b) << 16); }
typedef __bf16 bf16v2_ __attribute__((ext_vector_type(2)));
typedef float f32v2_ __attribute__((ext_vector_type(2)));
__device__ __forceinline__ unsigned pack2(float lo, float hi) { const f32v2_ v = {lo, hi}; return __builtin_bit_cast(unsigned, __builtin_convertvector(v, bf16v2_)); }
__device__ __forceinline__ float fexp2(float x) { return __builtin_amdgcn_exp2f(x); }
__device__ __forceinline__ float flog2(float x) { return __builtin_amdgcn_logf(x); }
__device__ __forceinline__ float sigmoidf_(float x) { return __builtin_amdgcn_rcpf(1.0f + __builtin_amdgcn_exp2f(-LOG2E * x)); }
__device__ __forceinline__ float wave_sum(float v) {
#pragma unroll
    for (int o = 32; o > 0; o >>= 1) v += __shfl_xor(v, o);
    return v;
}

struct P {
    const float *x, *p, *ab_w_in, *ab_w_out, *c_w_in, *c_w_out, *ln_g, *ln_b, *router_w, *router_b, *moe_w1, *moe_b1, *moe_w2, *moe_b2, *ple_w_proj, *ple_w_gate;
    float* out;
    bf16_t *wb_ab_in, *wb_ab_out, *wb_c_in, *wb_c_out, *wb_w1, *wb_w2, *wb_g, *wb_p;
    bf16_t *xb, *pb;
    float* pp;
    float* rope;
    bf16_t *q16, *k16, *vT16, *o;
    float* ksum;
    unsigned* kmax2;
    int* mb_cnt;
    int* mb_list;
    float* mb_part;
    float* mb_l;
    float *ypre, *x1;
    bf16_t* x1b;
    bf16_t *act, *oslot;
    float* x2;
    bf16_t* x2b;
    float* x3;
    bf16_t *qi, *ki;
    float* wi;
    unsigned* bm;
    int *cnt, *tok_of, *sel_e, *sel_pos;
    float* sel_g;
    float* dbg;
    unsigned* bar;
};

__device__ __forceinline__ int zz_unit(int r, int b, int G) { return (r & 1) ? (r * G + (G - 1 - b)) : (r * G + b); }

__device__ __forceinline__ int w1map(int n) {
    const int is_up = n & 1, j = n >> 1, tile = j >> 7, jj = j & 127, wc = jj >> 5, jl = jj & 31;
    return tile * 256 + wc * 64 + is_up * 32 + jl;
}

__device__ __forceinline__ void conv_job(const float* __restrict__ src, bf16_t* __restrict__ dst, int K, int N, int dst_rows, int mode, int batch) {
    const int tid = otid(), lane = tid & 63, wid = tid >> 6, kg = lane & 7, ng = lane >> 3;
    const int tkn = K / 64, tnn = dst_rows / 32, per = tkn * tnn, total = per * batch;
    const int stride = gridDim.x * NWAVE;
    int u = blockIdx.x * NWAVE + wid;
    if (u >= total) return;
    f32x4 v[8], w[8];
    auto coords = [&](int uu, const float*& S, bf16_t*& D, int& k0, int& n) {
        const int bt = uu / per, r = uu % per, tn = r / tkn, tk = r % tkn;
        S = src + (size_t)bt * K * N; D = dst + (size_t)bt * dst_rows * K; k0 = tk * 64 + 8 * kg; n = tn * 32 + 4 * ng;
    };
    auto load = [&](f32x4 (&x)[8], const float* S, int k0, int n) {
#pragma unroll
        for (int j = 0; j < 8; ++j) { x[j] = (f32x4){0.f, 0.f, 0.f, 0.f}; if (n < N) x[j] = *(const f32x4*)(S + (size_t)(k0 + j) * N + n); }
    };
    auto store = [&](const f32x4 (&x)[8], bf16_t* D, int k0, int n) {
#pragma unroll
        for (int i = 0; i < 4; ++i) {
            const int drow = (mode == 1) ? w1map(n + i) : (n + i);
            *(u32x4*)(D + (size_t)drow * K + k0) = (u32x4){pack2(x[0][i], x[1][i]), pack2(x[2][i], x[3][i]), pack2(x[4][i], x[5][i]), pack2(x[6][i], x[7][i])};
        }
    };
    const float* S0; bf16_t* D0; int k00, n0;
    coords(u, S0, D0, k00, n0);
    load(v, S0, k00, n0);
#pragma unroll 1
    for (;;) {
        const int u1 = u + stride;
        const float* S1 = S0; bf16_t* D1 = D0; int k01 = k00, n1 = n0;
        if (u1 < total) { coords(u1, S1, D1, k01, n1); load(w, S1, k01, n1); }
        store(v, D0, k00, n0);
        if (u1 >= total) break;
        const int u2 = u1 + stride;
        if (u2 < total) { coords(u2, S0, D0, k00, n0); load(v, S0, k00, n0); }
        store(w, D1, k01, n1);
        if (u2 >= total) break;
        u = u2;
    }
}

__device__ __forceinline__ void phase_convert(const P& p, char* lds) {
    conv_job(p.ab_w_in, p.wb_ab_in, 1024, 3072, 3072, 0, 1);
    conv_job(p.ab_w_out, p.wb_ab_out, 1024, 1024, 1024, 0, 1);
    conv_job(p.c_w_in, p.wb_c_in, 1024, C_IN_, C_INP, 0, 1);
    conv_job(p.c_w_out, p.wb_c_out, 1024, 1024, 1024, 0, 1);
    conv_job(p.moe_w1, p.wb_w1, 1024, 2048, 2048, 1, 64);
    conv_job(p.moe_w2, p.wb_w2, 1024, 1024, 1024, 0, 64);
    conv_job(p.ple_w_gate, p.wb_g, 1024, 1024, 1024, 0, 2);
    conv_job(p.ple_w_proj, p.wb_p, 256, 1024, 1024, 0, 2);
    const size_t gtid = (size_t)blockIdx.x * NTHR + otid(), gsz = (size_t)gridDim.x * NTHR;
    for (size_t i = gtid; i < (size_t)T_ * DM / 4; i += gsz) {
        const f32x4 v = *(const f32x4*)(p.x + 4 * i);
        *(uint2*)(p.xb + 4 * i) = make_uint2(pack2(v[0], v[1]), pack2(v[2], v[3]));
    }
    for (size_t i = gtid; i < (size_t)2 * T_ * 256 / 4; i += gsz) {
        const f32x4 v = *(const f32x4*)(p.p + 4 * i);
        *(uint2*)(p.pb + 4 * i) = make_uint2(pack2(v[0], v[1]), pack2(v[2], v[3]));
    }
    for (size_t i = gtid; i < (size_t)T_ * 32; i += gsz) {
        const int pos = (int)(i >> 5), k = (int)(i & 31);
        const double inv = exp2(-(double)k * (13.287712379549449 / 32.0));
        const double ang = (double)pos * inv;
        const double red = ang - 6.283185307179586 * floor(ang * 0.15915494309189535);
        float sn_, cs_;
        sincosf((float)red, &sn_, &cs_);
        p.rope[2 * i] = cs_;
        p.rope[2 * i + 1] = sn_;
    }
    for (size_t i = gtid; i < 8 * 64 * 64; i += gsz) p.ksum[i] = 0.f;
    if (blockIdx.x == 0 && otid() < 64) p.cnt[otid()] = 0;
    if (blockIdx.x == 0 && otid() < 32) p.kmax2[otid()] = 0u;
    if (blockIdx.x == 1) p.mb_cnt[otid()] = 0;
}

#define G_TILE_B 32768
#define G_STAGE_B 65536
#define G_LDS_B 131072
__device__ __forceinline__ int g_lds_byte(int r, int c) {
    const int st = (r >> 4) * 2 + (c >> 5), ob = (r & 15) * 64 + (c & 31) * 2;
    return st * 1024 + (ob ^ (((ob >> 9) & 1) << 5));
}
__device__ __forceinline__ void g_stage_rc(int b, int& R, int& C) {
    const int st = b >> 10, sb = b & 1023, swz = sb ^ (((sb >> 9) & 1) << 5);
    R = (st >> 1) * 16 + swz / 64;
    C = (st & 1) * 32 + (swz % 64) / 2;
}
__device__ __forceinline__ int xcd_remap(int l, int C) {
    const int chunk = (C + 7) >> 3, j = l >> 3, x = l & 7, ul = x * chunk + j;
    return (j < chunk && ul < C) ? ul : -1;
}
struct RoundUnits {
    int total;
    __device__ __forceinline__ int operator()(int k) const {
        const int G = gridDim.x, C = total - k * G;
        if (C <= 0) return -1;
        const int ul = xcd_remap(blockIdx.x, C < G ? C : G);
        return ul < 0 ? -1 : k * G + ul;
    }
};
#define G8_LAS __attribute__((address_space(3)))
#define G8_HTB 16384
struct AOff { unsigned o[2][2]; };

__device__ __forceinline__ void g8_rc(int i, int& R, int& C) { g_stage_rc(otid() * 16 + i * 8192, R, C); }
__device__ __forceinline__ AOff g8_dense_a(int row0, int ld) {
    AOff a; int R, C;
#pragma unroll
    for (int i = 0; i < 2; ++i) {
        g8_rc(i, R, C);
        a.o[0][i] = (unsigned)(((size_t)(row0 + R) * ld + C) * 2);
        a.o[1][i] = (unsigned)(((size_t)(row0 + 128 + R) * ld + C) * 2);
    }
    return a;
}

struct NoHalf { __device__ __forceinline__ bool operator()(int) const { return false; } };
template <bool TR, class UnitFn, class AFn, class BFn, class EpiFn, class HalfFn = NoHalf>
__device__ __forceinline__ void gemm8_units(UnitFn unit_of, int K, char* lds_, const bf16_t* Abase, AFn aoff_of, BFn bbase_of, EpiFn epi, HalfFn half_of = HalfFn()) {
    G8_LAS unsigned char* lds = (G8_LAS unsigned char*)lds_;
    const int tid = otid(), wid = __builtin_amdgcn_readfirstlane(tid >> 6), lane = tid & 63, wr = wid >> 2, wc = wid & 3, fr = lane & 15, fq = lane >> 4;
    const int nt = K / 64;
    int cur = unit_of(0);
    if (cur < 0) return;
    unsigned voffB[2];
#pragma unroll
    for (int i = 0; i < 2; ++i) { int R, C; g8_rc(i, R, C); voffB[i] = (unsigned)(((64 * (R >> 5) + (R & 31)) * K + C) * 2); }
    const size_t kstep = 128;
    const size_t hstepB = (size_t)32 * K * 2;
    const unsigned ldsw = (unsigned)wid * 1024u;
    const int aoffl = g_lds_byte(wr * 64 + fr, fq * 8), boffl = g_lds_byte(wc * 32 + fr, fq * 8);
#define G8_SA(b, h) (((b) * 2 + (h)) * G8_HTB)
#define G8_SB(b, h) ((4 + (b) * 2 + (h)) * G8_HTB)
#define G8_STAGE_A(bufoff, AO, h, kb) do { _Pragma("unroll") for (int _i = 0; _i < 2; ++_i) \
        __builtin_amdgcn_global_load_lds((const unsigned*)((const char*)Abase + (kb) + (AO).o[h][_i]), (G8_LAS unsigned*)(lds + (bufoff) + ldsw + _i * 8192), 16, 0, 0); } while (0)
#define G8_STAGE_B(bufoff, gbase) do { _Pragma("unroll") for (int _i = 0; _i < 2; ++_i) \
        __builtin_amdgcn_global_load_lds((const unsigned*)((const char*)(gbase) + voffB[_i]), (G8_LAS unsigned*)(lds + (bufoff) + ldsw + _i * 8192), 16, 0, 0); } while (0)
#define G8_LDA(dst, b, h) do { _Pragma("unroll") for (int m = 0; m < 4; ++m) _Pragma("unroll") for (int k = 0; k < 2; ++k) dst[m][k] = *(const G8_LAS bf16x8*)(lds + G8_SA(b, h) + aoffl + m * 2048 + k * 1024); } while (0)
#define G8_LDB(dst, b, h) do { _Pragma("unroll") for (int n = 0; n < 2; ++n) _Pragma("unroll") for (int k = 0; k < 2; ++k) dst[n][k] = *(const G8_LAS bf16x8*)(lds + G8_SB(b, h) + boffl + n * 2048 + k * 1024); } while (0)
#define G8_MMA(ai, bj, At_, Bt_) do { __builtin_amdgcn_s_setprio(1); _Pragma("unroll") for (int m = 0; m < 4; ++m) _Pragma("unroll") for (int n = 0; n < 2; ++n) _Pragma("unroll") for (int k = 0; k < 2; ++k) \
        acc[ai][bj][m][n] = TR ? __builtin_amdgcn_mfma_f32_16x16x32_bf16(Bt_[n][k], At_[m][k], acc[ai][bj][m][n], 0, 0, 0) \
                               : __builtin_amdgcn_mfma_f32_16x16x32_bf16(At_[m][k], Bt_[n][k], acc[ai][bj][m][n], 0, 0, 0); __builtin_amdgcn_s_setprio(0); } while (0)
#define G8_WAIT_V(n) asm volatile("s_waitcnt vmcnt(" #n ")" ::: "memory")
#define G8_WAIT_L(n) asm volatile("s_waitcnt lgkmcnt(" #n ")" ::: "memory")
#define G8_BAR __builtin_amdgcn_s_barrier()
#define G8_SCHED __builtin_amdgcn_sched_barrier(0)
    f32x4 acc[2][2][4][2];
#pragma unroll
    for (int a = 0; a < 2; ++a)
#pragma unroll
        for (int b = 0; b < 2; ++b)
#pragma unroll
            for (int m = 0; m < 4; ++m)
#pragma unroll
                for (int n = 0; n < 2; ++n) acc[a][b][m][n] = (f32x4){0.f, 0.f, 0.f, 0.f};
    bf16x8 At[4][2], B0[2][2], B1[2][2];
    AOff cA = aoff_of(cur), nA = cA;
    const char* cB = (const char*)bbase_of(cur);
    __syncthreads();
    G8_STAGE_B(G8_SB(0, 0), cB); G8_STAGE_A(G8_SA(0, 0), cA, 0, 0); G8_STAGE_B(G8_SB(0, 1), cB + hstepB); G8_STAGE_A(G8_SA(0, 1), cA, 1, 0);
    if (wr == 1) G8_BAR;
    G8_WAIT_V(4); G8_BAR;
    G8_STAGE_B(G8_SB(1, 0), cB + kstep); G8_STAGE_A(G8_SA(1, 0), cA, 0, kstep); G8_STAGE_B(G8_SB(1, 1), cB + hstepB + kstep);
    G8_WAIT_V(6); G8_BAR;
    for (int ui = 0;; ++ui) {
        const int nxt = unit_of(ui + 1);
        const bool has_next = nxt >= 0;
        const char* nB = cB;
        if (has_next) { nA = aoff_of(nxt); nB = (const char*)bbase_of(nxt); } else nA = cA;
        for (int t = 0; t < nt; t += 2) {
            const bool last = (t == nt - 2);
            const size_t k1 = (size_t)(t + 1) * kstep;
            AOff a2;
#pragma unroll
            for (int hh = 0; hh < 2; ++hh)
#pragma unroll
                for (int i = 0; i < 2; ++i) a2.o[hh][i] = last ? nA.o[hh][i] : cA.o[hh][i];
            const size_t k2 = last ? 0 : (size_t)(t + 2) * kstep, k3 = k2 + kstep;
            const char* b2 = last ? nB : cB + (size_t)(t + 2) * kstep;
            const char* b3 = b2 + kstep;
            G8_LDB(B0, 0, 0); G8_SCHED; G8_LDA(At, 0, 0); G8_STAGE_A(G8_SA(1, 1), cA, 1, k1);
            G8_WAIT_L(8); G8_BAR; G8_WAIT_L(0); G8_MMA(0, 0, At, B0); G8_BAR; G8_SCHED;
            G8_LDB(B1, 0, 1); G8_STAGE_B(G8_SB(0, 0), b2);
            G8_BAR; G8_WAIT_L(0); G8_MMA(0, 1, At, B1); G8_BAR;
            G8_LDA(At, 0, 1); G8_STAGE_A(G8_SA(0, 0), a2, 0, k2);
            G8_BAR; G8_WAIT_L(0); G8_MMA(1, 0, At, B0); G8_BAR; G8_SCHED;
            G8_STAGE_B(G8_SB(0, 1), b2 + hstepB);
            G8_WAIT_V(6); G8_BAR; G8_MMA(1, 1, At, B1); G8_BAR;
            G8_LDB(B0, 1, 0); G8_SCHED; G8_LDA(At, 1, 0); G8_STAGE_A(G8_SA(0, 1), a2, 1, k2);
            G8_WAIT_L(8); G8_BAR; G8_WAIT_L(0); G8_MMA(0, 0, At, B0); G8_BAR; G8_SCHED;
            G8_LDB(B1, 1, 1); G8_STAGE_B(G8_SB(1, 0), b3);
            G8_BAR; G8_WAIT_L(0); G8_MMA(0, 1, At, B1); G8_BAR;
            G8_LDA(At, 1, 1); G8_STAGE_A(G8_SA(1, 0), a2, 0, k3);
            G8_BAR; G8_WAIT_L(0); G8_MMA(1, 0, At, B0); G8_BAR; G8_SCHED;
            G8_STAGE_B(G8_SB(1, 1), b3 + hstepB);
            G8_WAIT_V(6); G8_BAR; G8_MMA(1, 1, At, B1); G8_BAR;
        }
        epi(cur, acc, wr, wc, fr, fq);
        if (!has_next) break;
#pragma unroll
        for (int a = 0; a < 2; ++a)
#pragma unroll
            for (int b = 0; b < 2; ++b)
#pragma unroll
                for (int m = 0; m < 4; ++m)
#pragma unroll
                    for (int n = 0; n < 2; ++n) acc[a][b][m][n] = (f32x4){0.f, 0.f, 0.f, 0.f};
        cur = nxt; cA = nA; cB = nB;
    }
    G8_WAIT_V(0);
    if (wr == 0) G8_BAR;
    G8_BAR;
#undef G8_SA
#undef G8_SB
#undef G8_STAGE_A
#undef G8_STAGE_B
#undef G8_LDA
#undef G8_LDB
#undef G8_MMA
#undef G8_WAIT_V
#undef G8_WAIT_L
#undef G8_BAR
#undef G8_SCHED
}
typedef f32x4 Acc8[2][2][4][2];
__device__ __forceinline__ void phase_pp(const P& p, char* lds) {
    gemm8_units<true>(RoundUnits{2 * 64 * 4}, 256, lds, p.pb,
        [&](int t) { const int l = t >> 8, mt = (t & 255) >> 2; return g8_dense_a(l * T_ + mt * 256, 256); },
        [&](int t) { const int l = t >> 8, nt = t & 3; return p.wb_p + ((size_t)l * 1024 + nt * 256) * 256; },
        [&](int t, Acc8& acc, int wr, int wc, int fr, int fq) {
            const int l = t >> 8, mt = (t & 255) >> 2, nt = t & 3;
            float* O = p.pp + (size_t)l * T_ * DM;
#pragma unroll
            for (int ai = 0; ai < 2; ++ai)
#pragma unroll
                for (int m = 0; m < 4; ++m)
#pragma unroll
                    for (int bj = 0; bj < 2; ++bj)
#pragma unroll
                        for (int n = 0; n < 2; ++n) {
                            const int tok = mt * 256 + 128 * ai + 64 * wr + 16 * m + fr, col = nt * 256 + 64 * wc + 32 * bj + 16 * n + 4 * fq;
                            *(f32x4*)(O + (size_t)tok * DM + col) = acc[ai][bj][m][n];
                        }
        });
}

template <bool ROPE>
__device__ __forceinline__ void epi_rows(const P& p, bf16_t* dst, int stride, Acc8& acc, int tok0, int wr, int fr, int fq, float scale) {
#pragma unroll
    for (int ai = 0; ai < 2; ++ai)
#pragma unroll
        for (int m = 0; m < 4; ++m) {
            const int tok = tok0 + 128 * ai + 64 * wr + 16 * m + fr;
            if (ROPE) {
#pragma unroll
                for (int n = 0; n < 2; ++n) {
                    const float* rt = p.rope + ((size_t)tok * 32 + n * 16 + 4 * fq) * 2;
                    const f32x4 cs0 = *(const f32x4*)rt, cs1 = *(const f32x4*)(rt + 4);
                    const float c[4] = {cs0[0], cs0[2], cs1[0], cs1[2]}, sn[4] = {cs0[1], cs0[3], cs1[1], cs1[3]};
#pragma unroll
                    for (int j = 0; j < 4; ++j) {
                        const float x1 = acc[ai][0][m][n][j], x2 = acc[ai][1][m][n][j];
                        acc[ai][0][m][n][j] = x1 * c[j] - x2 * sn[j];
                        acc[ai][1][m][n][j] = x2 * c[j] + x1 * sn[j];
                    }
                }
            }
#pragma unroll
            for (int bj = 0; bj < 2; ++bj)
#pragma unroll
                for (int n = 0; n < 2; ++n) {
                    const f32x4 v = acc[ai][bj][m][n] * scale;
                    *(uint2*)(dst + (size_t)tok * stride + 32 * bj + 16 * n + 4 * fq) = make_uint2(pack2(v[0], v[1]), pack2(v[2], v[3]));
                }
            __builtin_amdgcn_sched_barrier(0);
        }
}
template <bool KSUM>
__device__ __forceinline__ void epi_key(const P& p, bf16_t* dst, Acc8& acc, int tok0, int wr, int fr, int fq, unsigned* kmax2, float* ks) {
    f32x4 sum[2][2];
#pragma unroll
    for (int bj = 0; bj < 2; ++bj)
#pragma unroll
        for (int n = 0; n < 2; ++n) sum[bj][n] = (f32x4){0.f, 0.f, 0.f, 0.f};
    float mx = 0.f;
#pragma unroll
    for (int ai = 0; ai < 2; ++ai)
#pragma unroll
        for (int m = 0; m < 4; ++m) {
            const int tok = tok0 + 128 * ai + 64 * wr + 16 * m + fr;
#pragma unroll
            for (int n = 0; n < 2; ++n) {
                const float* rt = p.rope + ((size_t)tok * 32 + n * 16 + 4 * fq) * 2;
                const f32x4 cs0 = *(const f32x4*)rt, cs1 = *(const f32x4*)(rt + 4);
                const float c[4] = {cs0[0], cs0[2], cs1[0], cs1[2]}, sn[4] = {cs0[1], cs0[3], cs1[1], cs1[3]};
#pragma unroll
                for (int j = 0; j < 4; ++j) {
                    const float x1 = acc[ai][0][m][n][j], x2 = acc[ai][1][m][n][j];
                    acc[ai][0][m][n][j] = x1 * c[j] - x2 * sn[j];
                    acc[ai][1][m][n][j] = x2 * c[j] + x1 * sn[j];
                }
            }
            float ss = 0.f;
#pragma unroll
            for (int bj = 0; bj < 2; ++bj)
#pragma unroll
                for (int n = 0; n < 2; ++n) {
                    const f32x4 a = acc[ai][bj][m][n];
                    const unsigned w0 = pack2(a[0], a[1]), w1 = pack2(a[2], a[3]);
                    *(uint2*)(dst + (size_t)tok * 64 + 32 * bj + 16 * n + 4 * fq) = make_uint2(w0, w1);
                    const float e0 = __uint_as_float(w0 << 16), e1 = __uint_as_float(w0 & 0xffff0000u), e2 = __uint_as_float(w1 << 16), e3 = __uint_as_float(w1 & 0xffff0000u);
                    ss += (e0 * e0 + e1 * e1) + (e2 * e2 + e3 * e3);
                    if (KSUM) sum[bj][n] = sum[bj][n] + a;
                }
            ss += __shfl_xor(ss, 16);
            ss += __shfl_xor(ss, 32);
            mx = fmaxf(mx, ss);
            __builtin_amdgcn_sched_barrier(0);
        }
#pragma unroll
    for (int o = 8; o > 0; o >>= 1) mx = fmaxf(mx, __shfl_xor(mx, o));
    if ((otid() & 63) == 0) atomicMax(kmax2, __float_as_uint(mx));
    if (KSUM) {
#pragma unroll
        for (int bj = 0; bj < 2; ++bj)
#pragma unroll
            for (int n = 0; n < 2; ++n) {
                f32x4 sv = sum[bj][n];
#pragma unroll
                for (int o = 1; o < 16; o <<= 1) { sv[0] += __shfl_xor(sv[0], o); sv[1] += __shfl_xor(sv[1], o); sv[2] += __shfl_xor(sv[2], o); sv[3] += __shfl_xor(sv[3], o); }
                if (fr == 0) {
#pragma unroll
                    for (int j = 0; j < 4; ++j) atomicAdd(ks + 32 * bj + 16 * n + 4 * fq + j, sv[j]);
                }
            }
    }
}
__device__ __forceinline__ void epi_vT(bf16_t* dst  , Acc8& acc, int tok0, int wr, int fr, int fq) {
#pragma unroll
    for (int ai = 0; ai < 2; ++ai)
#pragma unroll
        for (int m = 0; m < 4; ++m)
#pragma unroll
            for (int bj = 0; bj < 2; ++bj)
#pragma unroll
                for (int n = 0; n < 2; ++n) {
                    const f32x4 v = acc[ai][bj][m][n];
                    *(uint2*)(dst + (size_t)(32 * bj + 16 * n + fr) * T_ + tok0 + 128 * ai + 64 * wr + 16 * m + 4 * fq) = make_uint2(pack2(v[0], v[1]), pack2(v[2], v[3]));
                }
}

template <bool TR, class NtFn, class EpiFn>
__device__ __forceinline__ void typed_loop(const P& p, char* lds, const bf16_t* W, int& base, int count, NtFn ntile_of, EpiFn epi) {
    const int G = gridDim.x, bidx = blockIdx.x, b0 = base;
    const int l = (((bidx - b0) % G) + G) % G;
    const int ul = l < count ? xcd_remap(l, count) : -1;
    gemm8_units<TR>([&](int k) { return (k == 0 && ul >= 0) ? ul : -1; }, DM, lds, p.xb,
        [&](int t) { int mt, nt; ntile_of(t, mt, nt); return g8_dense_a(mt * 256, DM); },
        [&](int t) { int mt, nt; ntile_of(t, mt, nt); return W + (size_t)nt * 256 * DM; },
        [&](int t, Acc8& acc, int wr, int wc, int fr, int fq) { int mt, nt; ntile_of(t, mt, nt); epi(acc, mt, nt, mt * 256, wr, wc, fr, fq); });
    base += count;
}

template <int LAYER>
__device__ __forceinline__ void phase_inproj(const P& p, char* lds) {
    int base = 0;
    if (LAYER == 0) {
        const bf16_t* W = p.wb_ab_in;
        typed_loop<true>(p, lds, W, base, 128, [](int i, int& mt, int& nt) { mt = i >> 1; nt = i & 1; },
            [&](Acc8& acc, int mt, int nt, int tok0, int wr, int wc, int fr, int fq) {
                epi_rows<false>(p, p.q16 + (size_t)(nt * 4 + wc) * T_ * 64, 64, acc, tok0, wr, fr, fq, 0.125f); });
        typed_loop<true>(p, lds, W, base, 128, [](int i, int& mt, int& nt) { mt = i >> 1; nt = 2 + (i & 1); },
            [&](Acc8& acc, int mt, int nt, int tok0, int wr, int wc, int fr, int fq) {
                epi_rows<false>(p, p.k16 + (size_t)((nt - 2) * 4 + wc) * T_ * 64, 64, acc, tok0, wr, fr, fq, 1.0f); });
        typed_loop<false>(p, lds, W, base, 256, [](int i, int& mt, int& nt) { mt = i >> 2; const int vi = i & 3; nt = (vi < 2 ? 4 : 8) + vi; },
            [&](Acc8& acc, int mt, int nt, int tok0, int wr, int wc, int fr, int fq) {
                const int head = (nt < 6 ? 0 : 8) + (nt & 1) * 4 + wc;
                epi_vT(p.vT16 + (size_t)head * 64 * T_, acc, tok0, wr, fr, fq); });
        typed_loop<true>(p, lds, W, base, 128, [](int i, int& mt, int& nt) { mt = i >> 1; nt = 6 + (i & 1); },
            [&](Acc8& acc, int mt, int nt, int tok0, int wr, int wc, int fr, int fq) {
                epi_rows<true>(p, p.q16 + (size_t)(8 + (nt - 6) * 4 + wc) * T_ * 64, 64, acc, tok0, wr, fr, fq, 0.125f * LOG2E); });
        typed_loop<true>(p, lds, W, base, 128, [](int i, int& mt, int& nt) { mt = i >> 1; nt = 8 + (i & 1); },
            [&](Acc8& acc, int mt, int nt, int tok0, int wr, int wc, int fr, int fq) {
                const int hd = (nt - 8) * 4 + wc;
                epi_key<true>(p, p.k16 + (size_t)(8 + hd) * T_ * 64, acc, tok0, wr, fr, fq, p.kmax2 + 8 + hd, p.ksum + ((size_t)hd * 64 + mt) * 64); });
    } else {
        const bf16_t* W = p.wb_c_in;
        typed_loop<true>(p, lds, W, base, 256, [](int i, int& mt, int& nt) { mt = i >> 2; nt = i & 3; },
            [&](Acc8& acc, int mt, int nt, int tok0, int wr, int wc, int fr, int fq) {
                epi_rows<true>(p, p.q16 + (size_t)(nt * 4 + wc) * T_ * 64, 64, acc, tok0, wr, fr, fq, 0.125f * LOG2E); });
        typed_loop<true>(p, lds, W, base, 256, [](int i, int& mt, int& nt) { mt = i >> 2; nt = 4 + (i & 3); },
            [&](Acc8& acc, int mt, int nt, int tok0, int wr, int wc, int fr, int fq) {
                const int hd = (nt - 4) * 4 + wc;
                epi_key<false>(p, p.k16 + (size_t)hd * T_ * 64, acc, tok0, wr, fr, fq, p.kmax2 + 16 + hd, nullptr); });
        typed_loop<false>(p, lds, W, base, 256, [](int i, int& mt, int& nt) { mt = i >> 2; nt = 8 + (i & 3); },
            [&](Acc8& acc, int mt, int nt, int tok0, int wr, int wc, int fr, int fq) {
                epi_vT(p.vT16 + (size_t)((nt - 8) * 4 + wc) * 64 * T_, acc, tok0, wr, fr, fq); });
        typed_loop<true>(p, lds, W, base, 128, [](int i, int& mt, int& nt) { mt = i >> 1; nt = 12 + (i & 1); },
            [&](Acc8& acc, int mt, int nt, int tok0, int wr, int wc, int fr, int fq) {
                const int hd = (nt - 12) * 4 + wc;
                epi_rows<true>(p, p.qi + (size_t)hd * 64, 512, acc, tok0, wr, fr, fq, 0.125f); });
        typed_loop<true>(p, lds, W, base, 64, [](int i, int& mt, int& nt) { mt = i; nt = 14; },
            [&](Acc8& acc, int mt, int nt, int tok0, int wr, int wc, int fr, int fq) {
                if (wc == 0) {
                    epi_rows<true>(p, p.ki, 64, acc, tok0, wr, fr, fq, 1.0f);
                } else if (wc == 1 && fq < 2) {
#pragma unroll
                    for (int ai = 0; ai < 2; ++ai)
#pragma unroll
                        for (int m = 0; m < 4; ++m)
                            *(f32x4*)(p.wi + (size_t)(tok0 + 128 * ai + 64 * wr + 16 * m + fr) * 8 + 4 * fq) = acc[ai][0][m][0] * 0.35355339059327373f;
                } });
    }
}
__device__ __forceinline__ void phase_outproj(const P& p, const bf16_t* W, const float* xres, char* lds) {
    gemm8_units<true>(RoundUnits{64 * 4}, DM, lds, p.o,
        [&](int t) { return g8_dense_a((t >> 2) * 256, DM); },
        [&](int t) { return W + (size_t)(t & 3) * 256 * DM; },
        [&](int t, Acc8& acc, int wr, int wc, int fr, int fq) {
            const int mt = t >> 2, nt = t & 3;
#pragma unroll
            for (int ai = 0; ai < 2; ++ai)
#pragma unroll
                for (int m = 0; m < 4; ++m)
#pragma unroll
                    for (int bj = 0; bj < 2; ++bj)
#pragma unroll
                        for (int n = 0; n < 2; ++n) {
                            const size_t off = (size_t)(mt * 256 + 128 * ai + 64 * wr + 16 * m + fr) * DM + nt * 256 + 64 * wc + 32 * bj + 16 * n + 4 * fq;
                            const f32x4 xr = *(const f32x4*)(xres + off);
                            *(f32x4*)(p.ypre + off) = xr * DN_ALPHA + acc[ai][bj][m][n];
                        }
        });
}

__device__ __forceinline__ void ln_row(f32x4 (&v)[4], const float* g, const float* b, int lane) {
    float s = 0.f;
#pragma unroll
    for (int c = 0; c < 4; ++c) s += (v[c][0] + v[c][1]) + (v[c][2] + v[c][3]);
    const float mu = wave_sum(s) * (1.0f / DM);
    float q = 0.f;
#pragma unroll
    for (int c = 0; c < 4; ++c) {
        v[c] = v[c] - mu;
        q += (v[c][0] * v[c][0] + v[c][1] * v[c][1]) + (v[c][2] * v[c][2] + v[c][3] * v[c][3]);
    }
    const float rstd = 1.0f / sqrtf(wave_sum(q) * (1.0f / DM) + 1e-5f);
#pragma unroll
    for (int c = 0; c < 4; ++c) {
        const f32x4 gg = *(const f32x4*)(g + 4 * lane + 256 * c), bb = *(const f32x4*)(b + 4 * lane + 256 * c);
        v[c] = v[c] * rstd * gg + bb;
    }
}

#define RT_XS_STRIDE 1025
#define RT_RED_OFF (32 * RT_XS_STRIDE * 4)
#define RT_DEC_OFF (RT_RED_OFF + 16384)
__device__ __forceinline__ void phase_ln_router(const P& p, int layer, char* lds) {
    const int tid = otid(), lane = tid & 63, wid = tid >> 6;
    float* xs = (float*)lds;
    float* red = (float*)(lds + RT_RED_OFF);
    int* dec = (int*)(lds + RT_DEC_OFF);
    float* decg = (float*)(lds + RT_DEC_OFF + 1024);
    int* lcnt = (int*)(lds + RT_DEC_OFF + 2048);
    int* gbase = lcnt + 32;
    const float* g = p.ln_g + (size_t)(layer * 2 + 0) * DM;
    const float* b = p.ln_b + (size_t)(layer * 2 + 0) * DM;
    const float* wr_ = p.router_w + (size_t)layer * DM * NEXP;
    const float* br_ = p.router_b + layer * NEXP;
    int* cnt = p.cnt + layer * NEXP;
#pragma unroll 1
    for (int itb = 0; (blockIdx.x + itb * gridDim.x) * 32 < T_; itb += 2) {
    __syncthreads();
    if (tid < 32) lcnt[tid] = 0;
#pragma unroll 1
    for (int it = 0; it < 2; ++it) {
        const int t0 = (blockIdx.x + (itb + it) * gridDim.x) * 32;
        if (t0 >= T_) break;
#pragma unroll 1
        for (int r = 0; r < 4; ++r) {
            const int tl_ = wid * 4 + r, tok = t0 + tl_;
            f32x4 v[4];
#pragma unroll
            for (int c = 0; c < 4; ++c) v[c] = *(const f32x4*)(p.ypre + (size_t)tok * DM + 4 * lane + 256 * c);
            ln_row(v, g, b, lane);
#pragma unroll
            for (int c = 0; c < 4; ++c) {
                *(f32x4*)(p.x1 + (size_t)tok * DM + 4 * lane + 256 * c) = v[c];
                *(uint2*)(p.x1b + (size_t)tok * DM + 4 * lane + 256 * c) = make_uint2(pack2(v[c][0], v[c][1]), pack2(v[c][2], v[c][3]));
                float* xr = xs + tl_ * RT_XS_STRIDE + 4 * lane + 256 * c;
                xr[0] = v[c][0]; xr[1] = v[c][1]; xr[2] = v[c][2]; xr[3] = v[c][3];
            }
        }
        __syncthreads();
        f32x16 d;
#pragma unroll
        for (int i = 0; i < 16; ++i) d[i] = 0.f;
        {
            const int i_ = lane & 31, kk = lane >> 5;
            const float* xa = xs + i_ * RT_XS_STRIDE + wid * 128 + kk;
            const float* wb = wr_ + (size_t)(wid * 128 + kk) * NEXP + i_;
#pragma unroll 8
            for (int s = 0; s < 64; ++s) d = __builtin_amdgcn_mfma_f32_32x32x2f32(xa[2 * s], wb[(size_t)(2 * s) * NEXP], d, 0, 0, 0);
        }
#pragma unroll
        for (int step = 4; step >= 1; step >>= 1) {
            if (wid >= step && wid < 2 * step) {
                float* rb = red + (wid - step) * 1024;
#pragma unroll
                for (int i = 0; i < 16; ++i) rb[i * 64 + lane] = d[i];
            }
            __syncthreads();
            if (wid < step) {
                const float* rb = red + wid * 1024;
#pragma unroll
                for (int i = 0; i < 16; ++i) d[i] += rb[i * 64 + lane];
            }
            __syncthreads();
        }
        if (wid == 0) {
#pragma unroll
            for (int i = 0; i < 16; ++i) red[((i & 3) + 8 * (i >> 2) + 4 * (lane >> 5)) * 32 + (lane & 31)] = d[i];
        }
        __syncthreads();
#pragma unroll
        for (int r = 0; r < 2; ++r) {
            const int e = lane & 31, hf = lane >> 5, tl_ = wid * 4 + 2 * r + hf;
            float cur = red[tl_ * 32 + e] + br_[e];
            float tv[4]; int ti[4];
#pragma unroll
            for (int k = 0; k < 4; ++k) {
                float mv = cur;
#pragma unroll
                for (int o = 16; o > 0; o >>= 1) mv = fmaxf(mv, __shfl_xor(mv, o));
                const unsigned long long bal = __ballot(cur == mv);
                const unsigned bh = hf ? (unsigned)(bal >> 32) : (unsigned)bal;
                const int idx = __ffs(bh) - 1;
                tv[k] = mv; ti[k] = idx;
                if (e == idx) cur = -3.0e38f;
            }
            const float e1 = __expf(tv[1] - tv[0]), e2 = __expf(tv[2] - tv[0]), e3 = __expf(tv[3] - tv[0]);
            const float inv = 1.0f / (1.0f + e1 + e2 + e3);
            if (e < 4) {
                const int ee = e == 0 ? ti[0] : e == 1 ? ti[1] : e == 2 ? ti[2] : ti[3];
                const float gg = e == 0 ? inv : e == 1 ? e1 * inv : e == 2 ? e2 * inv : e3 * inv;
                const int lpos = atomicAdd(lcnt + ee, 1);
                dec[(it * 32 + tl_) * 4 + e] = ee | (lpos << 8);
                decg[(it * 32 + tl_) * 4 + e] = gg;
            }
        }
        __syncthreads();
    }
    if (tid < 32) gbase[tid] = lcnt[tid] > 0 ? atomicAdd(cnt + tid, lcnt[tid]) : 0;
    __syncthreads();
    if (tid < 256) {
        const int it = tid >> 7, t0 = (blockIdx.x + (itb + it) * gridDim.x) * 32;
        if (t0 < T_) {
            const int tok = t0 + ((tid >> 2) & 31), k = tid & 3;
            const int dv = dec[tid], ee = dv & 255, pos = gbase[ee] + (dv >> 8);
            p.tok_of[(size_t)ee * T_ + pos] = tok;
            p.sel_e[tok * 4 + k] = ee;
            p.sel_pos[tok * 4 + k] = pos;
            p.sel_g[tok * 4 + k] = decg[tid];
        }
    }
    }
    __syncthreads();
}

__device__ __forceinline__ void moe_prefix(const int* cnt, int* mpre) {
    if (otid() == 0) {
        int s = 0;
        for (int e = 0; e < NEXP; ++e) { mpre[e] = s; s += (cnt[e] + 255) >> 8; }
        mpre[NEXP] = s;
    }
    __syncthreads();
}
#define MPRE_OFF G_LDS_B

__device__ __forceinline__ void phase_moe1(const P& p, int layer, char* lds) {
    int* mpre = (int*)(lds + MPRE_OFF);
    const int* cnt = p.cnt + layer * NEXP;
    moe_prefix(cnt, mpre);
    const int total = mpre[NEXP] * 8;
    auto expert_of = [&](int mg) { int e = 0;
#pragma unroll 1
        while (mpre[e + 1] <= mg) ++e;
        return e; };
    gemm8_units<true>(RoundUnits{total}, DM, lds, p.x1b,
        [&](int t) {
            const int mg = t >> 3, e = expert_of(mg), i = mg - mpre[e], ce_ = cnt[e];
            const int* tk = p.tok_of + (size_t)e * T_;
            AOff a; int R, C;
#pragma unroll
            for (int ii = 0; ii < 2; ++ii) {
                g8_rc(ii, R, C);
                const int p0 = i * 256 + R, p1 = p0 + 128;
                a.o[0][ii] = (unsigned)(((size_t)tk[p0 < ce_ ? p0 : 0] * DM + C) * 2);
                a.o[1][ii] = (unsigned)(((size_t)tk[p1 < ce_ ? p1 : 0] * DM + C) * 2);
            }
            return a;
        },
        [&](int t) { const int mg = t >> 3, nt = t & 7, e = expert_of(mg); return p.wb_w1 + ((size_t)(layer * NEXP + e) * 2048 + nt * 256) * DM; },
        [&](int t, Acc8& acc, int wr, int wc, int fr, int fq) {
            const int mg = t >> 3, nt = t & 7, e = expert_of(mg);
            const float* b1 = p.moe_b1 + (size_t)(layer * NEXP + e) * 2048;
#pragma unroll
            for (int n = 0; n < 2; ++n) {
                const int j0 = nt * 128 + wc * 32 + n * 16 + 4 * fq;
                float bg[4], bu[4];
#pragma unroll
                for (int j = 0; j < 4; ++j) { bg[j] = b1[2 * (j0 + j)]; bu[j] = b1[2 * (j0 + j) + 1]; }
#pragma unroll
                for (int ai = 0; ai < 2; ++ai)
#pragma unroll
                    for (int m = 0; m < 4; ++m) {
                        float r[4];
#pragma unroll
                        for (int j = 0; j < 4; ++j) {
                            const float gv = fminf(acc[ai][0][m][n][j] + bg[j], 7.0f);
                            const float uv = fminf(fmaxf(acc[ai][1][m][n][j] + bu[j], -7.0f), 7.0f);
                            const float glu = gv * sigmoidf_(1.702f * gv);
                            r[j] = (uv + 1.0f) * glu;
                        }
                        const size_t slot = (size_t)mg * 256 + 128 * ai + 64 * wr + 16 * m + fr;
                        *(uint2*)(p.act + slot * DM + j0) = make_uint2(pack2(r[0], r[1]), pack2(r[2], r[3]));
                    }
            }
        },
        [&](int t) { const int mg = t >> 3, e = expert_of(mg); return cnt[e] - (mg - mpre[e]) * 256 <= 128; });
}

__device__ __forceinline__ void phase_moe2(const P& p, int layer, char* lds) {
    int* mpre = (int*)(lds + MPRE_OFF);
    const int* cnt = p.cnt + layer * NEXP;
    moe_prefix(cnt, mpre);
    const int total = mpre[NEXP] * 4;
    auto expert_of = [&](int mg) { int e = 0;
#pragma unroll 1
        while (mpre[e + 1] <= mg) ++e;
        return e; };
    gemm8_units<true>(RoundUnits{total}, DM, lds, p.act,
        [&](int t) { return g8_dense_a((t >> 2) * 256, DM); },
        [&](int t) { const int mg = t >> 2, nt = t & 3, e = expert_of(mg); return p.wb_w2 + ((size_t)(layer * NEXP + e) * 1024 + nt * 256) * DM; },
        [&](int t, Acc8& acc, int wr, int wc, int fr, int fq) {
            const int mg = t >> 2, nt = t & 3, e = expert_of(mg);
            const float* b2 = p.moe_b2 + (size_t)(layer * NEXP + e) * DM;
#pragma unroll
            for (int ai = 0; ai < 2; ++ai)
#pragma unroll
                for (int m = 0; m < 4; ++m)
#pragma unroll
                    for (int bj = 0; bj < 2; ++bj)
#pragma unroll
                        for (int n = 0; n < 2; ++n) {
                            const int col = nt * 256 + 64 * wc + 32 * bj + 16 * n + 4 * fq;
                            const f32x4 v = acc[ai][bj][m][n] + *(const f32x4*)(b2 + col);
                            const size_t slot = (size_t)mg * 256 + 128 * ai + 64 * wr + 16 * m + fr;
                            *(uint2*)(p.oslot + slot * DM + col) = make_uint2(pack2(v[0], v[1]), pack2(v[2], v[3]));
                        }
        },
        [&](int t) { const int mg = t >> 2, e = expert_of(mg); return cnt[e] - (mg - mpre[e]) * 256 <= 128; });
}

__device__ __forceinline__ void phase_combine_ln(const P& p, int layer, char* lds) {
    const int tid = otid(), lane = tid & 63, wid = tid >> 6;
    int* mpre = (int*)(lds + MPRE_OFF);
    moe_prefix(p.cnt + layer * NEXP, mpre);
    const float* g = p.ln_g + (size_t)(layer * 2 + 1) * DM;
    const float* b = p.ln_b + (size_t)(layer * 2 + 1) * DM;
#pragma unroll 1
    for (int tok = blockIdx.x * NWAVE + wid; tok < T_; tok += gridDim.x * NWAVE) {
        f32x4 v[4];
#pragma unroll
        for (int c = 0; c < 4; ++c) v[c] = *(const f32x4*)(p.x1 + (size_t)tok * DM + 4 * lane + 256 * c) * DN_ALPHA;
        f32x4 f[4];
#pragma unroll
        for (int c = 0; c < 4; ++c) f[c] = (f32x4){0.f, 0.f, 0.f, 0.f};
#pragma unroll
        for (int k = 0; k < 4; ++k) {
            const int e = p.sel_e[tok * 4 + k], pos = p.sel_pos[tok * 4 + k];
            const float gt = p.sel_g[tok * 4 + k];
            const bf16_t* row = p.oslot + ((size_t)mpre[e] * 256 + pos) * DM;
#pragma unroll
            for (int c = 0; c < 4; ++c) {
                const uint2 w = *(const uint2*)(row + 4 * lane + 256 * c);
                f[c][0] += gt * __uint_as_float(w.x << 16);
                f[c][1] += gt * __uint_as_float(w.x & 0xffff0000u);
                f[c][2] += gt * __uint_as_float(w.y << 16);
                f[c][3] += gt * __uint_as_float(w.y & 0xffff0000u);
            }
        }
#pragma unroll
        for (int c = 0; c < 4; ++c) v[c] = v[c] + f[c];
        ln_row(v, g, b, lane);
#pragma unroll
        for (int c = 0; c < 4; ++c) {
            *(f32x4*)(p.x2 + (size_t)tok * DM + 4 * lane + 256 * c) = v[c];
            *(uint2*)(p.x2b + (size_t)tok * DM + 4 * lane + 256 * c) = make_uint2(pack2(v[c][0], v[c][1]), pack2(v[c][2], v[c][3]));
        }
    }
}

__device__ __forceinline__ void phase_ple(const P& p, int layer, float* xout, char* lds) {
    const float* pp = p.pp + (size_t)layer * T_ * DM;
    gemm8_units<true>(RoundUnits{64 * 4}, DM, lds, p.x2b,
        [&](int t) { return g8_dense_a((t >> 2) * 256, DM); },
        [&](int t) { return p.wb_g + (size_t)layer * DM * DM + (size_t)(t & 3) * 256 * DM; },
        [&](int t, Acc8& acc, int wr, int wc, int fr, int fq) {
            const int mt = t >> 2, nt = t & 3;
#pragma unroll
            for (int ai = 0; ai < 2; ++ai)
#pragma unroll
                for (int m = 0; m < 4; ++m)
#pragma unroll
                    for (int bj = 0; bj < 2; ++bj)
#pragma unroll
                        for (int n = 0; n < 2; ++n) {
                            const size_t off = (size_t)(mt * 256 + 128 * ai + 64 * wr + 16 * m + fr) * DM + nt * 256 + 64 * wc + 32 * bj + 16 * n + 4 * fq;
                            const f32x4 x2v = *(const f32x4*)(p.x2 + off), ppv = *(const f32x4*)(pp + off);
                            f32x4 r;
#pragma unroll
                            for (int j = 0; j < 4; ++j) r[j] = x2v[j] + sigmoidf_(acc[ai][bj][m][n][j]) * ppv[j];
                            *(f32x4*)(xout + off) = r;
                            *(uint2*)(p.xb + off) = make_uint2(pack2(r[0], r[1]), pack2(r[2], r[3]));
                        }
        });
}
#define KROW 144
#define VROW 136
#define KTILE_B (64 * KROW)
#define VTILE_B (64 * VROW)
#define ABUF_B (KTILE_B + VTILE_B)

struct TileRegs { u32x4 k0, v0; };

__device__ __forceinline__ void tile_gload(TileRegs& r, const bf16_t* kbase  , const bf16_t* vtbase  , int k0) {
    const int ci = otid(), row = ci >> 3, cc = ci & 7;
    r.k0 = *(const u32x4*)(kbase + (size_t)(k0 + row) * 64 + cc * 8);
    r.v0 = *(const u32x4*)(vtbase + (size_t)row * T_ + k0 + cc * 8);
}
__device__ __forceinline__ void tile_swrite(const TileRegs& r, char* buf) {
    const int ci = otid(), row = ci >> 3, cc = ci & 7;
    *(u32x4*)(buf + row * KROW + cc * 16) = r.k0;
    *(uint2*)(buf + KTILE_B + row * VROW + cc * 16) = make_uint2(r.v0[0], r.v0[1]);
    *(uint2*)(buf + KTILE_B + row * VROW + cc * 16 + 8) = make_uint2(r.v0[2], r.v0[3]);
}

__device__ __forceinline__ void load_qfrag(bf16x8 (&qf)[4], const bf16_t* qrow  , int h) {
#pragma unroll
    for (int kk = 0; kk < 4; ++kk) qf[kk] = *(const bf16x8*)(qrow + 16 * kk + 8 * h);
}
__device__ __forceinline__ float qnorm2(const bf16x8 (&qf)[4]) {
    float s = 0.f;
#pragma unroll
    for (int kk = 0; kk < 4; ++kk)
#pragma unroll
        for (int j = 0; j < 8; ++j) { const float e = bf2f((bf16_t)qf[kk][j]); s += e * e; }
    return s + __shfl_xor(s, 32);
}

__device__ __forceinline__ f32x16 qk_subtile(const char* kbuf, int t2, const bf16x8 (&qf)[4], int c, int h) {
    f32x16 s;
#pragma unroll
    for (int i = 0; i < 16; ++i) s[i] = 0.f;
#pragma unroll
    for (int kk = 0; kk < 4; ++kk) {
        const bf16x8 kf = *(const bf16x8*)(kbuf + (32 * t2 + c) * KROW + (16 * kk + 8 * h) * 2);
        s = __builtin_amdgcn_mfma_f32_32x32x16_bf16(kf, qf[kk], s, 0, 0, 0);
    }
    return s;
}

__device__ __forceinline__ void pv_subtile(const char* vbuf, int t2, const float (&pr)[16], f32x16 (&o)[2], int c, int h) {
#pragma unroll
    for (int s = 0; s < 2; ++s) {
        u32x4 pbu;
#pragma unroll
        for (int j = 0; j < 4; ++j) pbu[j] = pack2(pr[8 * s + 2 * j], pr[8 * s + 2 * j + 1]);
        const bf16x8 pbv = __builtin_bit_cast(bf16x8, pbu);
#pragma unroll
        for (int dt = 0; dt < 2; ++dt) {
            const char* a = vbuf + (32 * dt + c) * VROW + (32 * t2 + 16 * s + 4 * h) * 2;
            const uint2 lo = *(const uint2*)a, hi = *(const uint2*)(a + 16);
            const u32x4 vfu = {lo.x, lo.y, hi.x, hi.y};
            o[dt] = __builtin_amdgcn_mfma_f32_32x32x16_bf16(__builtin_bit_cast(bf16x8, vfu), pbv, o[dt], 0, 0, 0);
        }
    }
}

__device__ __forceinline__ void store_o(bf16_t* orow  , const f32x16 (&o)[2], int h, float scale) {
#pragma unroll
    for (int dt = 0; dt < 2; ++dt)
#pragma unroll
        for (int g = 0; g < 4; ++g) {
            const int d = 32 * dt + 8 * g + 4 * h;
            *(uint2*)(orow + d) = make_uint2(pack2(o[dt][4 * g] * scale, o[dt][4 * g + 1] * scale), pack2(o[dt][4 * g + 2] * scale, o[dt][4 * g + 3] * scale));
        }
}

#define SB_STOP 32.0f
__device__ __forceinline__ void phase_sb(const P& p, char* lds) {
    const int tid = otid(), lane = tid & 63, w = tid >> 6, c = lane & 31, h = lane >> 5;
#pragma unroll 1
    for (int t = blockIdx.x; t < 8 * 64; t += gridDim.x) {
        const int head = t & 7, qb = 63 - (t >> 3);
        const int q0 = qb * 256, qw = q0 + 32 * w, query = qw + c;
        const bf16_t* kbase = p.k16 + (size_t)head * T_ * 64;
        const bf16_t* vtbase = p.vT16 + (size_t)head * 64 * T_;
        bf16x8 qf[4];
        load_qfrag(qf, p.q16 + ((size_t)head * T_ + query) * 64, h);
        f32x16 o[2];
#pragma unroll
        for (int i = 0; i < 16; ++i) { o[0][i] = 0.f; o[1][i] = 0.f; }
        float R = 0.f;
        int kt = (q0 + 255) >> 6;
        TileRegs tr;
        tile_gload(tr, kbase, vtbase, kt * 64);
        __syncthreads();
        tile_swrite(tr, lds);
        __syncthreads();
        int buf = 0;
#pragma unroll 1
        for (;;) {
            const bool more = kt > 0;
            if (more) tile_gload(tr, kbase, vtbase, (kt - 1) * 64);
            const char* kb = lds + buf * ABUF_B;
            const char* vb = kb + KTILE_B;
            const int k0 = kt * 64;
#pragma unroll
            for (int t2 = 1; t2 >= 0; --t2) {
                const int keybase = k0 + 32 * t2;
                if (keybase < qw + 31) {
                    const f32x16 s = qk_subtile(kb, t2, qf, c, h);
                    const bool need_mask = keybase + 31 >= qw;
                    float L[16], E[16];
#pragma unroll
                    for (int r = 0; r < 16; ++r) {
                        const float z2 = s[r] * LOG2E;
                        const int zb = __float_as_int(z2);
                        float l = __int_as_float(zb > 0 ? zb : 0) + flog2(1.0f + fexp2(-fabsf(z2)));
                        const int key = keybase + (r & 3) + 8 * (r >> 2) + 4 * h;
                        const bool valid = !need_mask || key < query;
                        l = valid ? l : 0.f;
                        L[r] = l;
                        E[r] = valid ? (z2 - l) : -1.0e30f;
                    }
                    float gs[4], tot[4], ps[4];
#pragma unroll
                    for (int g = 0; g < 4; ++g) {
                        gs[g] = (L[4 * g] + L[4 * g + 1]) + (L[4 * g + 2] + L[4 * g + 3]);
                        ps[g] = __shfl_xor(gs[g], 32);
                        tot[g] = gs[g] + ps[g];
                    }
                    float above[4];
                    above[3] = (h == 0 ? ps[3] : 0.f);
                    above[2] = tot[3] + (h == 0 ? ps[2] : 0.f);
                    above[1] = tot[3] + tot[2] + (h == 0 ? ps[1] : 0.f);
                    above[0] = tot[3] + tot[2] + tot[1] + (h == 0 ? ps[0] : 0.f);
                    float pr[16];
#pragma unroll
                    for (int g = 0; g < 4; ++g) {
                        float run = R + above[g];
#pragma unroll
                        for (int i = 3; i >= 0; --i) {
                            pr[4 * g + i] = fexp2(E[4 * g + i] - run);
                            run += L[4 * g + i];
                        }
                    }
                    R += (tot[0] + tot[1]) + (tot[2] + tot[3]);
                    pv_subtile(vb, t2, pr, o, c, h);
                }
            }
            const int done = __syncthreads_and(R > SB_STOP);
            if (!more || done) break;
            tile_swrite(tr, lds + (buf ^ 1) * ABUF_B);
            __syncthreads();
            buf ^= 1;
            --kt;
        }
        store_o(p.o + (size_t)query * DM + head * 64, o, h, 1.0f);
    }
}

__device__ __forceinline__ void softmax_subtile(const f32x16& s, unsigned W, float M2, float& l, f32x16 (&o)[2], const char* vb, int t2, int c, int h) {
    const unsigned Wh = W >> (4 * h);
    float pr[16];
    float ls = 0.f;
#pragma unroll
    for (int r = 0; r < 16; ++r) {
        const bool ok = (Wh >> ((r & 3) + 8 * (r >> 2))) & 1u;
        const float pv = ok ? fexp2(s[r] * LOG2E - M2) : 0.f;
        pr[r] = pv;
        ls += pv;
    }
    l += ls;
    pv_subtile(vb, t2, pr, o, c, h);
}

__device__ __forceinline__ unsigned causal_word(int query, int keybase) {
    const int nk = query - keybase + 1;
    return nk >= 32 ? 0xffffffffu : (nk <= 0 ? 0u : ((1u << nk) - 1u));
}
__device__ __forceinline__ float shift_bound_l2(float qn2, unsigned kmax2_bits) {
    return fminf(sqrtf(qn2 * __uint_as_float(kmax2_bits)) * 1.002f, 64.0f);
}
__device__ __forceinline__ float shift_bound(float qn2, unsigned kmax2_bits) {
    const float b = sqrtf(qn2 * __uint_as_float(kmax2_bits)) * (LOG2E * 1.002f);
    return fminf(b, 64.0f);
}

__device__ __forceinline__ void attn_tile64(const char* kb, const char* vb, const bf16x8 (&qf)[4], unsigned W0, unsigned W1, float M2, float& l, f32x16 (&o)[2], int c, int h) {
    bf16x8 k0[4], k1[4];
#pragma unroll
    for (int kk = 0; kk < 4; ++kk) {
        k0[kk] = *(const bf16x8*)(kb + c * KROW + (16 * kk + 8 * h) * 2);
        k1[kk] = *(const bf16x8*)(kb + (32 + c) * KROW + (16 * kk + 8 * h) * 2);
    }
    const unsigned Wh0 = W0 >> (4 * h), Wh1 = W1 >> (4 * h);
    f32x16 s0, s1;
#pragma unroll
    for (int r = 0; r < 16; ++r) {
        const int bit = (r & 3) + 8 * (r >> 2);
        s0[r] = ((Wh0 >> bit) & 1u) ? -M2 : -1.0e30f;
        s1[r] = ((Wh1 >> bit) & 1u) ? -M2 : -1.0e30f;
    }
#pragma unroll
    for (int kk = 0; kk < 4; ++kk) {
        s0 = __builtin_amdgcn_mfma_f32_32x32x16_bf16(k0[kk], qf[kk], s0, 0, 0, 0);
        s1 = __builtin_amdgcn_mfma_f32_32x32x16_bf16(k1[kk], qf[kk], s1, 0, 0, 0);
    }
    u32x4 vf[2][2][2];
#pragma unroll
    for (int t2 = 0; t2 < 2; ++t2)
#pragma unroll
        for (int sI = 0; sI < 2; ++sI)
#pragma unroll
            for (int dt = 0; dt < 2; ++dt) {
                const char* a = vb + (32 * dt + c) * VROW + (32 * t2 + 16 * sI + 4 * h) * 2;
                const uint2 lo = *(const uint2*)a, hi = *(const uint2*)(a + 16);
                vf[t2][sI][dt] = (u32x4){lo.x, lo.y, hi.x, hi.y};
            }
    u32x4 pb[2][2];
    f32v2_ ls2 = {0.f, 0.f};
#pragma unroll
    for (int sI = 0; sI < 2; ++sI) {
        f32v2_ pa[4], pc[4];
#pragma unroll
        for (int j = 0; j < 4; ++j) {
            const int r = 8 * sI + 2 * j;
            pa[j][0] = fexp2(s0[r]); pa[j][1] = fexp2(s0[r + 1]);
            pc[j][0] = fexp2(s1[r]); pc[j][1] = fexp2(s1[r + 1]);
            ls2 = ls2 + pa[j] + pc[j];
        }
        pb[0][sI] = (u32x4){pack2(pa[0][0], pa[0][1]), pack2(pa[1][0], pa[1][1]), pack2(pa[2][0], pa[2][1]), pack2(pa[3][0], pa[3][1])};
        pb[1][sI] = (u32x4){pack2(pc[0][0], pc[0][1]), pack2(pc[1][0], pc[1][1]), pack2(pc[2][0], pc[2][1]), pack2(pc[3][0], pc[3][1])};
    }
    l += ls2[0] + ls2[1];
#pragma unroll
    for (int t2 = 0; t2 < 2; ++t2)
#pragma unroll
        for (int sI = 0; sI < 2; ++sI)
#pragma unroll
            for (int dt = 0; dt < 2; ++dt)
                o[dt] = __builtin_amdgcn_mfma_f32_32x32x16_bf16(__builtin_bit_cast(bf16x8, vf[t2][sI][dt]), __builtin_bit_cast(bf16x8, pb[t2][sI]), o[dt], 0, 0, 0);
}

__device__ __forceinline__ void phase_moba_gate(const P& p, char* lds) {
    const int tid = otid(), lane = tid & 63, w = tid >> 6, c = lane & 31, h = lane >> 5;
#pragma unroll 1
    for (int t = blockIdx.x; t < 8 * 63; t += gridDim.x) {
        const int head = t & 7, cur = 63 - (t >> 3);
        const int query = cur * 256 + 32 * w + c;
        bf16x8 qf[4];
        load_qfrag(qf, p.q16 + ((size_t)(8 + head) * T_ + query) * 64, h);
        int sel0 = -1, sel1 = -1, sel2 = -1;
        __syncthreads();
        if (tid < 64) ((int*)(lds + 16384))[tid] = 0;
        {
            const int row = tid >> 3, cc = tid & 7;
            const float* ks = p.ksum + ((size_t)head * 64 + row) * 64 + cc * 8;
            const f32x4 a = *(const f32x4*)ks * (1.0f / 256.0f), b = *(const f32x4*)(ks + 4) * (1.0f / 256.0f);
            *(u32x4*)(lds + row * KROW + cc * 16) = (u32x4){pack2(a[0], a[1]), pack2(a[2], a[3]), pack2(b[0], b[1]), pack2(b[2], b[3])};
        }
        __syncthreads();
        float v0 = -3.0e38f, v1 = -3.0e38f, v2 = -3.0e38f;
#pragma unroll
        for (int t2 = 0; t2 < 2; ++t2) {
            const f32x16 s = qk_subtile(lds, t2, qf, c, h);
#pragma unroll
            for (int r = 0; r < 16; ++r) {
                const int n = 32 * t2 + (r & 3) + 8 * (r >> 2) + 4 * h;
                const float g = s[r];
                if (n < cur) {
                    if (g > v0) { v2 = v1; sel2 = sel1; v1 = v0; sel1 = sel0; v0 = g; sel0 = n; }
                    else if (g > v1) { v2 = v1; sel2 = sel1; v1 = g; sel1 = n; }
                    else if (g > v2) { v2 = g; sel2 = n; }
                }
            }
        }
        const float pv0 = __shfl_xor(v0, 32), pv1 = __shfl_xor(v1, 32), pv2 = __shfl_xor(v2, 32);
        const int pn0 = __shfl_xor(sel0, 32), pn1 = __shfl_xor(sel1, 32), pn2 = __shfl_xor(sel2, 32);
#pragma unroll
        for (int k = 0; k < 3; ++k) {
            const float g = k == 0 ? pv0 : (k == 1 ? pv1 : pv2);
            const int n = k == 0 ? pn0 : (k == 1 ? pn1 : pn2);
            if (n >= 0) {
                if (g > v0 || (g == v0 && n < sel0)) { v2 = v1; sel2 = sel1; v1 = v0; sel1 = sel0; v0 = g; sel0 = n; }
                else if (g > v1 || (g == v1 && n < sel1)) { v2 = v1; sel2 = sel1; v1 = g; sel1 = n; }
                else if (g > v2 || (g == v2 && n < sel2)) { v2 = g; sel2 = n; }
            }
        }
        int* lc = (int*)(lds + 16384);
        int* gb = lc + 64;
        int lp0 = 0, lp1 = 0, lp2 = 0;
        if (h == 0) {
            if (sel0 >= 0) lp0 = atomicAdd(lc + sel0, 1);
            if (sel1 >= 0) lp1 = atomicAdd(lc + sel1, 1);
            if (sel2 >= 0) lp2 = atomicAdd(lc + sel2, 1);
        }
        __syncthreads();
        if (tid < 64) gb[tid] = lc[tid] > 0 ? atomicAdd(p.mb_cnt + head * 64 + tid, lc[tid]) : 0;
        __syncthreads();
        if (h == 0) {
            if (sel0 >= 0) p.mb_list[((size_t)head * 64 + sel0) * T_ + gb[sel0] + lp0] = (query << 2) | 0;
            if (sel1 >= 0) p.mb_list[((size_t)head * 64 + sel1) * T_ + gb[sel1] + lp1] = (query << 2) | 1;
            if (sel2 >= 0) p.mb_list[((size_t)head * 64 + sel2) * T_ + gb[sel2] + lp2] = (query << 2) | 2;
        }
    }
}

#define MB_PRE_OFF (2 * ABUF_B)
__device__ __forceinline__ void phase_moba_sparse(const P& p, char* lds) {
    const int tid = otid(), lane = tid & 63, w = tid >> 6, c = lane & 31, h = lane >> 5;
    int* pre = (int*)(lds + MB_PRE_OFF);
    __syncthreads();
    if (tid < 64) {
        int loc[8]; int s = 0;
#pragma unroll
        for (int i = 0; i < 8; ++i) { loc[i] = (p.mb_cnt[tid * 8 + i] + 255) >> 8; s += loc[i]; }
        int incl = s;
#pragma unroll
        for (int o = 1; o < 64; o <<= 1) { const int v = __shfl_up(incl, o); if (tid >= o) incl += v; }
        int run = incl - s;
#pragma unroll
        for (int i = 0; i < 8; ++i) { pre[tid * 8 + i] = run; run += loc[i]; }
        if (tid == 63) pre[512] = run;
    }
    __syncthreads();
    const int total = pre[512];
#pragma unroll 1
    for (int u = blockIdx.x; u < total; u += gridDim.x) {
        int lo = 0, hi = 512;
#pragma unroll 1
        while (hi - lo > 1) { const int mid = (lo + hi) >> 1; if (pre[mid] <= u) lo = mid; else hi = mid; }
        const int li = lo, chunk = u - pre[li], head = li >> 6, n = li & 63;
        const int cnt = p.mb_cnt[li], idx = chunk * 256 + 32 * w + c;
        const bool valid = idx < cnt;
        const int ent = p.mb_list[(size_t)li * T_ + (valid ? idx : 0)];
        const int query = ent >> 2, slot = ent & 3;
        const bf16_t* kbase = p.k16 + (size_t)(8 + head) * T_ * 64;
        const bf16_t* vtbase = p.vT16 + (size_t)(8 + head) * 64 * T_;
        bf16x8 qf[4];
        load_qfrag(qf, p.q16 + ((size_t)(8 + head) * T_ + query) * 64, h);
        const float M2 = shift_bound_l2(qnorm2(qf), p.kmax2[8 + head]);
        f32x16 o[2];
#pragma unroll
        for (int i = 0; i < 16; ++i) { o[0][i] = 0.f; o[1][i] = 0.f; }
        float l = 0.f;
        TileRegs tr;
        tile_gload(tr, kbase, vtbase, n * 256);
        __syncthreads();
        tile_swrite(tr, lds);
        __syncthreads();
#pragma unroll 1
        for (int kt = 0; kt < 4; ++kt) {
            if (kt < 3) tile_gload(tr, kbase, vtbase, n * 256 + (kt + 1) * 64);
            const char* kb = lds + (kt & 1) * ABUF_B;
            attn_tile64(kb, kb + KTILE_B, qf, 0xffffffffu, 0xffffffffu, M2, l, o, c, h);
            if (kt < 3) {
                tile_swrite(tr, lds + ((kt + 1) & 1) * ABUF_B);
                __syncthreads();
            }
        }
        l += __shfl_xor(l, 32);
        if (valid) {
            float* po = p.mb_part + (((size_t)head * T_ + query) * 3 + slot) * 64;
#pragma unroll
            for (int dt = 0; dt < 2; ++dt)
#pragma unroll
                for (int g = 0; g < 4; ++g) *(f32x4*)(po + 32 * dt + 8 * g + 4 * h) = (f32x4){o[dt][4 * g], o[dt][4 * g + 1], o[dt][4 * g + 2], o[dt][4 * g + 3]};
            if (h == 0) p.mb_l[((size_t)head * T_ + query) * 3 + slot] = l;
        }
    }
}

__device__ __forceinline__ void phase_moba_own(const P& p, char* lds) {
    const int tid = otid(), lane = tid & 63, w = tid >> 6, c = lane & 31, h = lane >> 5;
#pragma unroll 1
    for (int t = blockIdx.x; t < 8 * 64; t += gridDim.x) {
        const int head = t & 7, cur = t >> 3;
        const int q0 = cur * 256, qw = q0 + 32 * w, query = qw + c;
        const bf16_t* kbase = p.k16 + (size_t)(8 + head) * T_ * 64;
        const bf16_t* vtbase = p.vT16 + (size_t)(8 + head) * 64 * T_;
        bf16x8 qf[4];
        load_qfrag(qf, p.q16 + ((size_t)(8 + head) * T_ + query) * 64, h);
        const float M2 = shift_bound_l2(qnorm2(qf), p.kmax2[8 + head]);
        f32x16 o[2];
#pragma unroll
        for (int i = 0; i < 16; ++i) { o[0][i] = 0.f; o[1][i] = 0.f; }
        float l = 0.f;
        TileRegs tr;
        tile_gload(tr, kbase, vtbase, q0);
        __syncthreads();
        tile_swrite(tr, lds);
        __syncthreads();
#pragma unroll 1
        for (int kt = 0; kt < 4; ++kt) {
            if (kt < 3) tile_gload(tr, kbase, vtbase, q0 + (kt + 1) * 64);
            const char* kb = lds + (kt & 1) * ABUF_B;
            const int keybase = q0 + kt * 64;
            const unsigned W0 = causal_word(query, keybase), W1 = causal_word(query, keybase + 32);
            if (__ballot((W0 | W1) != 0u) != 0ull) attn_tile64(kb, kb + KTILE_B, qf, W0, W1, M2, l, o, c, h);
            if (kt < 3) {
                tile_swrite(tr, lds + ((kt + 1) & 1) * ABUF_B);
                __syncthreads();
            }
        }
        l += __shfl_xor(l, 32);
        const int nsel = cur < 3 ? cur : 3;
#pragma unroll 1
        for (int sI = 0; sI < nsel; ++sI) {
            const float* po = p.mb_part + (((size_t)head * T_ + query) * 3 + sI) * 64;
#pragma unroll
            for (int dt = 0; dt < 2; ++dt)
#pragma unroll
                for (int g = 0; g < 4; ++g) {
                    const f32x4 v = *(const f32x4*)(po + 32 * dt + 8 * g + 4 * h);
                    o[dt][4 * g] += v[0]; o[dt][4 * g + 1] += v[1]; o[dt][4 * g + 2] += v[2]; o[dt][4 * g + 3] += v[3];
                }
            l += p.mb_l[((size_t)head * T_ + query) * 3 + sI];
        }
        store_o(p.o + (size_t)query * DM + 512 + head * 64, o, h, 1.0f / l);
    }
}

__device__ __forceinline__ void attn_tile64_2h(const char* kbA, const char* vbA, const char* kbB, const char* vbB,
                                               const bf16x8 (&qA)[4], const bf16x8 (&qB)[4], unsigned W0, unsigned W1, float MA, float MB,
                                               float& lA, float& lB, f32x16 (&oA)[2], f32x16 (&oB)[2], int c, int h) {
    u32x4 pA[2][2], pB[2][2];
    float lsA = 0.f, lsB = 0.f;
#pragma unroll
    for (int t2 = 0; t2 < 2; ++t2) {
        const unsigned Wh = (t2 ? W1 : W0) >> (4 * h);
        bool ok[16];
#pragma unroll
        for (int r = 0; r < 16; ++r) ok[r] = (Wh >> ((r & 3) + 8 * (r >> 2))) & 1u;
#pragma unroll
        for (int hd = 0; hd < 2; ++hd) {
            const char* kb = hd ? kbB : kbA;
            bf16x8 kf[4];
#pragma unroll
            for (int kk = 0; kk < 4; ++kk) kf[kk] = *(const bf16x8*)(kb + (32 * t2 + c) * KROW + (16 * kk + 8 * h) * 2);
            const float Mx = hd ? MB : MA;
            f32x16 sv;
#pragma unroll
            for (int i = 0; i < 16; ++i) sv[i] = ok[i] ? -Mx : -1.0e30f;
#pragma unroll
            for (int kk = 0; kk < 4; ++kk) sv = __builtin_amdgcn_mfma_f32_32x32x16_bf16(kf[kk], hd ? qB[kk] : qA[kk], sv, 0, 0, 0);
            f32v2_ ls2 = {0.f, 0.f};
#pragma unroll
            for (int sI = 0; sI < 2; ++sI) {
                f32v2_ a2[4];
#pragma unroll
                for (int j = 0; j < 4; ++j) {
                    a2[j][0] = fexp2(sv[8 * sI + 2 * j]);
                    a2[j][1] = fexp2(sv[8 * sI + 2 * j + 1]);
                    ls2 = ls2 + a2[j];
                }
                const u32x4 pk = (u32x4){pack2(a2[0][0], a2[0][1]), pack2(a2[1][0], a2[1][1]), pack2(a2[2][0], a2[2][1]), pack2(a2[3][0], a2[3][1])};
                if (hd) pB[t2][sI] = pk; else pA[t2][sI] = pk;
            }
            if (hd) lsB += ls2[0] + ls2[1]; else lsA += ls2[0] + ls2[1];
        }
    }
    lA += lsA;
    lB += lsB;
#pragma unroll
    for (int hd = 0; hd < 2; ++hd) {
        const char* vb = hd ? vbB : vbA;
#pragma unroll
        for (int t2 = 0; t2 < 2; ++t2) {
            u32x4 vf[2][2];
#pragma unroll
            for (int sI = 0; sI < 2; ++sI)
#pragma unroll
                for (int dt = 0; dt < 2; ++dt) {
                    const char* a = vb + (32 * dt + c) * VROW + (32 * t2 + 16 * sI + 4 * h) * 2;
                    const uint2 lo = *(const uint2*)a, hi = *(const uint2*)(a + 16);
                    vf[sI][dt] = (u32x4){lo.x, lo.y, hi.x, hi.y};
                }
#pragma unroll
            for (int sI = 0; sI < 2; ++sI)
#pragma unroll
                for (int dt = 0; dt < 2; ++dt) {
                    if (hd == 0) oA[dt] = __builtin_amdgcn_mfma_f32_32x32x16_bf16(__builtin_bit_cast(bf16x8, vf[sI][dt]), __builtin_bit_cast(bf16x8, pA[t2][sI]), oA[dt], 0, 0, 0);
                    else oB[dt] = __builtin_amdgcn_mfma_f32_32x32x16_bf16(__builtin_bit_cast(bf16x8, vf[sI][dt]), __builtin_bit_cast(bf16x8, pB[t2][sI]), oB[dt], 0, 0, 0);
                }
        }
    }
}

__device__ __forceinline__ void phase_dsa(const P& p, char* lds) {
    const int tid = otid(), lane = tid & 63, w = tid >> 6, c = lane & 31, h = lane >> 5;
    const int G = gridDim.x;
#pragma unroll 1
    for (int r = 0; r * G < 8 * 64; ++r) {
        const int t = zz_unit(r, blockIdx.x, G);
        if (t >= 8 * 64) continue;
        const int hA = (t & 7) * 2, hB = hA + 1, qb = 63 - (t >> 3);
        const int q0 = qb * 256, qw = q0 + 32 * w, query = qw + c;
        const bf16_t* kbaseA = p.k16 + (size_t)hA * T_ * 64;
        const bf16_t* vtbaseA = p.vT16 + (size_t)hA * 64 * T_;
        const bf16_t* kbaseB = p.k16 + (size_t)hB * T_ * 64;
        const bf16_t* vtbaseB = p.vT16 + (size_t)hB * 64 * T_;
        bf16x8 qA[4], qB[4];
        load_qfrag(qA, p.q16 + ((size_t)hA * T_ + query) * 64, h);
        load_qfrag(qB, p.q16 + ((size_t)hB * T_ + query) * 64, h);
        const float MA = shift_bound_l2(qnorm2(qA), p.kmax2[16 + hA]), MB = shift_bound_l2(qnorm2(qB), p.kmax2[16 + hB]);
        f32x16 oA[2], oB[2];
#pragma unroll
        for (int i = 0; i < 16; ++i) { oA[0][i] = 0.f; oA[1][i] = 0.f; oB[0][i] = 0.f; oB[1][i] = 0.f; }
        float lA = 0.f, lB = 0.f;
        const int ktend = (q0 + 255) >> 6;
        TileRegs trA, trB;
        const unsigned* bmq = p.bm + query;
        unsigned W0 = bmq[0], W1 = bmq[(size_t)T_];
        tile_gload(trA, kbaseA, vtbaseA, 0);
        tile_gload(trB, kbaseB, vtbaseB, 0);
        __syncthreads();
        tile_swrite(trA, lds);
        tile_swrite(trB, lds + ABUF_B);
        __syncthreads();
        int buf = 0;
#pragma unroll 1
        for (int kt = 0; kt <= ktend; ++kt) {
            const bool more = kt < ktend;
            const int ktn = more ? kt + 1 : kt;
            const unsigned Wn0 = bmq[(size_t)(2 * ktn) * T_], Wn1 = bmq[(size_t)(2 * ktn + 1) * T_];
            tile_gload(trA, kbaseA, vtbaseA, ktn * 64);
            tile_gload(trB, kbaseB, vtbaseB, ktn * 64);
            const char* kb = lds + buf * (2 * ABUF_B);
            attn_tile64_2h(kb, kb + KTILE_B, kb + ABUF_B, kb + ABUF_B + KTILE_B, qA, qB, W0, W1, MA, MB, lA, lB, oA, oB, c, h);
            if (!more) break;
            tile_swrite(trA, lds + (buf ^ 1) * (2 * ABUF_B));
            tile_swrite(trB, lds + (buf ^ 1) * (2 * ABUF_B) + ABUF_B);
            __syncthreads();
            buf ^= 1;
            W0 = Wn0; W1 = Wn1;
        }
        lA += __shfl_xor(lA, 32);
        lB += __shfl_xor(lB, 32);
        store_o(p.o + (size_t)query * DM + hA * 64, oA, h, 1.0f / lA);
        store_o(p.o + (size_t)query * DM + hB * 64, oB, h, 1.0f / lB);
    }
}
#ifndef FORCE_SLOW
#define FORCE_SLOW 0
#endif
#define IDX_ROWS 32
#define IDX_HIST_B (IDX_ROWS * 4096)
#define IDX_INFO_OFF IDX_HIST_B
#define IDX_CAND_OFF (IDX_HIST_B + 1024)
#define IDX_CAP 16
#define IDX_LDS_B (IDX_CAND_OFF + IDX_ROWS * IDX_CAP * 8)
#define IDX_FCAP 256

__device__ __forceinline__ unsigned fkey(float s) {
    const unsigned u = __float_as_uint(s + 0.0f);
    return (u & 0x80000000u) ? ~u : (u | 0x80000000u);
}
__device__ __forceinline__ unsigned sbin(float s) {
    const unsigned u = __float_as_uint(s + 0.0f);
    int t = (int)((u & 0x7fffffffu) >> 17) - (115 << 6);
    t = t < 0 ? 0 : (t > 1023 ? 1023 : t);
    return (u >> 31) ? (unsigned)(1023 - t) : (unsigned)(1024 + t);
}

__device__ __forceinline__ void find_bin(const unsigned* hrow, int need, int lane, int& bin_out, int& above_out) {
    unsigned wv[16];
    const int wbase = 1008 - 16 * lane;
#pragma unroll
    for (int i = 0; i < 4; ++i) {
        const u32x4 q = *(const u32x4*)(hrow + wbase + 4 * i);
        wv[4 * i] = q[0]; wv[4 * i + 1] = q[1]; wv[4 * i + 2] = q[2]; wv[4 * i + 3] = q[3];
    }
    int tot = 0;
#pragma unroll
    for (int i = 0; i < 16; ++i) tot += (int)(wv[i] >> 16) + (int)(wv[i] & 0xffffu);
    int incl = tot;
#pragma unroll
    for (int o = 1; o < 64; o <<= 1) {
        const int v = __shfl_up(incl, o);
        if (lane >= o) incl += v;
    }
    const unsigned long long bal = __ballot(incl >= need);
    const int fl = __ffsll(bal) - 1;
    int b = 0, ab = 0;
    if (lane == fl) {
        int cum = incl - tot;
        bool found = false;
#pragma unroll
        for (int i = 15; i >= 0; --i) {
            const int hi = (int)(wv[i] >> 16), lo = (int)(wv[i] & 0xffffu);
            if (!found) { if (cum + hi >= need) { found = true; b = 2 * (wbase + i) + 1; ab = cum; } else cum += hi; }
            if (!found) { if (cum + lo >= need) { found = true; b = 2 * (wbase + i); ab = cum; } else cum += lo; }
        }
    }
    bin_out = __shfl(b, fl < 0 ? 0 : fl);
    above_out = __shfl(ab, fl < 0 ? 0 : fl);
}

struct IdxCtx {
    bf16x8 af[4];
    float wq[2][8];
    int qabs[2], qloc[2];
};

__device__ __forceinline__ void idx_setup(const P& p, IdxCtx& x, int q0, int w, int c, int h) {
    const int u = ((c >> 4) & 1) + 2 * ((c >> 2) & 1), hd = (c & 3) + 4 * ((c >> 3) & 1);
    const bf16_t* qp = p.qi + ((size_t)(q0 + 4 * w + u) * 8 + hd) * 64;
#pragma unroll
    for (int kk = 0; kk < 4; ++kk) x.af[kk] = *(const bf16x8*)(qp + 16 * kk + 8 * h);
#pragma unroll
    for (int uu = 0; uu < 2; ++uu) {
        x.qloc[uu] = 4 * w + 2 * h + uu;
        x.qabs[uu] = q0 + x.qloc[uu];
        const f32x4 a = *(const f32x4*)(p.wi + (size_t)x.qabs[uu] * 8), b = *(const f32x4*)(p.wi + (size_t)x.qabs[uu] * 8 + 4);
        x.wq[uu][0] = a[0]; x.wq[uu][1] = a[1]; x.wq[uu][2] = a[2]; x.wq[uu][3] = a[3];
        x.wq[uu][4] = b[0]; x.wq[uu][5] = b[1]; x.wq[uu][6] = b[2]; x.wq[uu][7] = b[3];
    }
}
__device__ __forceinline__ void idx_load(const P& p, bf16x8 (&bk)[4], int kt, int c, int h) {
    const bf16_t* kp = p.ki + (size_t)(32 * kt + c) * 64 + 8 * h;
#pragma unroll
    for (int kk = 0; kk < 4; ++kk) bk[kk] = *(const bf16x8*)(kp + 16 * kk);
}
__device__ __forceinline__ void idx_scores(const IdxCtx& x, const bf16x8 (&bk)[4], float& s0, float& s1) {
    f32x16 s;
#pragma unroll
    for (int i = 0; i < 16; ++i) s[i] = 0.f;
#pragma unroll
    for (int kk = 0; kk < 4; ++kk) s = __builtin_amdgcn_mfma_f32_32x32x16_bf16(x.af[kk], bk[kk], s, 0, 0, 0);
    float r[16];
#pragma unroll
    for (int i = 0; i < 16; ++i) r[i] = fmaxf(s[i], 0.f);
    const float e0 = __builtin_fmaf(x.wq[0][6], r[6], __builtin_fmaf(x.wq[0][4], r[4], __builtin_fmaf(x.wq[0][2], r[2], x.wq[0][0] * r[0])));
    const float o0 = __builtin_fmaf(x.wq[0][7], r[7], __builtin_fmaf(x.wq[0][5], r[5], __builtin_fmaf(x.wq[0][3], r[3], x.wq[0][1] * r[1])));
    const float e1 = __builtin_fmaf(x.wq[1][6], r[14], __builtin_fmaf(x.wq[1][4], r[12], __builtin_fmaf(x.wq[1][2], r[10], x.wq[1][0] * r[8])));
    const float o1 = __builtin_fmaf(x.wq[1][7], r[15], __builtin_fmaf(x.wq[1][5], r[13], __builtin_fmaf(x.wq[1][3], r[11], x.wq[1][1] * r[9])));
    s0 = e0 + o0;
    s1 = e1 + o1;
}

__device__ __forceinline__ float relu1(float v) { const int b = __float_as_int(v); return __int_as_float(b > 0 ? b : 0); }
__device__ __forceinline__ void idx_scores2(const IdxCtx& x, const bf16x8 (&bk0)[4], const bf16x8 (&bk1)[4], float& a0, float& a1, float& b0, float& b1) {
    f32x16 s, t;
#pragma unroll
    for (int i = 0; i < 16; ++i) { s[i] = 0.f; t[i] = 0.f; }
#pragma unroll
    for (int kk = 0; kk < 4; ++kk) {
        s = __builtin_amdgcn_mfma_f32_32x32x16_bf16(x.af[kk], bk0[kk], s, 0, 0, 0);
        t = __builtin_amdgcn_mfma_f32_32x32x16_bf16(x.af[kk], bk1[kk], t, 0, 0, 0);
    }
    float r[16], q[16];
#pragma unroll
    for (int i = 0; i < 16; ++i) { r[i] = relu1(s[i]); q[i] = relu1(t[i]); }
    {
        const float e0 = __builtin_fmaf(x.wq[0][6], r[6], __builtin_fmaf(x.wq[0][4], r[4], __builtin_fmaf(x.wq[0][2], r[2], x.wq[0][0] * r[0])));
        const float o0 = __builtin_fmaf(x.wq[0][7], r[7], __builtin_fmaf(x.wq[0][5], r[5], __builtin_fmaf(x.wq[0][3], r[3], x.wq[0][1] * r[1])));
        const float e1 = __builtin_fmaf(x.wq[1][6], r[14], __builtin_fmaf(x.wq[1][4], r[12], __builtin_fmaf(x.wq[1][2], r[10], x.wq[1][0] * r[8])));
        const float o1 = __builtin_fmaf(x.wq[1][7], r[15], __builtin_fmaf(x.wq[1][5], r[13], __builtin_fmaf(x.wq[1][3], r[11], x.wq[1][1] * r[9])));
        a0 = e0 + o0; a1 = e1 + o1;
    }
    {
        const float e0 = __builtin_fmaf(x.wq[0][6], q[6], __builtin_fmaf(x.wq[0][4], q[4], __builtin_fmaf(x.wq[0][2], q[2], x.wq[0][0] * q[0])));
        const float o0 = __builtin_fmaf(x.wq[0][7], q[7], __builtin_fmaf(x.wq[0][5], q[5], __builtin_fmaf(x.wq[0][3], q[3], x.wq[0][1] * q[1])));
        const float e1 = __builtin_fmaf(x.wq[1][6], q[14], __builtin_fmaf(x.wq[1][4], q[12], __builtin_fmaf(x.wq[1][2], q[10], x.wq[1][0] * q[8])));
        const float o1 = __builtin_fmaf(x.wq[1][7], q[15], __builtin_fmaf(x.wq[1][5], q[13], __builtin_fmaf(x.wq[1][3], q[11], x.wq[1][1] * q[9])));
        b0 = e0 + o0; b1 = e1 + o1;
    }
}

#define IDX_RING_OFF IDX_LDS_B
#define IDX_RING_TILE_B (64 * 144)
#define IDX_STAGE_OFF (IDX_RING_OFF + 2 * IDX_RING_TILE_B)
#define IDX_TOTAL_LDS_B (IDX_STAGE_OFF + 2 * 4096)
struct NoHook { __device__ __forceinline__ void operator()(int) const {} };
template <class F, class H = NoHook>
__device__ __forceinline__ void idx_sweep(const P& p, const IdxCtx& x, int ntile, int c, int h, char* lds, F body, H hook = H()) {
    const int tid = otid(), row = tid >> 3, cc = tid & 7;
    char* ring = lds + IDX_RING_OFF;
    const int nt64 = (ntile + 1) >> 1;
    const bf16_t* src = p.ki + (size_t)row * 64 + cc * 8;
    u32x4 reg = *(const u32x4*)src;
    __syncthreads();
    *(u32x4*)(ring + row * 144 + cc * 16) = reg;
    __syncthreads();
#pragma unroll 1
    for (int t = 0; t < nt64; ++t) {
        const bool more = t + 1 < nt64;
        if (more) reg = *(const u32x4*)(src + (size_t)(t + 1) * 64 * 64);
        if (t > 0) hook(t - 1);
        const char* rb = ring + (t & 1) * IDX_RING_TILE_B;
        bf16x8 bk0[4], bk1[4];
#pragma unroll
        for (int kk = 0; kk < 4; ++kk) {
            bk0[kk] = *(const bf16x8*)(rb + c * 144 + 32 * kk + 16 * h);
            bk1[kk] = *(const bf16x8*)(rb + (32 + c) * 144 + 32 * kk + 16 * h);
        }
        __builtin_amdgcn_sched_barrier(0);
        float sa0, sa1, sb0, sb1;
        idx_scores2(x, bk0, bk1, sa0, sa1, sb0, sb1);
        body(2 * t, sa0, sa1);
        body(2 * t + 1, sb0, sb1);
        if (more) *(u32x4*)(ring + ((t + 1) & 1) * IDX_RING_TILE_B + row * 144 + cc * 16) = reg;
        __syncthreads();
    }
    hook(nt64 - 1);
}

__device__ __forceinline__ void idx_unit_slow(const P& p, const IdxCtx& x, char* lds, int q0, int ntile, int tid, int lane, int w, int c, int h) {
    unsigned* hist = (unsigned*)lds;
    int* info = (int*)(lds + IDX_INFO_OFF);
    uint2* cand = (uint2*)(lds + IDX_CAND_OFF);
    __syncthreads();
    if (tid < IDX_ROWS) {
        const int nk = q0 + tid + 1;
        info[tid] = nk < 256 ? nk : 256;
        info[5 * IDX_ROWS + tid] = 0;
    }
#pragma unroll 1
    for (int pass = 0; pass < 3; ++pass) {
        for (int i = tid; i < IDX_HIST_B / 16; i += NTHR) ((u32x4*)hist)[i] = (u32x4){0u, 0u, 0u, 0u};
        __syncthreads();
        int pb1[2], pb2[2];
#pragma unroll
        for (int uu = 0; uu < 2; ++uu) { pb1[uu] = info[IDX_ROWS + x.qloc[uu]]; pb2[uu] = info[3 * IDX_ROWS + x.qloc[uu]]; }
        idx_sweep(p, x, ntile, c, h, lds, [&](int kt, float s0, float s1) {
            const int key = 32 * kt + c;
#pragma unroll
            for (int uu = 0; uu < 2; ++uu) {
                const bool valid = key <= x.qabs[uu];
                const unsigned ku = fkey(uu == 0 ? s0 : s1);
                if (pass == 0) {
                    if (valid) { const unsigned bin = ku >> 21; atomicAdd(hist + x.qloc[uu] * 1024 + (bin >> 1), 1u << (16 * (bin & 1))); }
                } else if (pass == 1) {
                    if (valid && (int)(ku >> 21) == pb1[uu]) { const unsigned bin = (ku >> 10) & 2047u; atomicAdd(hist + x.qloc[uu] * 1024 + (bin >> 1), 1u << (16 * (bin & 1))); }
                } else {
                    const bool sa = x.qabs[uu] < 256;
                    const unsigned pfx = ku >> 10, P22 = ((unsigned)pb1[uu] << 11) | (unsigned)pb2[uu];
                    const bool gt = valid && (sa || pfx > P22);
                    const bool eq = valid && !sa && pfx == P22;
                    const unsigned long long bal = __ballot(gt);
                    if (c == 0) hist[kt * IDX_ROWS + x.qloc[uu]] = h ? (unsigned)(bal >> 32) : (unsigned)bal;
                    if (eq) {
                        const int ix = atomicAdd(info + 5 * IDX_ROWS + x.qloc[uu], 1);
                        if (ix < IDX_CAP) cand[x.qloc[uu] * IDX_CAP + ix] = make_uint2(ku, (unsigned)key);
                    }
                }
            }
        });
        __syncthreads();
        if (pass < 2) {
#pragma unroll 1
            for (int rr = 0; rr < 4; ++rr) {
                const int row = 4 * w + rr;
                const int need = pass == 0 ? info[row] : info[2 * IDX_ROWS + row];
                int b, ab;
                find_bin(hist + row * 1024, need, lane, b, ab);
                if (lane == 0) {
                    if (pass == 0) { info[IDX_ROWS + row] = b; info[2 * IDX_ROWS + row] = need - ab; }
                    else { info[3 * IDX_ROWS + row] = b; info[4 * IDX_ROWS + row] = need - ab; }
                }
            }
            __syncthreads();
        }
    }
    if (tid < IDX_ROWS) {
        const int row = tid, n = info[5 * IDX_ROWS + row] < IDX_CAP ? info[5 * IDX_ROWS + row] : IDX_CAP, need2 = info[4 * IDX_ROWS + row];
        for (int i = 0; i < n; ++i) {
            const uint2 ci = cand[row * IDX_CAP + i];
            int rank = 0;
            for (int j = 0; j < n; ++j) {
                const uint2 cj = cand[row * IDX_CAP + j];
                rank += (cj.x > ci.x || (cj.x == ci.x && cj.y < ci.y)) ? 1 : 0;
            }
            if (rank < need2) hist[(ci.y >> 5) * IDX_ROWS + row] |= 1u << (ci.y & 31u);
        }
    }
    __syncthreads();
}

__device__ __forceinline__ void phase_indexer(const P& p, char* lds) {
    const int tid = otid(), lane = tid & 63, w = tid >> 6, c = lane & 31, h = lane >> 5;
    unsigned* hist = (unsigned*)lds;
    int* info = (int*)(lds + IDX_INFO_OFF);
    uint2* fcand = (uint2*)(lds + 65536);
#pragma unroll 1
    for (int rnd = 0; rnd * (int)gridDim.x < T_ / IDX_ROWS; ++rnd) {
        const int t = zz_unit(rnd, blockIdx.x, gridDim.x);
        if (t >= T_ / IDX_ROWS) continue;
        const int qblk = (T_ / IDX_ROWS - 1) - t;
        const int q0 = qblk * IDX_ROWS;
        IdxCtx x;
        idx_setup(p, x, q0, w, c, h);
        const int ntile = (q0 + IDX_ROWS - 1) / 32 + 1;
        const bool selall_blk = (q0 + IDX_ROWS) <= 256;
        __syncthreads();
        if (tid < IDX_ROWS) {
            const int nk = q0 + tid + 1;
            info[tid] = nk < 256 ? nk : 256;
            info[IDX_ROWS + tid] = 0;
            info[2 * IDX_ROWS + tid] = 0;
            info[5 * IDX_ROWS + tid] = 0;
        }
        const int Lrow = ((ntile + 1) >> 1) * 64;
        unsigned short* bins = (unsigned short*)p.act + (size_t)32 * 64 * ((qblk & 1) ? ((qblk >> 1) + 1) * ((qblk >> 1) + 1) : (qblk >> 1) * ((qblk >> 1) + 1));
        if (!selall_blk) {
            for (int i = tid; i < IDX_HIST_B / 16; i += NTHR) ((u32x4*)hist)[i] = (u32x4){0u, 0u, 0u, 0u};
            __syncthreads();
            idx_sweep(p, x, ntile, c, h, lds, [&](int kt, float s0, float s1) {
                const int key = 32 * kt + c;
                const unsigned b0 = sbin(s0), b1_ = sbin(s1);
                const unsigned inc0 = key <= x.qabs[0] ? (1u << (16 * (b0 & 1))) : 0u, inc1 = key <= x.qabs[1] ? (1u << (16 * (b1_ & 1))) : 0u;
                atomicAdd(hist + x.qloc[0] * 1024 + (b0 >> 1), inc0);
                atomicAdd(hist + x.qloc[1] * 1024 + (b1_ >> 1), inc1);
                const unsigned p0 = b0 | ((unsigned)__builtin_amdgcn_update_dpp(0, (int)b0, 0x101, 0xF, 0xF, true) << 16);
                const unsigned p1 = b1_ | ((unsigned)__builtin_amdgcn_update_dpp(0, (int)b1_, 0x101, 0xF, 0xF, true) << 16);
                const unsigned p0h = (unsigned)__builtin_amdgcn_update_dpp(0, (int)p0, 0x102, 0xF, 0xF, true);
                const unsigned p1h = (unsigned)__builtin_amdgcn_update_dpp(0, (int)p1, 0x102, 0xF, 0xF, true);
                if ((c & 3) == 0) {
                    unsigned short* stg = (unsigned short*)(lds + IDX_STAGE_OFF + ((key >> 6) & 1) * 4096);
                    *(uint2*)(stg + x.qloc[0] * 64 + (key & 63)) = make_uint2(p0, p0h);
                    *(uint2*)(stg + x.qloc[1] * 64 + (key & 63)) = make_uint2(p1, p1h);
                }
            }, [&](int t64) {
                if (tid < 256) *(u32x4*)(bins + (size_t)t64 * 2048 + tid * 8) = *(const u32x4*)(lds + IDX_STAGE_OFF + (t64 & 1) * 4096 + tid * 16);
            });
            __syncthreads();
#pragma unroll 1
            for (int rr = 0; rr < 4; ++rr) {
                const int row = 4 * w + rr;
                int b, ab;
                find_bin(hist + row * 1024, info[row], lane, b, ab);
                if (lane == 0) { info[IDX_ROWS + row] = b; info[2 * IDX_ROWS + row] = info[row] - ab; }
            }
            __syncthreads();
        }
        for (int i = tid; i < 65536 / 16; i += NTHR) ((u32x4*)hist)[i] = (u32x4){0u, 0u, 0u, 0u};
        __syncthreads();
        {
            const int row = 4 * w + ((lane >> 3) & 3), kc = lane & 7, th = lane >> 5, qrow = q0 + row;
            const int tb = info[IDX_ROWS + row];
            const bool sa = selall_blk;
            const int nt64 = Lrow >> 6;
            const unsigned short* br = bins + row * 64 + 8 * kc;
            const int nstep = (nt64 + 1) >> 1;
            u32x4 cur = {0u, 0u, 0u, 0u};
            if (!sa && th < nt64) cur = *(const u32x4*)(br + th * 2048);
#pragma unroll 1
            for (int st = 0; st < nstep; ++st) {
                u32x4 nxt = {0u, 0u, 0u, 0u};
                if (!sa && 2 * (st + 1) + th < nt64) nxt = *(const u32x4*)(br + (2 * (st + 1) + th) * 2048);
                const int tile = 2 * st + th, k0 = tile * 64 + 8 * kc;
                unsigned m8 = 0u;
#pragma unroll
                for (int i = 0; i < 8; ++i) {
                    const int bn = (int)((cur[i >> 1] >> (16 * (i & 1))) & 0xffffu), key = k0 + i;
                    const bool v = key <= qrow && tile < nt64;
                    if (v && (sa || bn > tb)) m8 |= 1u << i;
                    if (v && !sa && bn == tb) {
                        const int ix = atomicAdd(info + 5 * IDX_ROWS + row, 1);
                        if (ix < IDX_FCAP) fcand[row * IDX_FCAP + ix] = make_uint2(0u, (unsigned)key);
                    }
                }
                const unsigned w1 = (unsigned)__builtin_amdgcn_update_dpp(0, (int)m8, 0x101, 0xF, 0xF, true);
                const unsigned w2 = (unsigned)__builtin_amdgcn_update_dpp(0, (int)m8, 0x102, 0xF, 0xF, true);
                const unsigned w3 = (unsigned)__builtin_amdgcn_update_dpp(0, (int)m8, 0x103, 0xF, 0xF, true);
                if ((kc & 3) == 0 && tile < nt64) hist[(tile * 2 + (kc >> 2)) * IDX_ROWS + row] = m8 | (w1 << 8) | (w2 << 16) | (w3 << 24);
                cur = nxt;
            }
        }
        const int ovf = __syncthreads_or(FORCE_SLOW || (tid < IDX_ROWS && info[5 * IDX_ROWS + tid] > IDX_FCAP));
        if (ovf) {
            idx_unit_slow(p, x, lds, q0, ntile, tid, lane, w, c, h);
        } else {
#pragma unroll 1
            for (int rr = 0; rr < 4; ++rr) {
                const int row = 4 * w + rr, n = info[5 * IDX_ROWS + row], need1 = info[2 * IDX_ROWS + row];
                uint2* cl = fcand + row * IDX_FCAP;
                if (n > 0) {
                    const int hd = lane >> 3, dc = lane & 7;
                    const bf16x8 qv = *(const bf16x8*)(p.qi + ((size_t)(q0 + row) * 8 + hd) * 64 + 8 * dc);
                    const float wgt = p.wi[(size_t)(q0 + row) * 8 + hd];
#pragma unroll 1
                    for (int j0 = 0; j0 < n; j0 += 8) {
                        bf16x8 kv[8];
#pragma unroll
                        for (int u = 0; u < 8; ++u) {
                            const unsigned key = cl[j0 + u < n ? j0 + u : n - 1].y;
                            kv[u] = *(const bf16x8*)(p.ki + (size_t)key * 64 + 8 * dc);
                        }
#pragma unroll
                        for (int u = 0; u < 8; ++u) {
                            float d = 0.f;
#pragma unroll
                            for (int e = 0; e < 8; ++e) d = __builtin_fmaf(bf2f((bf16_t)qv[e]), bf2f((bf16_t)kv[u][e]), d);
                            d += __shfl_xor(d, 1); d += __shfl_xor(d, 2); d += __shfl_xor(d, 4);
                            float sc = wgt * fmaxf(d, 0.f);
                            sc += __shfl_xor(sc, 8); sc += __shfl_xor(sc, 16); sc += __shfl_xor(sc, 32);
                            if (lane == 0 && j0 + u < n) cl[j0 + u].x = fkey(sc);
                        }
                    }
                }
                __builtin_amdgcn_s_waitcnt(0xc07f);
                __builtin_amdgcn_wave_barrier();
#pragma unroll 1
                for (int i0 = 0; i0 < n; i0 += 64) {
                    const int i = i0 + lane;
                    const uint2 ci = cl[i < n ? i : 0];
                    int rank = 0;
#pragma unroll 1
                    for (int j = 0; j < n; ++j) {
                        const uint2 cj = cl[j];
                        rank += (cj.x > ci.x || (cj.x == ci.x && cj.y < ci.y)) ? 1 : 0;
                    }
                    if (i < n && rank < need1) atomicOr(hist + (ci.y >> 5) * IDX_ROWS + row, 1u << (ci.y & 31u));
                }
            }
            __syncthreads();
        }
        const int nw = (((q0 & ~255) >> 5) + 8) * IDX_ROWS;
        for (int i = tid; i < nw; i += NTHR) {
            const int kt = i / IDX_ROWS, r = i % IDX_ROWS;
            p.bm[(size_t)kt * T_ + q0 + r] = hist[i];
        }
    }
}
#define XB_TMO      128
#define XB_XCNT(j)  (256  + 64 * (j))
#define XB_XSUB(j)  (1280 + 64 * (j))
#define XB_XGEN(j)  (2304 + 64 * (j))
#define XB_TOP      3328
#define XB_TOPGEN   3392
#define XCD_BAR_WORDS 3456
#define XB_SPIN_CAP (1u << 22)
#define LAS __attribute__((address_space(3)))

__device__ __forceinline__ unsigned xb_ld(unsigned* p)              { return __hip_atomic_load(p, __ATOMIC_RELAXED, __HIP_MEMORY_SCOPE_AGENT); }
__device__ __forceinline__ unsigned xb_add(unsigned* p, unsigned v) { return __hip_atomic_fetch_add(p, v, __ATOMIC_RELAXED, __HIP_MEMORY_SCOPE_AGENT); }
__device__ __forceinline__ unsigned xb_xcc_id() { return (unsigned)__builtin_amdgcn_s_getreg((3 << 11) | 20) & 0xFu; }
#define XB_SPIN(cond, bar) do { unsigned _sp = 0; while (cond) { __builtin_amdgcn_s_sleep(1); \
    if ((++_sp & 255u) == 0u) { if (xb_ld(&(bar)[XB_TMO])) break; if (_sp > XB_SPIN_CAP) { atomicAdd(&(bar)[XB_TMO], 1u); break; } } } } while (0)

struct XcdBarrier { unsigned* bar; unsigned x; volatile LAS unsigned* st; };

__device__ __forceinline__ XcdBarrier xcd_barrier_post(unsigned* bar, volatile LAS unsigned* st) {
    XcdBarrier b; b.bar = bar; b.x = xb_xcc_id(); b.st = st;
    if (threadIdx.x == 0) (void)xb_add(&bar[XB_XCNT(b.x)], 1u);
    return b;
}
__device__ __forceinline__ void xcd_barrier_complete(unsigned* bar, unsigned x, unsigned& nloc, unsigned& nx) {
    const unsigned G = gridDim.x * gridDim.y * gridDim.z;
    unsigned sum, cnt, mine, sp = 0u;
    for (;;) {
        sum = 0u; cnt = 0u; mine = 0u;
#pragma unroll
        for (unsigned j = 0; j < 16; ++j) { const unsigned c = xb_ld(&bar[XB_XCNT(j)]); sum += c; cnt += (c > 0u) ? 1u : 0u; mine = (j == x) ? c : mine; }
        if (sum == G) break;
        __builtin_amdgcn_s_sleep(1);
        if ((++sp & 255u) == 0u) { if (xb_ld(&bar[XB_TMO])) break; if (sp > XB_SPIN_CAP) { atomicAdd(&bar[XB_TMO], 1u); break; } }
    }
    nloc = mine > 0u ? mine : 1u; nx = cnt > 0u ? cnt : 1u;
}
__device__ __forceinline__ void xcd_barrier(const XcdBarrier& b) {
    asm volatile("s_waitcnt vmcnt(0)" ::: "memory");
    __syncthreads();
    if (threadIdx.x == 0) {
        unsigned* bar = b.bar;
        __builtin_amdgcn_s_waitcnt(0);
        unsigned nloc = b.st[0], nx = b.st[1];
        if (nloc == 0u) { xcd_barrier_complete(bar, b.x, nloc, nx); b.st[0] = nloc; b.st[1] = nx; }
        const unsigned old = xb_add(&bar[XB_XSUB(b.x)], 1u);
        const unsigned gen = old / nloc;
        if (old + 1u == (gen + 1u) * nloc) {
            __builtin_amdgcn_fence(__ATOMIC_RELEASE, "agent");
            asm volatile("s_waitcnt vmcnt(0)" ::: "memory");
            const unsigned og = xb_add(&bar[XB_TOP], 1u);
            const unsigned tg = og / nx;
            if (og + 1u == (tg + 1u) * nx) xb_add(&bar[XB_TOPGEN], 1u);
            else XB_SPIN(xb_ld(&bar[XB_TOPGEN]) == tg, bar);
            __builtin_amdgcn_fence(__ATOMIC_ACQUIRE, "agent");
            xb_add(&bar[XB_XGEN(b.x)], 1u);
            asm volatile("s_waitcnt vmcnt(0)" ::: "memory");
        } else {
            XB_SPIN(xb_ld(&bar[XB_XGEN(b.x)]) == gen, bar);
            __builtin_amdgcn_fence(__ATOMIC_ACQUIRE, "agent");
            asm volatile("s_waitcnt vmcnt(0)" ::: "memory");
        }
    }
    __syncthreads();
}


#define GSYNC() xcd_barrier(xb)
#define MEGA_LDS_B (IDX_TOTAL_LDS_B > (RT_DEC_OFF + 4096) ? IDX_TOTAL_LDS_B : (RT_DEC_OFF + 4096))
template <int layer>
__device__ __forceinline__ void tail_phases(const P& p, char* lds, const XcdBarrier& xb) {
    phase_outproj(p, layer == 0 ? p.wb_ab_out : p.wb_c_out, layer == 0 ? p.x : p.x3, lds);
    GSYNC();
    phase_ln_router(p, layer, lds);
    GSYNC();
    phase_moe1(p, layer, lds);
    GSYNC();
    phase_moe2(p, layer, lds);
    GSYNC();
    phase_combine_ln(p, layer, lds);
    GSYNC();
    phase_ple(p, layer, layer == 0 ? p.x3 : p.out, lds);
    if (layer == 0) GSYNC();
}

__global__ void __launch_bounds__(512, 2) mega(P p) {
    extern __shared__ __attribute__((aligned(16))) char lds[];
    cg::grid_group grid = cg::this_grid();
    volatile LAS unsigned* st = (volatile LAS unsigned*)(lds + MEGA_LDS_B);
    if (threadIdx.x == 0) { st[0] = 0u; st[1] = 0u; }
    __syncthreads();
    const XcdBarrier xb = xcd_barrier_post(p.bar, st);
    phase_convert(p, lds);
    if (p.bar == nullptr) grid.sync();
    xcd_barrier(xb);
    phase_pp(p, lds);
    phase_inproj<0>(p, lds);
    GSYNC();
    phase_moba_gate(p, lds);
    phase_sb(p, lds);
    GSYNC();
    phase_moba_sparse(p, lds);
    GSYNC();
    phase_moba_own(p, lds);
    GSYNC();
#if defined(DEBUG_STAGE) && (DEBUG_STAGE == 2 || DEBUG_STAGE == 1)
    return;
#endif
    tail_phases<0>(p, lds, xb);
    phase_inproj<1>(p, lds);
    GSYNC();
    phase_indexer(p, lds);
    GSYNC();
    phase_dsa(p, lds);
    GSYNC();
    tail_phases<1>(p, lds, xb);
}

static inline char* carve(char*& cur, size_t bytes) { char* r = cur; cur += (bytes + 255) & ~(size_t)255; return r; }

static void make_params(P& p, void* const* d_in, void* d_out, void* d_ws) {
    p.x = (const float*)d_in[0]; p.p = (const float*)d_in[1]; p.ab_w_in = (const float*)d_in[2]; p.ab_w_out = (const float*)d_in[3];
    p.c_w_in = (const float*)d_in[4]; p.c_w_out = (const float*)d_in[5]; p.ln_g = (const float*)d_in[6]; p.ln_b = (const float*)d_in[7];
    p.router_w = (const float*)d_in[8]; p.router_b = (const float*)d_in[9]; p.moe_w1 = (const float*)d_in[10]; p.moe_b1 = (const float*)d_in[11];
    p.moe_w2 = (const float*)d_in[12]; p.moe_b2 = (const float*)d_in[13]; p.ple_w_proj = (const float*)d_in[14]; p.ple_w_gate = (const float*)d_in[15];
    p.out = (float*)d_out;
    char* cur = (char*)d_ws;
    const size_t T = T_;
    p.cnt = (int*)carve(cur, 256);
    p.dbg = (float*)carve(cur, 256);
    p.bar = (unsigned*)carve(cur, XCD_BAR_WORDS * sizeof(unsigned));
    p.wb_ab_in = (bf16_t*)carve(cur, (size_t)3072 * 1024 * 2);
    p.wb_ab_out = (bf16_t*)carve(cur, (size_t)1024 * 1024 * 2);
    p.wb_c_in = (bf16_t*)carve(cur, (size_t)C_INP * 1024 * 2);
    p.ksum = (float*)carve(cur, 8 * 64 * 64 * 4);
    p.kmax2 = (unsigned*)carve(cur, 256);
    p.mb_cnt = (int*)carve(cur, 512 * 4);
    p.mb_list = (int*)carve(cur, (size_t)512 * T * 4);
    p.mb_part = (float*)carve(cur, (size_t)8 * T * 3 * 64 * 4);
    p.mb_l = (float*)carve(cur, (size_t)8 * T * 3 * 4);
    p.wb_c_out = (bf16_t*)carve(cur, (size_t)1024 * 1024 * 2);
    p.wb_w1 = (bf16_t*)carve(cur, (size_t)64 * 2048 * 1024 * 2);
    p.wb_w2 = (bf16_t*)carve(cur, (size_t)64 * 1024 * 1024 * 2);
    p.wb_g = (bf16_t*)carve(cur, (size_t)2 * 1024 * 1024 * 2);
    p.wb_p = (bf16_t*)carve(cur, (size_t)2 * 1024 * 256 * 2);
    p.xb = (bf16_t*)carve(cur, T * DM * 2);
    p.pb = (bf16_t*)carve(cur, 2 * T * 256 * 2);
    p.pp = (float*)carve(cur, 2 * T * DM * 4);
    p.rope = (float*)carve(cur, T * 32 * 2 * 4);
    p.q16 = (bf16_t*)carve(cur, 16 * T * 64 * 2);
    p.k16 = (bf16_t*)carve(cur, 16 * T * 64 * 2);
    p.vT16 = (bf16_t*)carve(cur, 16 * T * 64 * 2);
    p.o = (bf16_t*)carve(cur, T * DM * 2);
    p.ypre = (float*)carve(cur, T * DM * 4);
    p.x1 = (float*)carve(cur, T * DM * 4);
    p.x1b = (bf16_t*)carve(cur, T * DM * 2);
    p.act = (bf16_t*)carve(cur, (size_t)(65536 + 32 * 256) * DM * 2);
    p.oslot = (bf16_t*)carve(cur, (size_t)(65536 + 32 * 256) * DM * 2);
    p.x2 = (float*)carve(cur, T * DM * 4);
    p.x2b = (bf16_t*)carve(cur, T * DM * 2);
    p.x3 = (float*)carve(cur, T * DM * 4);
    p.qi = (bf16_t*)carve(cur, T * 8 * 64 * 2);
    p.ki = (bf16_t*)carve(cur, T * 64 * 2);
    p.wi = (float*)carve(cur, T * 8 * 4);
    p.bm = (unsigned*)carve(cur, (size_t)512 * T * 4);
    p.tok_of = (int*)carve(cur, (size_t)32 * T * 4);
    p.sel_e = (int*)carve(cur, T * 4 * 4);
    p.sel_pos = (int*)carve(cur, T * 4 * 4);
    p.sel_g = (float*)carve(cur, T * 4 * 4);
}

extern "C" void kernel_launch(void* const* d_in, const int* in_sizes, int n_in, void* d_out, int out_size, void* d_ws, size_t ws_size, hipStream_t stream) {
    P p{};
    make_params(p, d_in, d_out, d_ws);
    constexpr size_t kDynLds = MEGA_LDS_B + 16;
    static int grid_blocks = 0;
    if (!grid_blocks) {
        int dev = 0, cus = 0, per_cu = 0;
        hipGetDevice(&dev);
        hipDeviceGetAttribute(&cus, hipDeviceAttributeMultiprocessorCount, dev);
        hipFuncSetAttribute((const void*)mega, hipFuncAttributeMaxDynamicSharedMemorySize, (int)kDynLds);
        hipOccupancyMaxActiveBlocksPerMultiprocessor(&per_cu, mega, NTHR, kDynLds);
        if (per_cu > 1) per_cu = 1;
        if (per_cu < 1) per_cu = 1;
        grid_blocks = cus * per_cu;
    }
    hipMemsetAsync(p.bar, 0, XCD_BAR_WORDS * sizeof(unsigned), stream);
    void* args[] = {&p};
    hipError_t e = hipLaunchCooperativeKernel((void*)mega, dim3(grid_blocks), dim3(NTHR), args, kDynLds, stream);
    if (e != hipSuccess) fprintf(stderr, "cooperative launch failed: %s (grid %d)\n", hipGetErrorString(e), grid_blocks);
#if defined(DEBUG_STAGE) && DEBUG_STAGE == 1
    k_dbg_zero<<<1, 64, 0, stream>>>(p);
    k_chk_sb<<<512, 64, 0, stream>>>(p);
    k_report<<<1024, 256, 0, stream>>>(p, 0, 100.0f);
#endif
#if defined(DEBUG_STAGE) && DEBUG_STAGE == 5
    k_dbg_zero<<<1, 64, 0, stream>>>(p);
    k_chk_moe<<<128, 256, 0, stream>>>(p);
    k_report<<<1024, 256, 0, stream>>>(p, 0, 100.0f);
#endif
#if defined(DEBUG_STAGE) && DEBUG_STAGE == 4
    k_dbg_zero<<<1, 64, 0, stream>>>(p);
    k_chk_dsa<<<512, 64, 0, stream>>>(p);
    k_report<<<1024, 256, 0, stream>>>(p, 0, 100.0f);
#endif
#if defined(DEBUG_STAGE) && DEBUG_STAGE == 3
    k_dbg_zero<<<1, 64, 0, stream>>>(p);
    k_chk_idx<<<32, 256, 65536, stream>>>(p);
    k_report<<<1024, 256, 0, stream>>>(p, 1, 1.0f / 32.0f);
#endif
#if defined(DEBUG_STAGE) && DEBUG_STAGE == 2
    k_dbg_zero<<<1, 64, 0, stream>>>(p);
    k_chk_moba<<<512, 64, 0, stream>>>(p);
    k_report<<<1024, 256, 0, stream>>>(p, 1, 1.0f);
#endif
}
```

```cpp
#include <hip/hip_runtime.h>
#include <hip/hip_cooperative_groups.h>
#include <stdint.h>
#include <cstdio>
namespace cg = cooperative_groups;

typedef unsigned short bf16_t;
typedef short bf16x8 __attribute__((ext_vector_type(8)));
typedef float f32x4 __attribute__((ext_vector_type(4)));
typedef float f32x16 __attribute__((ext_vector_type(16)));
typedef unsigned u32x4 __attribute__((ext_vector_type(4)));

#define T_ 16384
#define DM 1024
#define NEXP 32
#define C_IN_ 3656
#define C_INP 3840
#define LOG2E 1.4426950408889634f
#define DN_ALPHA 1.4142135623730951f
#define NTHR 512
#define NWAVE 8

__device__ __forceinline__ int otid() { int t = threadIdx.x; asm volatile("" : "+v"(t)); return t; }
__device__ __forceinline__ bf16_t f2bf(float f) { unsigned u = __float_as_uint(f); u += 0x7FFFu + ((u >> 16) & 1u); return (bf16_t)(u >> 16); }
__device__ __forceinline__ float bf2f(bf16_t b) { return __uint_as_float(((unsigned)b) << 16); }
typedef __bf16 bf16v2_ __attribute__((ext_vector_type(2)));
typedef float f32v2_ __attribute__((ext_vector_type(2)));
__device__ __forceinline__ unsigned pack2(float lo, float hi) { const f32v2_ v = {lo, hi}; return __builtin_bit_cast(unsigned, __builtin_convertvector(v, bf16v2_)); }
__device__ __forceinline__ float fexp2(float x) { return __builtin_amdgcn_exp2f(x); }
__device__ __forceinline__ float flog2(float x) { return __builtin_amdgcn_logf(x); }
__device__ __forceinline__ float sigmoidf_(float x) { return __builtin_amdgcn_rcpf(1.0f + __builtin_amdgcn_exp2f(-LOG2E * x)); }
__device__ __forceinline__ float wave_sum(float v) {
#pragma unroll
    for (int o = 32; o > 0; o >>= 1) v += __shfl_xor(v, o);
    return v;
}

struct P {
    const float *x, *p, *ab_w_in, *ab_w_out, *c_w_in, *c_w_out, *ln_g, *ln_b, *router_w, *router_b, *moe_w1, *moe_b1, *moe_w2, *moe_b2, *ple_w_proj, *ple_w_gate;
    float* out;
    bf16_t *wb_ab_in, *wb_ab_out, *wb_c_in, *wb_c_out, *wb_w1, *wb_w2, *wb_g, *wb_p;
    bf16_t *xb, *pb;
    float* pp;
    float* rope;
    bf16_t *q16, *k16, *vT16, *o;
    float* ksum;
    unsigned* kmax2;
    int* mb_cnt;
    int* mb_list;
    float* mb_part;
    float* mb_l;
    float *ypre, *x1;
    bf16_t* x1b;
    bf16_t *act, *oslot;
    float* x2;
    bf16_t* x2b;
    float* x3;
    bf16_t *qi, *ki;
    float* wi;
    unsigned* bm;
    int *cnt, *tok_of, *sel_e, *sel_pos;
    float* sel_g;
    float* dbg;
    unsigned* bar;
    unsigned* dyn;
};

__device__ __forceinline__ int zz_unit(int r, int b, int G) { return (r & 1) ? (r * G + (G - 1 - b)) : (r * G + b); }

__device__ __forceinline__ int w1map(int n) {
    const int is_up = n & 1, j = n >> 1, tile = j >> 7, jj = j & 127, wc = jj >> 5, jl = jj & 31;
    return tile * 256 + wc * 64 + is_up * 32 + jl;
}

__device__ __forceinline__ void conv_job(const float* __restrict__ src, bf16_t* __restrict__ dst, int K, int N, int dst_rows, int mode, int batch, int nblk = -1, int bidx = -1) {
    const int tid = otid(), lane = tid & 63, wid = tid >> 6, kg = lane & 7, ng = lane >> 3;
    const int tkn = K / 64, tnn = dst_rows / 32, per = tkn * tnn, total = per * batch;
    if (nblk < 0) { nblk = gridDim.x; bidx = blockIdx.x; }
    const int stride = nblk * NWAVE;
    int u = bidx * NWAVE + wid;
    if (u >= total) return;
    f32x4 v[8], w[8];
    auto coords = [&](int uu, const float*& S, bf16_t*& D, int& k0, int& n) {
        const int bt = uu / per, r = uu % per, tn = r / tkn, tk = r % tkn;
        S = src + (size_t)bt * K * N; D = dst + (size_t)bt * dst_rows * K; k0 = tk * 64 + 8 * kg; n = tn * 32 + 4 * ng;
    };
    auto load = [&](f32x4 (&x)[8], const float* S, int k0, int n) {
#pragma unroll
        for (int j = 0; j < 8; ++j) { x[j] = (f32x4){0.f, 0.f, 0.f, 0.f}; if (n < N) x[j] = *(const f32x4*)(S + (size_t)(k0 + j) * N + n); }
    };
    auto store = [&](const f32x4 (&x)[8], bf16_t* D, int k0, int n) {
#pragma unroll
        for (int i = 0; i < 4; ++i) {
            const int drow = (mode == 1) ? w1map(n + i) : (n + i);
            *(u32x4*)(D + (size_t)drow * K + k0) = (u32x4){pack2(x[0][i], x[1][i]), pack2(x[2][i], x[3][i]), pack2(x[4][i], x[5][i]), pack2(x[6][i], x[7][i])};
        }
    };
    const float* S0; bf16_t* D0; int k00, n0;
    coords(u, S0, D0, k00, n0);
    load(v, S0, k00, n0);
#pragma unroll 1
    for (;;) {
        const int u1 = u + stride;
        const float* S1 = S0; bf16_t* D1 = D0; int k01 = k00, n1 = n0;
        if (u1 < total) { coords(u1, S1, D1, k01, n1); load(w, S1, k01, n1); }
        store(v, D0, k00, n0);
        if (u1 >= total) break;
        const int u2 = u1 + stride;
        if (u2 < total) { coords(u2, S0, D0, k00, n0); load(v, S0, k00, n0); }
        store(w, D1, k01, n1);
        if (u2 >= total) break;
        u = u2;
    }
}

__device__ __forceinline__ void conv_job_dyn(const float* __restrict__ src, bf16_t* __restrict__ dst, int K, int N, int dst_rows, int mode, int batch, unsigned* ctr) {
    constexpr int CH = 4;
    const int tid = otid(), lane = tid & 63, kg = lane & 7, ng = lane >> 3;
    const int tkn = K / 64, tnn = dst_rows / 32, per = tkn * tnn, total = per * batch;
    auto issue = [&]() -> unsigned { unsigned v = 0u; if (lane == 0) v = atomicAdd(ctr + (tid >> 16), (unsigned)CH); return v; };
    auto consume = [&](unsigned v) -> int { return (int)__builtin_amdgcn_readfirstlane(v); };
    f32x4 v[8], w[8];
    auto load = [&](f32x4 (&x)[8], int uu) {
        const int bt = uu / per, r = uu % per, tk = r / tnn, tn = r % tnn;
        const float* S = src + (size_t)bt * K * N + (size_t)(tk * 64 + 8 * kg) * N + tn * 32 + 4 * ng;
#pragma unroll
        for (int j = 0; j < 8; ++j) x[j] = *(const f32x4*)(S + (size_t)j * N);
    };
    auto store = [&](const f32x4 (&x)[8], int uu) {
        const int bt = uu / per, r = uu % per, tk = r / tnn, tn = r % tnn, n = tn * 32 + 4 * ng;
        bf16_t* D = dst + (size_t)bt * dst_rows * K + tk * 64 + 8 * kg;
#pragma unroll
        for (int i = 0; i < 4; ++i) {
            const int drow = (mode == 1) ? w1map(n + i) : (n + i);
            *(u32x4*)(D + (size_t)drow * K) = (u32x4){pack2(x[0][i], x[1][i]), pack2(x[2][i], x[3][i]), pack2(x[4][i], x[5][i]), pack2(x[6][i], x[7][i])};
        }
    };
    int cb = consume(issue());
    if (cb >= total) return;
    unsigned pend = issue();
    load(v, cb);
#pragma unroll 1
    for (;;) {
        load(w, cb + 1); store(v, cb);
        load(v, cb + 2); store(w, cb + 1);
        load(w, cb + 3); store(v, cb + 2);
        const int nb = consume(pend);
        pend = issue();
        const int nbc = nb < total ? nb : total - CH;
        store(w, cb + 3);
        load(v, nbc);
        if (nb >= total) break;
        cb = nb;
    }
}

#ifdef SPIN_P0
#define P0S(k) do { if (blockIdx.x == 0 && threadIdx.x == 0) ((unsigned long long*)p.dbg)[96 + (k)] = __builtin_amdgcn_s_memrealtime(); if ((k) == 6 && threadIdx.x == 0) ((unsigned long long*)p.dbg)[128 + blockIdx.x] = __builtin_amdgcn_s_memrealtime(); } while (0)
#else
#define P0S(k)
#endif
#define CV_LAS __attribute__((address_space(3)))
__device__ __forceinline__ void phase_convert(const P& p, char* lds) {
    P0S(0);
    conv_job(p.ab_w_in, p.wb_ab_in, 1024, 3072, 3072, 0, 1);
    conv_job(p.ab_w_out, p.wb_ab_out, 1024, 1024, 1024, 0, 1);
    conv_job(p.c_w_in, p.wb_c_in, 1024, C_IN_, C_INP, 0, 1);
    conv_job(p.c_w_out, p.wb_c_out, 1024, 1024, 1024, 0, 1);
    P0S(1);
    P0S(2);
    P0S(3);
    conv_job(p.ple_w_gate, p.wb_g, 1024, 1024, 1024, 0, 2);
    conv_job(p.ple_w_proj, p.wb_p, 256, 1024, 1024, 0, 2);
    P0S(4);
    const size_t gtid = (size_t)blockIdx.x * NTHR + otid(), gsz = (size_t)gridDim.x * NTHR;
    {
        const int lane_ = otid() & 63, wid_ = __builtin_amdgcn_readfirstlane(otid() >> 6);
        const int ux = (int)((size_t)T_ * DM / 4 / 512), up = (int)((size_t)2 * T_ * 256 / 4 / 512), ut = ux + up;
        char* wl = lds + wid_ * 16384;
        const int stride = (int)gridDim.x * NWAVE;
        int u = (int)blockIdx.x * NWAVE + wid_;
        auto srcof = [&](int uu) -> const float* { return uu < ux ? p.x + (size_t)uu * 2048 : p.p + (size_t)(uu - ux) * 2048; };
        auto dstof = [&](int uu) -> bf16_t* { return uu < ux ? p.xb + (size_t)uu * 2048 : p.pb + (size_t)(uu - ux) * 2048; };
        auto issue = [&](int buf, int uu) {
            const float* S = srcof(uu) + 4 * lane_;
#pragma unroll
            for (int j = 0; j < 8; ++j)
                __builtin_amdgcn_global_load_lds((const unsigned*)(S + 256 * j), (CV_LAS unsigned*)(wl + buf * 8192 + j * 1024), 16, 0, 2);
        };
        __syncthreads();
        if (u < ut) {
            issue(0, u);
            int buf = 0;
#pragma unroll 1
            for (;;) {
                const int u1 = u + stride;
                const bool more = u1 < ut;
                issue(buf ^ 1, more ? u1 : u);
                asm volatile("s_waitcnt vmcnt(8)" ::: "memory");
                bf16_t* D = dstof(u) + 4 * lane_;
#pragma unroll
                for (int j = 0; j < 8; ++j) {
                    const f32x4 v = *(const f32x4*)(wl + buf * 8192 + j * 1024 + lane_ * 16);
                    *(uint2*)(D + 256 * j) = make_uint2(pack2(v[0], v[1]), pack2(v[2], v[3]));
                }
                if (!more) break;
                u = u1; buf ^= 1;
            }
            asm volatile("s_waitcnt vmcnt(0)" ::: "memory");
        }
        __syncthreads();
    }
    P0S(5);
    {
        const int k = (int)(gtid & 31);
        const double inv_rev = exp2(-(double)k * (13.287712379549449 / 32.0)) * 0.15915494309189535;
        for (size_t i = gtid; i < (size_t)T_ * 32; i += gsz) {
            const double tr = (double)(int)(i >> 5) * inv_rev;
            const float rev = (float)(tr - rint(tr));
            p.rope[2 * i] = __builtin_amdgcn_cosf(rev);
            p.rope[2 * i + 1] = __builtin_amdgcn_sinf(rev);
        }
    }
    P0S(6);
    for (size_t i = gtid; i < 8 * 64 * 64; i += gsz) p.ksum[i] = 0.f;
    if (blockIdx.x == 0 && otid() < 64) p.cnt[otid()] = 0;
    if (blockIdx.x == 0 && otid() < 32) p.kmax2[otid()] = 0u;
    if (blockIdx.x == 1) p.mb_cnt[otid()] = 0;
}
__device__ __forceinline__ void conv_job_dma(const float* __restrict__ src, bf16_t* __restrict__ dst, int K, int N, int dst_rows, int mode, int batch, int nblk, int bidx, char* lds) {
    const int tid = otid(), lane = tid & 63, wid = __builtin_amdgcn_readfirstlane(tid >> 6), kg = lane & 7, ng = lane >> 3;
    const int tkn = K / 64, tnn = dst_rows / 32, per = tkn * tnn, total = per * batch;
    const int stride = nblk * NWAVE;
    int u = bidx * NWAVE + wid;
    if (u >= total) return;
    char* wl = lds + wid * 16384;
    auto coords = [&](int uu, const float*& S, bf16_t*& D, int& k0, int& n) {
        const int bt = uu / per, r = uu % per, tn = r / tkn, tk = r % tkn;
        S = src + (size_t)bt * K * N; D = dst + (size_t)bt * dst_rows * K; k0 = tk * 64 + 8 * kg; n = tn * 32 + 4 * ng;
    };
    auto issue = [&](int buf, const float* S, int k0, int n) {
#pragma unroll
        for (int j = 0; j < 8; ++j)
            __builtin_amdgcn_global_load_lds((const unsigned*)(S + (size_t)(k0 + j) * N + n), (CV_LAS unsigned*)(wl + buf * 8192 + j * 1024), 16, 0, 2);
    };
    auto store = [&](const f32x4 (&x)[8], bf16_t* D, int k0, int n) {
#pragma unroll
        for (int i = 0; i < 4; ++i) {
            const int drow = (mode == 1) ? w1map(n + i) : (n + i);
            *(u32x4*)(D + (size_t)drow * K + k0) = (u32x4){pack2(x[0][i], x[1][i]), pack2(x[2][i], x[3][i]), pack2(x[4][i], x[5][i]), pack2(x[6][i], x[7][i])};
        }
    };
    const float* S0; bf16_t* D0; int k00, n0;
    coords(u, S0, D0, k00, n0);
    issue(0, S0, k00, n0);
    int buf = 0;
#pragma unroll 1
    for (;;) {
        const int u1 = u + stride;
        const bool more = u1 < total;
        const float* S1 = S0; bf16_t* D1 = D0; int k01 = k00, n1 = n0;
        if (more) coords(u1, S1, D1, k01, n1);
        issue(buf ^ 1, S1, k01, n1);
        asm volatile("s_waitcnt vmcnt(8)" ::: "memory");
        f32x4 x[8];
#pragma unroll
        for (int j = 0; j < 8; ++j) x[j] = *(const f32x4*)(wl + buf * 8192 + j * 1024 + lane * 16);
        store(x, D0, k00, n0);
        if (!more) break;
        u = u1; S0 = S1; D0 = D1; k00 = k01; n0 = n1; buf ^= 1;
    }
    asm volatile("s_waitcnt vmcnt(0)" ::: "memory");
}
__device__ __forceinline__ void conv_moe_layer(const P& p, int layer, char* lds) {
    const int bidx = (int)(blockIdx.x & 7) | (int)((blockIdx.x >> 4) << 3), nblk = gridDim.x >> 1;
    __syncthreads();
    conv_job_dma(p.moe_w1 + (size_t)layer * 32 * 1024 * 2048, p.wb_w1 + (size_t)layer * 32 * 2048 * 1024, 1024, 2048, 2048, 1, 32, nblk, bidx, lds);
    conv_job_dma(p.moe_w2 + (size_t)layer * 32 * 1024 * 1024, p.wb_w2 + (size_t)layer * 32 * 1024 * 1024, 1024, 1024, 1024, 0, 32, nblk, bidx, lds);
    __syncthreads();
}

#define G_TILE_B 32768
#define G_STAGE_B 65536
#define G_LDS_B 131072
__device__ __forceinline__ int g_lds_byte(int r, int c) {
    const int st = (r >> 4) * 2 + (c >> 5), ob = (r & 15) * 64 + (c & 31) * 2;
    return st * 1024 + (ob ^ (((ob >> 9) & 1) << 5));
}
__device__ __forceinline__ void g_stage_rc(int b, int& R, int& C) {
    const int st = b >> 10, sb = b & 1023, swz = sb ^ (((sb >> 9) & 1) << 5);
    R = (st >> 1) * 16 + swz / 64;
    C = (st & 1) * 32 + (swz % 64) / 2;
}
__device__ __forceinline__ int xcd_remap(int l, int C) {
    const int chunk = (C + 7) >> 3, j = l >> 3, x = l & 7, ul = x * chunk + j;
    return (j < chunk && ul < C) ? ul : -1;
}
struct RoundUnits {
    int total;
    __device__ __forceinline__ int operator()(int k) const {
        const int G = gridDim.x, C = total - k * G;
        if (C <= 0) return -1;
        const int ul = xcd_remap(blockIdx.x, C < G ? C : G);
        return ul < 0 ? -1 : k * G + ul;
    }
};
#define G8_LAS __attribute__((address_space(3)))
#define G8_HTB 16384
struct AOff { unsigned o[2][2]; };

__device__ __forceinline__ void g8_rc(int i, int& R, int& C) { g_stage_rc(otid() * 16 + i * 8192, R, C); }
__device__ __forceinline__ AOff g8_dense_a(int row0, int ld) {
    AOff a; int R, C;
#pragma unroll
    for (int i = 0; i < 2; ++i) {
        g8_rc(i, R, C);
        a.o[0][i] = (unsigned)(((size_t)(row0 + R) * ld + C) * 2);
        a.o[1][i] = (unsigned)(((size_t)(row0 + 128 + R) * ld + C) * 2);
    }
    return a;
}

struct NoHalf { __device__ __forceinline__ bool operator()(int) const { return false; } };
template <bool TR, class UnitFn, class AFn, class BFn, class EpiFn, class HalfFn = NoHalf>
__device__ __forceinline__ void gemm8_units(UnitFn unit_of, int K, char* lds_, const bf16_t* Abase, AFn aoff_of, BFn bbase_of, EpiFn epi, HalfFn half_of = HalfFn()) {
    G8_LAS unsigned char* lds = (G8_LAS unsigned char*)lds_;
    const int tid = otid(), wid = __builtin_amdgcn_readfirstlane(tid >> 6), lane = tid & 63, wr = wid >> 2, wc = wid & 3, fr = lane & 15, fq = lane >> 4;
    const int nt = K / 64;
    int cur = unit_of(0);
    if (cur < 0) return;
    unsigned voffB[2];
#pragma unroll
    for (int i = 0; i < 2; ++i) { int R, C; g8_rc(i, R, C); voffB[i] = (unsigned)(((64 * (R >> 5) + (R & 31)) * K + C) * 2); }
    const size_t kstep = 128;
    const size_t hstepB = (size_t)32 * K * 2;
    const unsigned ldsw = (unsigned)wid * 1024u;
    const int aoffl = g_lds_byte(wr * 64 + fr, fq * 8), boffl = g_lds_byte(wc * 32 + fr, fq * 8);
#define G8_SA(b, h) (((b) * 2 + (h)) * G8_HTB)
#define G8_SB(b, h) ((4 + (b) * 2 + (h)) * G8_HTB)
#define G8_STAGE_A(bufoff, AO, h, kb) do { _Pragma("unroll") for (int _i = 0; _i < 2; ++_i) \
        __builtin_amdgcn_global_load_lds((const unsigned*)((const char*)Abase + (kb) + (AO).o[h][_i]), (G8_LAS unsigned*)(lds + (bufoff) + ldsw + _i * 8192), 16, 0, 0); } while (0)
#define G8_STAGE_B(bufoff, gbase) do { _Pragma("unroll") for (int _i = 0; _i < 2; ++_i) \
        __builtin_amdgcn_global_load_lds((const unsigned*)((const char*)(gbase) + voffB[_i]), (G8_LAS unsigned*)(lds + (bufoff) + ldsw + _i * 8192), 16, 0, 0); } while (0)
#define G8_LDA(dst, b, h) do { _Pragma("unroll") for (int m = 0; m < 4; ++m) _Pragma("unroll") for (int k = 0; k < 2; ++k) dst[m][k] = *(const G8_LAS bf16x8*)(lds + G8_SA(b, h) + aoffl + m * 2048 + k * 1024); } while (0)
#define G8_LDB(dst, b, h) do { _Pragma("unroll") for (int n = 0; n < 2; ++n) _Pragma("unroll") for (int k = 0; k < 2; ++k) dst[n][k] = *(const G8_LAS bf16x8*)(lds + G8_SB(b, h) + boffl + n * 2048 + k * 1024); } while (0)
#define G8_MMA(ai, bj, At_, Bt_) do { __builtin_amdgcn_s_setprio(1); _Pragma("unroll") for (int m = 0; m < 4; ++m) _Pragma("unroll") for (int n = 0; n < 2; ++n) _Pragma("unroll") for (int k = 0; k < 2; ++k) \
        acc[ai][bj][m][n] = TR ? __builtin_amdgcn_mfma_f32_16x16x32_bf16(Bt_[n][k], At_[m][k], acc[ai][bj][m][n], 0, 0, 0) \
                               : __builtin_amdgcn_mfma_f32_16x16x32_bf16(At_[m][k], Bt_[n][k], acc[ai][bj][m][n], 0, 0, 0); __builtin_amdgcn_s_setprio(0); } while (0)
#define G8_WAIT_V(n) asm volatile("s_waitcnt vmcnt(" #n ")" ::: "memory")
#define G8_WAIT_L(n) asm volatile("s_waitcnt lgkmcnt(" #n ")" ::: "memory")
#define G8_BAR __builtin_amdgcn_s_barrier()
#define G8_SCHED __builtin_amdgcn_sched_barrier(0)
    f32x4 acc[2][2][4][2];
#pragma unroll
    for (int a = 0; a < 2; ++a)
#pragma unroll
        for (int b = 0; b < 2; ++b)
#pragma unroll
            for (int m = 0; m < 4; ++m)
#pragma unroll
                for (int n = 0; n < 2; ++n) acc[a][b][m][n] = (f32x4){0.f, 0.f, 0.f, 0.f};
    bf16x8 At[4][2], B0[2][2], B1[2][2];
    AOff cA = aoff_of(cur), nA = cA;
    const char* cB = (const char*)bbase_of(cur);
    __syncthreads();
    G8_STAGE_B(G8_SB(0, 0), cB); G8_STAGE_A(G8_SA(0, 0), cA, 0, 0); G8_STAGE_B(G8_SB(0, 1), cB + hstepB); G8_STAGE_A(G8_SA(0, 1), cA, 1, 0);
    if (wr == 1) G8_BAR;
    G8_WAIT_V(4); G8_BAR;
    G8_STAGE_B(G8_SB(1, 0), cB + kstep); G8_STAGE_A(G8_SA(1, 0), cA, 0, kstep); G8_STAGE_B(G8_SB(1, 1), cB + hstepB + kstep);
    G8_WAIT_V(6); G8_BAR;
    for (int ui = 0;; ++ui) {
        const int nxt = unit_of(ui + 1);
        const bool has_next = nxt >= 0;
        const char* nB = cB;
        if (has_next) { nA = aoff_of(nxt); nB = (const char*)bbase_of(nxt); } else nA = cA;
        for (int t = 0; t < nt; t += 2) {
            const bool last = (t == nt - 2);
            const size_t k1 = (size_t)(t + 1) * kstep;
            AOff a2;
#pragma unroll
            for (int hh = 0; hh < 2; ++hh)
#pragma unroll
                for (int i = 0; i < 2; ++i) a2.o[hh][i] = last ? nA.o[hh][i] : cA.o[hh][i];
            const size_t k2 = last ? 0 : (size_t)(t + 2) * kstep, k3 = k2 + kstep;
            const char* b2 = last ? nB : cB + (size_t)(t + 2) * kstep;
            const char* b3 = b2 + kstep;
            G8_LDB(B0, 0, 0); G8_SCHED; G8_LDA(At, 0, 0); G8_STAGE_A(G8_SA(1, 1), cA, 1, k1);
            G8_WAIT_L(8); G8_BAR; G8_WAIT_L(0); G8_MMA(0, 0, At, B0); G8_BAR; G8_SCHED;
            G8_LDB(B1, 0, 1); G8_STAGE_B(G8_SB(0, 0), b2);
            G8_BAR; G8_WAIT_L(0); G8_MMA(0, 1, At, B1); G8_BAR;
            G8_LDA(At, 0, 1); G8_STAGE_A(G8_SA(0, 0), a2, 0, k2);
            G8_BAR; G8_WAIT_L(0); G8_MMA(1, 0, At, B0); G8_BAR; G8_SCHED;
            G8_STAGE_B(G8_SB(0, 1), b2 + hstepB);
            G8_WAIT_V(6); G8_BAR; G8_MMA(1, 1, At, B1); G8_BAR;
            G8_LDB(B0, 1, 0); G8_SCHED; G8_LDA(At, 1, 0); G8_STAGE_A(G8_SA(0, 1), a2, 1, k2);
            G8_WAIT_L(8); G8_BAR; G8_WAIT_L(0); G8_MMA(0, 0, At, B0); G8_BAR; G8_SCHED;
            G8_LDB(B1, 1, 1); G8_STAGE_B(G8_SB(1, 0), b3);
            G8_BAR; G8_WAIT_L(0); G8_MMA(0, 1, At, B1); G8_BAR;
            G8_LDA(At, 1, 1); G8_STAGE_A(G8_SA(1, 0), a2, 0, k3);
            G8_BAR; G8_WAIT_L(0); G8_MMA(1, 0, At, B0); G8_BAR; G8_SCHED;
            G8_STAGE_B(G8_SB(1, 1), b3 + hstepB);
            G8_WAIT_V(6); G8_BAR; G8_MMA(1, 1, At, B1); G8_BAR;
        }
        epi(cur, acc, wr, wc, fr, fq);
        if (!has_next) break;
#pragma unroll
        for (int a = 0; a < 2; ++a)
#pragma unroll
            for (int b = 0; b < 2; ++b)
#pragma unroll
                for (int m = 0; m < 4; ++m)
#pragma unroll
                    for (int n = 0; n < 2; ++n) acc[a][b][m][n] = (f32x4){0.f, 0.f, 0.f, 0.f};
        cur = nxt; cA = nA; cB = nB;
    }
    G8_WAIT_V(0);
    if (wr == 0) G8_BAR;
    G8_BAR;
#undef G8_SA
#undef G8_SB
#undef G8_STAGE_A
#undef G8_STAGE_B
#undef G8_LDA
#undef G8_LDB
#undef G8_MMA
#undef G8_WAIT_V
#undef G8_WAIT_L
#undef G8_BAR
#undef G8_SCHED
}
typedef f32x4 Acc8[2][2][4][2];
__device__ __forceinline__ void phase_pp(const P& p, char* lds) {
    gemm8_units<true>(RoundUnits{2 * 64 * 4}, 256, lds, p.pb,
        [&](int t) { const int l = t >> 8, mt = (t & 255) >> 2; return g8_dense_a(l * T_ + mt * 256, 256); },
        [&](int t) { const int l = t >> 8, nt = t & 3; return p.wb_p + ((size_t)l * 1024 + nt * 256) * 256; },
        [&](int t, Acc8& acc, int wr, int wc, int fr, int fq) {
            const int l = t >> 8, mt = (t & 255) >> 2, nt = t & 3;
            bf16_t* O = (bf16_t*)p.pp + (size_t)l * T_ * DM;
#pragma unroll
            for (int ai = 0; ai < 2; ++ai)
#pragma unroll
                for (int m = 0; m < 4; ++m)
#pragma unroll
                    for (int bj = 0; bj < 2; ++bj)
#pragma unroll
                        for (int n = 0; n < 2; ++n) {
                            const int tok = mt * 256 + 128 * ai + 64 * wr + 16 * m + fr, col = nt * 256 + 64 * wc + 32 * bj + 16 * n + 4 * fq;
                            const f32x4 a = acc[ai][bj][m][n];
                            *(uint2*)(O + (size_t)tok * DM + col) = make_uint2(pack2(a[0], a[1]), pack2(a[2], a[3]));
                        }
        });
}

template <bool ROPE>
__device__ __forceinline__ void epi_rows(const P& p, bf16_t* dst, int stride, Acc8& acc, int tok0, int wr, int fr, int fq, float scale) {
#pragma unroll
    for (int ai = 0; ai < 2; ++ai)
#pragma unroll
        for (int m = 0; m < 4; ++m) {
            const int tok = tok0 + 128 * ai + 64 * wr + 16 * m + fr;
            if (ROPE) {
#pragma unroll
                for (int n = 0; n < 2; ++n) {
                    const float* rt = p.rope + ((size_t)tok * 32 + n * 16 + 4 * fq) * 2;
                    const f32x4 cs0 = *(const f32x4*)rt, cs1 = *(const f32x4*)(rt + 4);
                    const float c[4] = {cs0[0], cs0[2], cs1[0], cs1[2]}, sn[4] = {cs0[1], cs0[3], cs1[1], cs1[3]};
#pragma unroll
                    for (int j = 0; j < 4; ++j) {
                        const float x1 = acc[ai][0][m][n][j], x2 = acc[ai][1][m][n][j];
                        acc[ai][0][m][n][j] = x1 * c[j] - x2 * sn[j];
                        acc[ai][1][m][n][j] = x2 * c[j] + x1 * sn[j];
                    }
                }
            }
#pragma unroll
            for (int bj = 0; bj < 2; ++bj)
#pragma unroll
                for (int n = 0; n < 2; ++n) {
                    const f32x4 v = acc[ai][bj][m][n] * scale;
                    *(uint2*)(dst + (size_t)tok * stride + 32 * bj + 16 * n + 4 * fq) = make_uint2(pack2(v[0], v[1]), pack2(v[2], v[3]));
                }
            __builtin_amdgcn_sched_barrier(0);
        }
}
template <bool KSUM>
__device__ __forceinline__ void epi_key(const P& p, bf16_t* dst, Acc8& acc, int tok0, int wr, int fr, int fq, unsigned* kmax2, float* ks) {
    f32x4 sum[2][2];
#pragma unroll
    for (int bj = 0; bj < 2; ++bj)
#pragma unroll
        for (int n = 0; n < 2; ++n) sum[bj][n] = (f32x4){0.f, 0.f, 0.f, 0.f};
    float mx = 0.f;
#pragma unroll
    for (int ai = 0; ai < 2; ++ai)
#pragma unroll
        for (int m = 0; m < 4; ++m) {
            const int tok = tok0 + 128 * ai + 64 * wr + 16 * m + fr;
#pragma unroll
            for (int n = 0; n < 2; ++n) {
                const float* rt = p.rope + ((size_t)tok * 32 + n * 16 + 4 * fq) * 2;
                const f32x4 cs0 = *(const f32x4*)rt, cs1 = *(const f32x4*)(rt + 4);
                const float c[4] = {cs0[0], cs0[2], cs1[0], cs1[2]}, sn[4] = {cs0[1], cs0[3], cs1[1], cs1[3]};
#pragma unroll
                for (int j = 0; j < 4; ++j) {
                    const float x1 = acc[ai][0][m][n][j], x2 = acc[ai][1][m][n][j];
                    acc[ai][0][m][n][j] = x1 * c[j] - x2 * sn[j];
                    acc[ai][1][m][n][j] = x2 * c[j] + x1 * sn[j];
                }
            }
            float ss = 0.f;
#pragma unroll
            for (int bj = 0; bj < 2; ++bj)
#pragma unroll
                for (int n = 0; n < 2; ++n) {
                    const f32x4 a = acc[ai][bj][m][n];
                    const unsigned w0 = pack2(a[0], a[1]), w1 = pack2(a[2], a[3]);
                    *(uint2*)(dst + (size_t)tok * 64 + 32 * bj + 16 * n + 4 * fq) = make_uint2(w0, w1);
                    const float e0 = __uint_as_float(w0 << 16), e1 = __uint_as_float(w0 & 0xffff0000u), e2 = __uint_as_float(w1 << 16), e3 = __uint_as_float(w1 & 0xffff0000u);
                    ss += (e0 * e0 + e1 * e1) + (e2 * e2 + e3 * e3);
                    if (KSUM) sum[bj][n] = sum[bj][n] + a;
                }
            ss += __shfl_xor(ss, 16);
            ss += __shfl_xor(ss, 32);
            mx = fmaxf(mx, ss);
            __builtin_amdgcn_sched_barrier(0);
        }
#pragma unroll
    for (int o = 8; o > 0; o >>= 1) mx = fmaxf(mx, __shfl_xor(mx, o));
    if ((otid() & 63) == 0) atomicMax(kmax2, __float_as_uint(mx));
    if (KSUM) {
#pragma unroll
        for (int bj = 0; bj < 2; ++bj)
#pragma unroll
            for (int n = 0; n < 2; ++n) {
                f32x4 sv = sum[bj][n];
#pragma unroll
                for (int o = 1; o < 16; o <<= 1) { sv[0] += __shfl_xor(sv[0], o); sv[1] += __shfl_xor(sv[1], o); sv[2] += __shfl_xor(sv[2], o); sv[3] += __shfl_xor(sv[3], o); }
                if (fr == 0) {
#pragma unroll
                    for (int j = 0; j < 4; ++j) atomicAdd(ks + 32 * bj + 16 * n + 4 * fq + j, sv[j]);
                }
            }
    }
}
__device__ __forceinline__ void epi_vT(bf16_t* dst  , Acc8& acc, int tok0, int wr, int fr, int fq) {
#pragma unroll
    for (int ai = 0; ai < 2; ++ai)
#pragma unroll
        for (int m = 0; m < 4; ++m)
#pragma unroll
            for (int bj = 0; bj < 2; ++bj)
#pragma unroll
                for (int n = 0; n < 2; ++n) {
                    const f32x4 v = acc[ai][bj][m][n];
                    *(uint2*)(dst + (size_t)(32 * bj + 16 * n + fr) * T_ + tok0 + 128 * ai + 64 * wr + 16 * m + 4 * fq) = make_uint2(pack2(v[0], v[1]), pack2(v[2], v[3]));
                }
}

template <bool TR, class NtFn, class EpiFn>
__device__ __forceinline__ void typed_loop(const P& p, char* lds, const bf16_t* W, int& base, int count, NtFn ntile_of, EpiFn epi) {
    const int G = gridDim.x, bidx = blockIdx.x, b0 = base;
    const int l = (((bidx - b0) % G) + G) % G;
    const int ul = l < count ? xcd_remap(l, count) : -1;
    gemm8_units<TR>([&](int k) { return (k == 0 && ul >= 0) ? ul : -1; }, DM, lds, p.xb,
        [&](int t) { int mt, nt; ntile_of(t, mt, nt); return g8_dense_a(mt * 256, DM); },
        [&](int t) { int mt, nt; ntile_of(t, mt, nt); return W + (size_t)nt * 256 * DM; },
        [&](int t, Acc8& acc, int wr, int wc, int fr, int fq) { int mt, nt; ntile_of(t, mt, nt); epi(acc, mt, nt, mt * 256, wr, wc, fr, fq); });
    base += count;
}

template <int LAYER>
__device__ __forceinline__ void phase_inproj(const P& p, char* lds) {
    int base = 0;
    if (LAYER == 0) {
        const bf16_t* W = p.wb_ab_in;
        typed_loop<true>(p, lds, W, base, 128, [](int i, int& mt, int& nt) { mt = i >> 1; nt = i & 1; },
            [&](Acc8& acc, int mt, int nt, int tok0, int wr, int wc, int fr, int fq) {
                epi_rows<false>(p, p.q16 + (size_t)(nt * 4 + wc) * T_ * 64, 64, acc, tok0, wr, fr, fq, 0.125f); });
        typed_loop<true>(p, lds, W, base, 128, [](int i, int& mt, int& nt) { mt = i >> 1; nt = 2 + (i & 1); },
            [&](Acc8& acc, int mt, int nt, int tok0, int wr, int wc, int fr, int fq) {
                epi_rows<false>(p, p.k16 + (size_t)((nt - 2) * 4 + wc) * T_ * 64, 64, acc, tok0, wr, fr, fq, 1.0f); });
        typed_loop<false>(p, lds, W, base, 256, [](int i, int& mt, int& nt) { mt = i >> 2; const int vi = i & 3; nt = (vi < 2 ? 4 : 8) + vi; },
            [&](Acc8& acc, int mt, int nt, int tok0, int wr, int wc, int fr, int fq) {
                const int head = (nt < 6 ? 0 : 8) + (nt & 1) * 4 + wc;
                epi_vT(p.vT16 + (size_t)head * 64 * T_, acc, tok0, wr, fr, fq); });
        typed_loop<true>(p, lds, W, base, 128, [](int i, int& mt, int& nt) { mt = i >> 1; nt = 6 + (i & 1); },
            [&](Acc8& acc, int mt, int nt, int tok0, int wr, int wc, int fr, int fq) {
                epi_rows<true>(p, p.q16 + (size_t)(8 + (nt - 6) * 4 + wc) * T_ * 64, 64, acc, tok0, wr, fr, fq, 0.125f * LOG2E); });
        typed_loop<true>(p, lds, W, base, 128, [](int i, int& mt, int& nt) { mt = i >> 1; nt = 8 + (i & 1); },
            [&](Acc8& acc, int mt, int nt, int tok0, int wr, int wc, int fr, int fq) {
                const int hd = (nt - 8) * 4 + wc;
                epi_key<true>(p, p.k16 + (size_t)(8 + hd) * T_ * 64, acc, tok0, wr, fr, fq, p.kmax2 + 8 + hd, p.ksum + ((size_t)hd * 64 + mt) * 64); });
    } else {
        const bf16_t* W = p.wb_c_in;
        typed_loop<true>(p, lds, W, base, 256, [](int i, int& mt, int& nt) { mt = i >> 2; nt = i & 3; },
            [&](Acc8& acc, int mt, int nt, int tok0, int wr, int wc, int fr, int fq) {
                epi_rows<true>(p, p.q16 + (size_t)(nt * 4 + wc) * T_ * 64, 64, acc, tok0, wr, fr, fq, 0.125f * LOG2E); });
        typed_loop<true>(p, lds, W, base, 256, [](int i, int& mt, int& nt) { mt = i >> 2; nt = 4 + (i & 3); },
            [&](Acc8& acc, int mt, int nt, int tok0, int wr, int wc, int fr, int fq) {
                const int hd = (nt - 4) * 4 + wc;
                epi_key<false>(p, p.k16 + (size_t)hd * T_ * 64, acc, tok0, wr, fr, fq, p.kmax2 + 16 + hd, nullptr); });
        typed_loop<false>(p, lds, W, base, 256, [](int i, int& mt, int& nt) { mt = i >> 2; nt = 8 + (i & 3); },
            [&](Acc8& acc, int mt, int nt, int tok0, int wr, int wc, int fr, int fq) {
                epi_vT(p.vT16 + (size_t)((nt - 8) * 4 + wc) * 64 * T_, acc, tok0, wr, fr, fq); });
        typed_loop<true>(p, lds, W, base, 128, [](int i, int& mt, int& nt) { mt = i >> 1; nt = 12 + (i & 1); },
            [&](Acc8& acc, int mt, int nt, int tok0, int wr, int wc, int fr, int fq) {
                const int hd = (nt - 12) * 4 + wc;
                epi_rows<true>(p, p.qi + (size_t)hd * 64, 512, acc, tok0, wr, fr, fq, 0.125f); });
        typed_loop<true>(p, lds, W, base, 64, [](int i, int& mt, int& nt) { mt = i; nt = 14; },
            [&](Acc8& acc, int mt, int nt, int tok0, int wr, int wc, int fr, int fq) {
                if (wc == 0) {
                    epi_rows<true>(p, p.ki, 64, acc, tok0, wr, fr, fq, 1.0f);
                } else if (wc == 1 && fq < 2) {
#pragma unroll
                    for (int ai = 0; ai < 2; ++ai)
#pragma unroll
                        for (int m = 0; m < 4; ++m)
                            *(f32x4*)(p.wi + (size_t)(tok0 + 128 * ai + 64 * wr + 16 * m + fr) * 8 + 4 * fq) = acc[ai][0][m][0] * 0.35355339059327373f;
                } });
    }
}
__device__ __forceinline__ f32x4 ld_bf4(const bf16_t* ptr) {
    const uint2 w = *(const uint2*)ptr;
    return (f32x4){__uint_as_float(w.x << 16), __uint_as_float(w.x & 0xffff0000u), __uint_as_float(w.y << 16), __uint_as_float(w.y & 0xffff0000u)};
}
__device__ __forceinline__ void phase_outproj(const P& p, const bf16_t* W, const bf16_t* xres, char* lds) {
    gemm8_units<true>(RoundUnits{64 * 4}, DM, lds, p.o,
        [&](int t) { return g8_dense_a((t >> 2) * 256, DM); },
        [&](int t) { return W + (size_t)(t & 3) * 256 * DM; },
        [&](int t, Acc8& acc, int wr, int wc, int fr, int fq) {
            const int mt = t >> 2, nt = t & 3;
#pragma unroll
            for (int ai = 0; ai < 2; ++ai)
#pragma unroll
                for (int m = 0; m < 4; ++m)
#pragma unroll
                    for (int bj = 0; bj < 2; ++bj)
#pragma unroll
                        for (int n = 0; n < 2; ++n) {
                            const size_t off = (size_t)(mt * 256 + 128 * ai + 64 * wr + 16 * m + fr) * DM + nt * 256 + 64 * wc + 32 * bj + 16 * n + 4 * fq;
                            const f32x4 y = ld_bf4(xres + off) * DN_ALPHA + acc[ai][bj][m][n];
                            *(uint2*)((bf16_t*)p.ypre + off) = make_uint2(pack2(y[0], y[1]), pack2(y[2], y[3]));
                        }
        });
}

__device__ __forceinline__ void ln_row(f32x4 (&v)[4], const float* g, const float* b, int lane) {
    float s = 0.f;
#pragma unroll
    for (int c = 0; c < 4; ++c) s += (v[c][0] + v[c][1]) + (v[c][2] + v[c][3]);
    const float mu = wave_sum(s) * (1.0f / DM);
    float q = 0.f;
#pragma unroll
    for (int c = 0; c < 4; ++c) {
        v[c] = v[c] - mu;
        q += (v[c][0] * v[c][0] + v[c][1] * v[c][1]) + (v[c][2] * v[c][2] + v[c][3] * v[c][3]);
    }
    const float rstd = 1.0f / sqrtf(wave_sum(q) * (1.0f / DM) + 1e-5f);
#pragma unroll
    for (int c = 0; c < 4; ++c) {
        const f32x4 gg = *(const f32x4*)(g + 4 * lane + 256 * c), bb = *(const f32x4*)(b + 4 * lane + 256 * c);
        v[c] = v[c] * rstd * gg + bb;
    }
}

#define RT_XS_STRIDE 1025
#define RT_RED_OFF (32 * RT_XS_STRIDE * 4)
#define RT_DEC_OFF (RT_RED_OFF + 16384)
__device__ __forceinline__ void phase_ln_router(const P& p, int layer, char* lds) {
    const int tid = otid(), lane = tid & 63, wid = tid >> 6;
    float* xs = (float*)lds;
    float* red = (float*)(lds + RT_RED_OFF);
    int* dec = (int*)(lds + RT_DEC_OFF);
    float* decg = (float*)(lds + RT_DEC_OFF + 1024);
    int* lcnt = (int*)(lds + RT_DEC_OFF + 2048);
    int* gbase = lcnt + 32;
    const float* g = p.ln_g + (size_t)(layer * 2 + 0) * DM;
    const float* b = p.ln_b + (size_t)(layer * 2 + 0) * DM;
    const float* wr_ = p.router_w + (size_t)layer * DM * NEXP;
    const float* br_ = p.router_b + layer * NEXP;
    int* cnt = p.cnt + layer * NEXP;
#pragma unroll 1
    for (int itb = 0; (blockIdx.x + itb * gridDim.x) * 32 < T_; itb += 2) {
    __syncthreads();
    if (tid < 32) lcnt[tid] = 0;
#pragma unroll 1
    for (int it = 0; it < 2; ++it) {
        const int t0 = (blockIdx.x + (itb + it) * gridDim.x) * 32;
        if (t0 >= T_) break;
        uint2 raw[4][4];
#pragma unroll
        for (int r = 0; r < 4; ++r)
#pragma unroll
            for (int c = 0; c < 4; ++c) raw[r][c] = *(const uint2*)((const bf16_t*)p.ypre + (size_t)(t0 + wid * 4 + r) * DM + 4 * lane + 256 * c);
#pragma unroll
        for (int r = 0; r < 4; ++r) {
            const int tl_ = wid * 4 + r, tok = t0 + tl_;
            f32x4 v[4];
#pragma unroll
            for (int c = 0; c < 4; ++c) {
                const uint2 w_ = raw[r][c];
                v[c] = (f32x4){__uint_as_float(w_.x << 16), __uint_as_float(w_.x & 0xffff0000u), __uint_as_float(w_.y << 16), __uint_as_float(w_.y & 0xffff0000u)};
            }
            ln_row(v, g, b, lane);
#pragma unroll
            for (int c = 0; c < 4; ++c) {
                *(uint2*)(p.x1b + (size_t)tok * DM + 4 * lane + 256 * c) = make_uint2(pack2(v[c][0], v[c][1]), pack2(v[c][2], v[c][3]));
                float* xr = xs + tl_ * RT_XS_STRIDE + 4 * lane + 256 * c;
                xr[0] = v[c][0]; xr[1] = v[c][1]; xr[2] = v[c][2]; xr[3] = v[c][3];
            }
        }
        __syncthreads();
        f32x16 d;
#pragma unroll
        for (int i = 0; i < 16; ++i) d[i] = 0.f;
        {
            const int i_ = lane & 31, kk = lane >> 5;
            const float* xa = xs + i_ * RT_XS_STRIDE + wid * 128 + kk;
            const float* wb = wr_ + (size_t)(wid * 128 + kk) * NEXP + i_;
#pragma unroll 8
            for (int s = 0; s < 64; ++s) d = __builtin_amdgcn_mfma_f32_32x32x2f32(xa[2 * s], wb[(size_t)(2 * s) * NEXP], d, 0, 0, 0);
        }
#pragma unroll
        for (int step = 4; step >= 1; step >>= 1) {
            if (wid >= step && wid < 2 * step) {
                float* rb = red + (wid - step) * 1024;
#pragma unroll
                for (int i = 0; i < 16; ++i) rb[i * 64 + lane] = d[i];
            }
            __syncthreads();
            if (wid < step) {
                const float* rb = red + wid * 1024;
#pragma unroll
                for (int i = 0; i < 16; ++i) d[i] += rb[i * 64 + lane];
            }
            __syncthreads();
        }
        if (wid == 0) {
#pragma unroll
            for (int i = 0; i < 16; ++i) red[((i & 3) + 8 * (i >> 2) + 4 * (lane >> 5)) * 32 + (lane & 31)] = d[i];
        }
        __syncthreads();
#pragma unroll
        for (int r = 0; r < 2; ++r) {
            const int e = lane & 31, hf = lane >> 5, tl_ = wid * 4 + 2 * r + hf;
            float cur = red[tl_ * 32 + e] + br_[e];
            float tv[4]; int ti[4];
#pragma unroll
            for (int k = 0; k < 4; ++k) {
                float mv = cur;
#pragma unroll
                for (int o = 16; o > 0; o >>= 1) mv = fmaxf(mv, __shfl_xor(mv, o));
                const unsigned long long bal = __ballot(cur == mv);
                const unsigned bh = hf ? (unsigned)(bal >> 32) : (unsigned)bal;
                const int idx = __ffs(bh) - 1;
                tv[k] = mv; ti[k] = idx;
                if (e == idx) cur = -3.0e38f;
            }
            const float e1 = __expf(tv[1] - tv[0]), e2 = __expf(tv[2] - tv[0]), e3 = __expf(tv[3] - tv[0]);
            const float inv = 1.0f / (1.0f + e1 + e2 + e3);
            if (e < 4) {
                const int ee = e == 0 ? ti[0] : e == 1 ? ti[1] : e == 2 ? ti[2] : ti[3];
                const float gg = e == 0 ? inv : e == 1 ? e1 * inv : e == 2 ? e2 * inv : e3 * inv;
                const int lpos = atomicAdd(lcnt + ee, 1);
                dec[(it * 32 + tl_) * 4 + e] = ee | (lpos << 8);
                decg[(it * 32 + tl_) * 4 + e] = gg;
            }
        }
        __syncthreads();
    }
    if (tid < 32) gbase[tid] = lcnt[tid] > 0 ? atomicAdd(cnt + tid, lcnt[tid]) : 0;
    __syncthreads();
    if (tid < 256) {
        const int it = tid >> 7, t0 = (blockIdx.x + (itb + it) * gridDim.x) * 32;
        if (t0 < T_) {
            const int tok = t0 + ((tid >> 2) & 31), k = tid & 3;
            const int dv = dec[tid], ee = dv & 255, pos = gbase[ee] + (dv >> 8);
            p.tok_of[(size_t)ee * T_ + pos] = tok;
            p.sel_e[tok * 4 + k] = ee;
            p.sel_pos[tok * 4 + k] = pos;
            p.sel_g[tok * 4 + k] = decg[tid];
        }
    }
    }
    __syncthreads();
}

__device__ __forceinline__ void moe_prefix(const int* cnt, int* mpre) {
    if (otid() == 0) {
        int s = 0;
        for (int e = 0; e < NEXP; ++e) { mpre[e] = s; s += (cnt[e] + 255) >> 8; }
        mpre[NEXP] = s;
    }
    __syncthreads();
}
#define MPRE_OFF G_LDS_B

__device__ __forceinline__ void phase_moe1(const P& p, int layer, char* lds) {
    int* mpre = (int*)(lds + MPRE_OFF);
    const int* cnt = p.cnt + layer * NEXP;
    moe_prefix(cnt, mpre);
    const int total = mpre[NEXP] * 8;
    auto expert_of = [&](int mg) { int e = 0;
#pragma unroll 1
        while (mpre[e + 1] <= mg) ++e;
        return e; };
    gemm8_units<true>(RoundUnits{total}, DM, lds, p.x1b,
        [&](int t) {
            const int mg = t >> 3, e = expert_of(mg), i = mg - mpre[e], ce_ = cnt[e];
            const int* tk = p.tok_of + (size_t)e * T_;
            AOff a; int R, C;
#pragma unroll
            for (int ii = 0; ii < 2; ++ii) {
                g8_rc(ii, R, C);
                const int p0 = i * 256 + R, p1 = p0 + 128;
                a.o[0][ii] = (unsigned)(((size_t)tk[p0 < ce_ ? p0 : 0] * DM + C) * 2);
                a.o[1][ii] = (unsigned)(((size_t)tk[p1 < ce_ ? p1 : 0] * DM + C) * 2);
            }
            return a;
        },
        [&](int t) { const int mg = t >> 3, nt = t & 7, e = expert_of(mg); return p.wb_w1 + ((size_t)(layer * NEXP + e) * 2048 + nt * 256) * DM; },
        [&](int t, Acc8& acc, int wr, int wc, int fr, int fq) {
            const int mg = t >> 3, nt = t & 7, e = expert_of(mg);
            const float* b1 = p.moe_b1 + (size_t)(layer * NEXP + e) * 2048;
#pragma unroll
            for (int n = 0; n < 2; ++n) {
                const int j0 = nt * 128 + wc * 32 + n * 16 + 4 * fq;
                float bg[4], bu[4];
#pragma unroll
                for (int j = 0; j < 4; ++j) { bg[j] = b1[2 * (j0 + j)]; bu[j] = b1[2 * (j0 + j) + 1]; }
#pragma unroll
                for (int ai = 0; ai < 2; ++ai)
#pragma unroll
                    for (int m = 0; m < 4; ++m) {
                        float r[4];
#pragma unroll
                        for (int j = 0; j < 4; ++j) {
                            const float gv = fminf(acc[ai][0][m][n][j] + bg[j], 7.0f);
                            const float uv = fminf(fmaxf(acc[ai][1][m][n][j] + bu[j], -7.0f), 7.0f);
                            const float glu = gv * sigmoidf_(1.702f * gv);
                            r[j] = (uv + 1.0f) * glu;
                        }
                        const size_t slot = (size_t)mg * 256 + 128 * ai + 64 * wr + 16 * m + fr;
                        *(uint2*)(p.act + slot * DM + j0) = make_uint2(pack2(r[0], r[1]), pack2(r[2], r[3]));
                    }
            }
        },
        [&](int t) { const int mg = t >> 3, e = expert_of(mg); return cnt[e] - (mg - mpre[e]) * 256 <= 128; });
}

__device__ __forceinline__ void phase_moe2(const P& p, int layer, char* lds) {
    int* mpre = (int*)(lds + MPRE_OFF);
    const int* cnt = p.cnt + layer * NEXP;
    moe_prefix(cnt, mpre);
    const int total = mpre[NEXP] * 4;
    auto expert_of = [&](int mg) { int e = 0;
#pragma unroll 1
        while (mpre[e + 1] <= mg) ++e;
        return e; };
    gemm8_units<true>(RoundUnits{total}, DM, lds, p.act,
        [&](int t) { return g8_dense_a((t >> 2) * 256, DM); },
        [&](int t) { const int mg = t >> 2, nt = t & 3, e = expert_of(mg); return p.wb_w2 + ((size_t)(layer * NEXP + e) * 1024 + nt * 256) * DM; },
        [&](int t, Acc8& acc, int wr, int wc, int fr, int fq) {
            const int mg = t >> 2, nt = t & 3, e = expert_of(mg);
            const float* b2 = p.moe_b2 + (size_t)(layer * NEXP + e) * DM;
#pragma unroll
            for (int ai = 0; ai < 2; ++ai)
#pragma unroll
                for (int m = 0; m < 4; ++m)
#pragma unroll
                    for (int bj = 0; bj < 2; ++bj)
#pragma unroll
                        for (int n = 0; n < 2; ++n) {
                            const int col = nt * 256 + 64 * wc + 32 * bj + 16 * n + 4 * fq;
                            const f32x4 v = acc[ai][bj][m][n] + *(const f32x4*)(b2 + col);
                            const size_t slot = (size_t)mg * 256 + 128 * ai + 64 * wr + 16 * m + fr;
                            *(uint2*)(p.oslot + slot * DM + col) = make_uint2(pack2(v[0], v[1]), pack2(v[2], v[3]));
                        }
        },
        [&](int t) { const int mg = t >> 2, e = expert_of(mg); return cnt[e] - (mg - mpre[e]) * 256 <= 128; });
}

__device__ __forceinline__ void phase_combine_ln(const P& p, int layer, char* lds) {
    const int tid = otid(), lane = tid & 63, wid = tid >> 6;
    int* mpre = (int*)(lds + MPRE_OFF);
    moe_prefix(p.cnt + layer * NEXP, mpre);
    const float* g = p.ln_g + (size_t)(layer * 2 + 1) * DM;
    const float* b = p.ln_b + (size_t)(layer * 2 + 1) * DM;
#pragma unroll 1
    for (int tok = blockIdx.x * NWAVE + wid; tok < T_; tok += gridDim.x * NWAVE) {
        f32x4 v[4];
#pragma unroll
        for (int c = 0; c < 4; ++c) v[c] = ld_bf4(p.x1b + (size_t)tok * DM + 4 * lane + 256 * c) * DN_ALPHA;
        f32x4 f[4];
#pragma unroll
        for (int c = 0; c < 4; ++c) f[c] = (f32x4){0.f, 0.f, 0.f, 0.f};
#pragma unroll
        for (int k = 0; k < 4; ++k) {
            const int e = p.sel_e[tok * 4 + k], pos = p.sel_pos[tok * 4 + k];
            const float gt = p.sel_g[tok * 4 + k];
            const bf16_t* row = p.oslot + ((size_t)mpre[e] * 256 + pos) * DM;
#pragma unroll
            for (int c = 0; c < 4; ++c) {
                const uint2 w = *(const uint2*)(row + 4 * lane + 256 * c);
                f[c][0] += gt * __uint_as_float(w.x << 16);
                f[c][1] += gt * __uint_as_float(w.x & 0xffff0000u);
                f[c][2] += gt * __uint_as_float(w.y << 16);
                f[c][3] += gt * __uint_as_float(w.y & 0xffff0000u);
            }
        }
#pragma unroll
        for (int c = 0; c < 4; ++c) v[c] = v[c] + f[c];
        ln_row(v, g, b, lane);
#pragma unroll
        for (int c = 0; c < 4; ++c) {
            *(uint2*)(p.x2b + (size_t)tok * DM + 4 * lane + 256 * c) = make_uint2(pack2(v[c][0], v[c][1]), pack2(v[c][2], v[c][3]));
        }
    }
}

__device__ __forceinline__ void phase_ple(const P& p, int layer, float* xout, char* lds) {
    const bf16_t* pp = (const bf16_t*)p.pp + (size_t)layer * T_ * DM;
    gemm8_units<true>(RoundUnits{64 * 4}, DM, lds, p.x2b,
        [&](int t) { return g8_dense_a((t >> 2) * 256, DM); },
        [&](int t) { return p.wb_g + (size_t)layer * DM * DM + (size_t)(t & 3) * 256 * DM; },
        [&](int t, Acc8& acc, int wr, int wc, int fr, int fq) {
            const int mt = t >> 2, nt = t & 3;
#pragma unroll
            for (int ai = 0; ai < 2; ++ai)
#pragma unroll
                for (int m = 0; m < 4; ++m)
#pragma unroll
                    for (int bj = 0; bj < 2; ++bj)
#pragma unroll
                        for (int n = 0; n < 2; ++n) {
                            const size_t off = (size_t)(mt * 256 + 128 * ai + 64 * wr + 16 * m + fr) * DM + nt * 256 + 64 * wc + 32 * bj + 16 * n + 4 * fq;
                            const f32x4 x2v = ld_bf4(p.x2b + off), ppv = ld_bf4(pp + off);
                            f32x4 r;
#pragma unroll
                            for (int j = 0; j < 4; ++j) r[j] = x2v[j] + sigmoidf_(acc[ai][bj][m][n][j]) * ppv[j];
                            if (xout) *(f32x4*)(xout + off) = r;
                            else *(uint2*)(p.xb + off) = make_uint2(pack2(r[0], r[1]), pack2(r[2], r[3]));
                        }
        });
}
#define KROW 144
#define VROW 144
#define KTILE_B (64 * KROW)
#define VTILE_B (64 * VROW)
#define ABUF_B (KTILE_B + VTILE_B)

struct TileRegs { u32x4 k0, v0; };

__device__ __forceinline__ void tile_gload(TileRegs& r, const bf16_t* kbase  , const bf16_t* vtbase  , int k0) {
    const int ci = otid(), row = ci >> 3, cc = ci & 7;
    r.k0 = *(const u32x4*)(kbase + (size_t)(k0 + row) * 64 + cc * 8);
    r.v0 = *(const u32x4*)(vtbase + (size_t)row * T_ + k0 + cc * 8);
}
__device__ __forceinline__ void tile_swrite(const TileRegs& r, char* buf) {
    const int ci = otid(), row = ci >> 3, cc = ci & 7;
    *(u32x4*)(buf + row * KROW + cc * 16) = r.k0;
    char* vd = buf + KTILE_B + row * VROW + (cc >> 1) * 32 + (cc & 1) * 8;
    *(uint2*)vd = make_uint2(r.v0[0], r.v0[1]);
    *(uint2*)(vd + 16) = make_uint2(r.v0[2], r.v0[3]);
}

__device__ __forceinline__ void load_qfrag(bf16x8 (&qf)[4], const bf16_t* qrow  , int h) {
#pragma unroll
    for (int kk = 0; kk < 4; ++kk) qf[kk] = *(const bf16x8*)(qrow + 16 * kk + 8 * h);
}
__device__ __forceinline__ float qnorm2(const bf16x8 (&qf)[4]) {
    float s = 0.f;
#pragma unroll
    for (int kk = 0; kk < 4; ++kk)
#pragma unroll
        for (int j = 0; j < 8; ++j) { const float e = bf2f((bf16_t)qf[kk][j]); s += e * e; }
    return s + __shfl_xor(s, 32);
}

__device__ __forceinline__ f32x16 qk_subtile(const char* kbuf, int t2, const bf16x8 (&qf)[4], int c, int h) {
    f32x16 s;
#pragma unroll
    for (int i = 0; i < 16; ++i) s[i] = 0.f;
#pragma unroll
    for (int kk = 0; kk < 4; ++kk) {
        const bf16x8 kf = *(const bf16x8*)(kbuf + (32 * t2 + c) * KROW + (16 * kk + 8 * h) * 2);
        s = __builtin_amdgcn_mfma_f32_32x32x16_bf16(kf, qf[kk], s, 0, 0, 0);
    }
    return s;
}

__device__ __forceinline__ void pv_subtile(const char* vbuf, int t2, const float (&pr)[16], f32x16 (&o)[2], int c, int h) {
#pragma unroll
    for (int s = 0; s < 2; ++s) {
        u32x4 pbu;
#pragma unroll
        for (int j = 0; j < 4; ++j) pbu[j] = pack2(pr[8 * s + 2 * j], pr[8 * s + 2 * j + 1]);
        const bf16x8 pbv = __builtin_bit_cast(bf16x8, pbu);
#pragma unroll
        for (int dt = 0; dt < 2; ++dt) {
            const u32x4 vfu = *(const u32x4*)(vbuf + (32 * dt + c) * VROW + (32 * t2 + 16 * s) * 2 + 16 * h);
            o[dt] = __builtin_amdgcn_mfma_f32_32x32x16_bf16(__builtin_bit_cast(bf16x8, vfu), pbv, o[dt], 0, 0, 0);
        }
    }
}

__device__ __forceinline__ void store_o(bf16_t* orow  , const f32x16 (&o)[2], int h, float scale) {
#pragma unroll
    for (int dt = 0; dt < 2; ++dt)
#pragma unroll
        for (int g = 0; g < 4; ++g) {
            const int d = 32 * dt + 8 * g + 4 * h;
            *(uint2*)(orow + d) = make_uint2(pack2(o[dt][4 * g] * scale, o[dt][4 * g + 1] * scale), pack2(o[dt][4 * g + 2] * scale, o[dt][4 * g + 3] * scale));
        }
}

#define SB_STOP 32.0f
__device__ __forceinline__ void phase_sb(const P& p, char* lds) {
    const int tid = otid(), lane = tid & 63, w = tid >> 6, c = lane & 31, h = lane >> 5;
#pragma unroll 1
    for (int t = blockIdx.x; t < 8 * 64; t += gridDim.x) {
        const int head = t & 7, qb = 63 - (t >> 3);
        const int q0 = qb * 256, qw = q0 + 32 * w, query = qw + c;
        const bf16_t* kbase = p.k16 + (size_t)head * T_ * 64;
        const bf16_t* vtbase = p.vT16 + (size_t)head * 64 * T_;
        bf16x8 qf[4];
        load_qfrag(qf, p.q16 + ((size_t)head * T_ + query) * 64, h);
        f32x16 o[2];
#pragma unroll
        for (int i = 0; i < 16; ++i) { o[0][i] = 0.f; o[1][i] = 0.f; }
        float R = 0.f;
        int kt = (q0 + 255) >> 6;
        TileRegs tr;
        tile_gload(tr, kbase, vtbase, kt * 64);
        __syncthreads();
        tile_swrite(tr, lds);
        __syncthreads();
        int buf = 0;
#pragma unroll 1
        for (;;) {
            const bool more = kt > 0;
            if (more) tile_gload(tr, kbase, vtbase, (kt - 1) * 64);
            const char* kb = lds + buf * ABUF_B;
            const char* vb = kb + KTILE_B;
            const int k0 = kt * 64;
#pragma unroll
            for (int t2 = 1; t2 >= 0; --t2) {
                const int keybase = k0 + 32 * t2;
                if (keybase < qw + 31) {
                    const f32x16 s = qk_subtile(kb, t2, qf, c, h);
                    const bool need_mask = keybase + 31 >= qw;
                    float L[16], E[16];
#pragma unroll
                    for (int r = 0; r < 16; ++r) {
                        const float z2 = s[r] * LOG2E;
                        const int zb = __float_as_int(z2);
                        float l = __int_as_float(zb > 0 ? zb : 0) + flog2(1.0f + fexp2(-fabsf(z2)));
                        const int key = keybase + (r & 3) + 8 * (r >> 2) + 4 * h;
                        const bool valid = !need_mask || key < query;
                        l = valid ? l : 0.f;
                        L[r] = l;
                        E[r] = valid ? (z2 - l) : -1.0e30f;
                    }
                    float gs[4], tot[4], ps[4];
#pragma unroll
                    for (int g = 0; g < 4; ++g) {
                        gs[g] = (L[4 * g] + L[4 * g + 1]) + (L[4 * g + 2] + L[4 * g + 3]);
                        ps[g] = __shfl_xor(gs[g], 32);
                        tot[g] = gs[g] + ps[g];
                    }
                    float above[4];
                    above[3] = (h == 0 ? ps[3] : 0.f);
                    above[2] = tot[3] + (h == 0 ? ps[2] : 0.f);
                    above[1] = tot[3] + tot[2] + (h == 0 ? ps[1] : 0.f);
                    above[0] = tot[3] + tot[2] + tot[1] + (h == 0 ? ps[0] : 0.f);
                    float pr[16];
#pragma unroll
                    for (int g = 0; g < 4; ++g) {
                        float run = R + above[g];
#pragma unroll
                        for (int i = 3; i >= 0; --i) {
                            pr[4 * g + i] = fexp2(E[4 * g + i] - run);
                            run += L[4 * g + i];
                        }
                    }
                    R += (tot[0] + tot[1]) + (tot[2] + tot[3]);
                    pv_subtile(vb, t2, pr, o, c, h);
                }
            }
            const int done = __syncthreads_and(R > SB_STOP);
            if (!more || done) break;
            tile_swrite(tr, lds + (buf ^ 1) * ABUF_B);
            __syncthreads();
            buf ^= 1;
            --kt;
        }
        store_o(p.o + (size_t)query * DM + head * 64, o, h, 1.0f);
    }
}

__device__ __forceinline__ void softmax_subtile(const f32x16& s, unsigned W, float M2, float& l, f32x16 (&o)[2], const char* vb, int t2, int c, int h) {
    const unsigned Wh = W >> (4 * h);
    float pr[16];
    float ls = 0.f;
#pragma unroll
    for (int r = 0; r < 16; ++r) {
        const bool ok = (Wh >> ((r & 3) + 8 * (r >> 2))) & 1u;
        const float pv = ok ? fexp2(s[r] * LOG2E - M2) : 0.f;
        pr[r] = pv;
        ls += pv;
    }
    l += ls;
    pv_subtile(vb, t2, pr, o, c, h);
}

__device__ __forceinline__ unsigned causal_word(int query, int keybase) {
    const int nk = query - keybase + 1;
    return nk >= 32 ? 0xffffffffu : (nk <= 0 ? 0u : ((1u << nk) - 1u));
}
__device__ __forceinline__ float shift_bound_l2(float qn2, unsigned kmax2_bits) {
    return fminf(sqrtf(qn2 * __uint_as_float(kmax2_bits)) * 1.002f, 64.0f);
}
__device__ __forceinline__ float shift_bound(float qn2, unsigned kmax2_bits) {
    const float b = sqrtf(qn2 * __uint_as_float(kmax2_bits)) * (LOG2E * 1.002f);
    return fminf(b, 64.0f);
}

__device__ __forceinline__ void attn_tile64(const char* kb, const char* vb, const bf16x8 (&qf)[4], unsigned W0, unsigned W1, float M2, float& l, f32x16 (&o)[2], int c, int h) {
    bf16x8 k0[4], k1[4];
#pragma unroll
    for (int kk = 0; kk < 4; ++kk) {
        k0[kk] = *(const bf16x8*)(kb + c * KROW + (16 * kk + 8 * h) * 2);
        k1[kk] = *(const bf16x8*)(kb + (32 + c) * KROW + (16 * kk + 8 * h) * 2);
    }
    const unsigned Wh0 = W0 >> (4 * h), Wh1 = W1 >> (4 * h);
    f32x16 s0, s1;
#pragma unroll
    for (int r = 0; r < 16; ++r) {
        const int bit = (r & 3) + 8 * (r >> 2);
        s0[r] = ((Wh0 >> bit) & 1u) ? -M2 : -1.0e30f;
        s1[r] = ((Wh1 >> bit) & 1u) ? -M2 : -1.0e30f;
    }
#pragma unroll
    for (int kk = 0; kk < 4; ++kk) {
        s0 = __builtin_amdgcn_mfma_f32_32x32x16_bf16(k0[kk], qf[kk], s0, 0, 0, 0);
        s1 = __builtin_amdgcn_mfma_f32_32x32x16_bf16(k1[kk], qf[kk], s1, 0, 0, 0);
    }
    u32x4 vf[2][2][2];
#pragma unroll
    for (int t2 = 0; t2 < 2; ++t2)
#pragma unroll
        for (int sI = 0; sI < 2; ++sI)
#pragma unroll
            for (int dt = 0; dt < 2; ++dt) {
                vf[t2][sI][dt] = *(const u32x4*)(vb + (32 * dt + c) * VROW + (32 * t2 + 16 * sI) * 2 + 16 * h);
            }
    u32x4 pb[2][2];
    f32v2_ ls2 = {0.f, 0.f};
#pragma unroll
    for (int sI = 0; sI < 2; ++sI) {
        f32v2_ pa[4], pc[4];
#pragma unroll
        for (int j = 0; j < 4; ++j) {
            const int r = 8 * sI + 2 * j;
            pa[j][0] = fexp2(s0[r]); pa[j][1] = fexp2(s0[r + 1]);
            pc[j][0] = fexp2(s1[r]); pc[j][1] = fexp2(s1[r + 1]);
            ls2 = ls2 + pa[j] + pc[j];
        }
        pb[0][sI] = (u32x4){pack2(pa[0][0], pa[0][1]), pack2(pa[1][0], pa[1][1]), pack2(pa[2][0], pa[2][1]), pack2(pa[3][0], pa[3][1])};
        pb[1][sI] = (u32x4){pack2(pc[0][0], pc[0][1]), pack2(pc[1][0], pc[1][1]), pack2(pc[2][0], pc[2][1]), pack2(pc[3][0], pc[3][1])};
    }
    l += ls2[0] + ls2[1];
#pragma unroll
    for (int t2 = 0; t2 < 2; ++t2)
#pragma unroll
        for (int sI = 0; sI < 2; ++sI)
#pragma unroll
            for (int dt = 0; dt < 2; ++dt)
                o[dt] = __builtin_amdgcn_mfma_f32_32x32x16_bf16(__builtin_bit_cast(bf16x8, vf[t2][sI][dt]), __builtin_bit_cast(bf16x8, pb[t2][sI]), o[dt], 0, 0, 0);
}

__device__ __forceinline__ void phase_moba_gate(const P& p, char* lds) {
    const int tid = otid(), lane = tid & 63, w = tid >> 6, c = lane & 31, h = lane >> 5;
#pragma unroll 1
    for (int t = blockIdx.x; t < 8 * 63; t += gridDim.x) {
        const int head = t & 7, cur = 63 - (t >> 3);
        const int query = cur * 256 + 32 * w + c;
        bf16x8 qf[4];
        load_qfrag(qf, p.q16 + ((size_t)(8 + head) * T_ + query) * 64, h);
        int sel0 = -1, sel1 = -1, sel2 = -1;
        __syncthreads();
        if (tid < 64) ((int*)(lds + 16384))[tid] = 0;
        {
            const int row = tid >> 3, cc = tid & 7;
            const float* ks = p.ksum + ((size_t)head * 64 + row) * 64 + cc * 8;
            const f32x4 a = *(const f32x4*)ks * (1.0f / 256.0f), b = *(const f32x4*)(ks + 4) * (1.0f / 256.0f);
            *(u32x4*)(lds + row * KROW + cc * 16) = (u32x4){pack2(a[0], a[1]), pack2(a[2], a[3]), pack2(b[0], b[1]), pack2(b[2], b[3])};
        }
        __syncthreads();
        float v0 = -3.0e38f, v1 = -3.0e38f, v2 = -3.0e38f;
#pragma unroll
        for (int t2 = 0; t2 < 2; ++t2) {
            const f32x16 s = qk_subtile(lds, t2, qf, c, h);
#pragma unroll
            for (int r = 0; r < 16; ++r) {
                const int n = 32 * t2 + (r & 3) + 8 * (r >> 2) + 4 * h;
                const float g = s[r];
                if (n < cur) {
                    if (g > v0) { v2 = v1; sel2 = sel1; v1 = v0; sel1 = sel0; v0 = g; sel0 = n; }
                    else if (g > v1) { v2 = v1; sel2 = sel1; v1 = g; sel1 = n; }
                    else if (g > v2) { v2 = g; sel2 = n; }
                }
            }
        }
        const float pv0 = __shfl_xor(v0, 32), pv1 = __shfl_xor(v1, 32), pv2 = __shfl_xor(v2, 32);
        const int pn0 = __shfl_xor(sel0, 32), pn1 = __shfl_xor(sel1, 32), pn2 = __shfl_xor(sel2, 32);
#pragma unroll
        for (int k = 0; k < 3; ++k) {
            const float g = k == 0 ? pv0 : (k == 1 ? pv1 : pv2);
            const int n = k == 0 ? pn0 : (k == 1 ? pn1 : pn2);
            if (n >= 0) {
                if (g > v0 || (g == v0 && n < sel0)) { v2 = v1; sel2 = sel1; v1 = v0; sel1 = sel0; v0 = g; sel0 = n; }
                else if (g > v1 || (g == v1 && n < sel1)) { v2 = v1; sel2 = sel1; v1 = g; sel1 = n; }
                else if (g > v2 || (g == v2 && n < sel2)) { v2 = g; sel2 = n; }
            }
        }
        int* lc = (int*)(lds + 16384);
        int* gb = lc + 64;
        int lp0 = 0, lp1 = 0, lp2 = 0;
        if (h == 0) {
            if (sel0 >= 0) lp0 = atomicAdd(lc + sel0, 1);
            if (sel1 >= 0) lp1 = atomicAdd(lc + sel1, 1);
            if (sel2 >= 0) lp2 = atomicAdd(lc + sel2, 1);
        }
        __syncthreads();
        if (tid < 64) gb[tid] = lc[tid] > 0 ? atomicAdd(p.mb_cnt + head * 64 + tid, lc[tid]) : 0;
        __syncthreads();
        if (h == 0) {
            if (sel0 >= 0) p.mb_list[((size_t)head * 64 + sel0) * T_ + gb[sel0] + lp0] = (query << 2) | 0;
            if (sel1 >= 0) p.mb_list[((size_t)head * 64 + sel1) * T_ + gb[sel1] + lp1] = (query << 2) | 1;
            if (sel2 >= 0) p.mb_list[((size_t)head * 64 + sel2) * T_ + gb[sel2] + lp2] = (query << 2) | 2;
        }
    }
}

#define MB_PRE_OFF (2 * ABUF_B)
__device__ __forceinline__ void phase_moba_sparse(const P& p, char* lds) {
    const int tid = otid(), lane = tid & 63, w = tid >> 6, c = lane & 31, h = lane >> 5;
    int* pre = (int*)(lds + MB_PRE_OFF);
    __syncthreads();
    if (tid < 64) {
        int loc[8]; int s = 0;
#pragma unroll
        for (int i = 0; i < 8; ++i) { loc[i] = (p.mb_cnt[tid * 8 + i] + 255) >> 8; s += loc[i]; }
        int incl = s;
#pragma unroll
        for (int o = 1; o < 64; o <<= 1) { const int v = __shfl_up(incl, o); if (tid >= o) incl += v; }
        int run = incl - s;
#pragma unroll
        for (int i = 0; i < 8; ++i) { pre[tid * 8 + i] = run; run += loc[i]; }
        if (tid == 63) pre[512] = run;
    }
    __syncthreads();
    const int total = pre[512];
    auto meta = [&](int u, int& li_, int& chunk_) {
        int lo = 0, hi = 512;
#pragma unroll 1
        while (hi - lo > 1) { const int mid = (lo + hi) >> 1; if (pre[mid] <= u) lo = mid; else hi = mid; }
        li_ = lo; chunk_ = u - pre[lo];
    };
    int li = 0, chunk = 0, cnt = 0, ent = 0, li2 = 0, chunk2 = 0, cnt2 = 0, ent2 = 0;
    bf16x8 qf[4], qf2[4];
#pragma unroll
    for (int kk = 0; kk < 4; ++kk) { qf[kk] = (bf16x8){0, 0, 0, 0, 0, 0, 0, 0}; qf2[kk] = qf[kk]; }
    if ((int)blockIdx.x < total) {
        meta(blockIdx.x, li, chunk);
        cnt = p.mb_cnt[li];
        const int idx0 = chunk * 256 + 32 * w + c;
        ent = p.mb_list[(size_t)li * T_ + idx0];
        const int q0_ = idx0 < cnt ? (ent >> 2) : 0;
        load_qfrag(qf, p.q16 + ((size_t)(8 + (li >> 6)) * T_ + q0_) * 64, h);
    }
#pragma unroll 1
    for (int u = blockIdx.x; u < total; u += gridDim.x) {
        const int un = u + (int)gridDim.x;
        const bool hasn = un < total;
        if (hasn) {
            meta(un, li2, chunk2);
            cnt2 = p.mb_cnt[li2];
            ent2 = p.mb_list[(size_t)li2 * T_ + chunk2 * 256 + 32 * w + c];
        }
        const int head = li >> 6, n = li & 63;
        const int idx = chunk * 256 + 32 * w + c;
        const bool valid = idx < cnt;
        const int query = valid ? (ent >> 2) : 0, slot = ent & 3;
        const bf16_t* kbase = p.k16 + (size_t)(8 + head) * T_ * 64;
        const bf16_t* vtbase = p.vT16 + (size_t)(8 + head) * 64 * T_;
        const float M2 = shift_bound_l2(qnorm2(qf), p.kmax2[8 + head]);
        f32x16 o[2];
#pragma unroll
        for (int i = 0; i < 16; ++i) { o[0][i] = 0.f; o[1][i] = 0.f; }
        float l = 0.f;
        TileRegs tr;
        tile_gload(tr, kbase, vtbase, n * 256);
        __syncthreads();
        tile_swrite(tr, lds);
        __syncthreads();
#pragma unroll 1
        for (int kt = 0; kt < 4; ++kt) {
            if (kt < 3) tile_gload(tr, kbase, vtbase, n * 256 + (kt + 1) * 64);
            if (kt == 1 && hasn) {
                const int q2_ = (chunk2 * 256 + 32 * w + c) < cnt2 ? (ent2 >> 2) : 0;
                load_qfrag(qf2, p.q16 + ((size_t)(8 + (li2 >> 6)) * T_ + q2_) * 64, h);
            }
            const char* kb = lds + (kt & 1) * ABUF_B;
            attn_tile64(kb, kb + KTILE_B, qf, 0xffffffffu, 0xffffffffu, M2, l, o, c, h);
            if (kt < 3) {
                tile_swrite(tr, lds + ((kt + 1) & 1) * ABUF_B);
                __syncthreads();
            }
        }
        l += __shfl_xor(l, 32);
        if (valid) {
            float* po = p.mb_part + (((size_t)head * T_ + query) * 3 + slot) * 64;
#pragma unroll
            for (int dt = 0; dt < 2; ++dt)
#pragma unroll
                for (int g = 0; g < 4; ++g) *(f32x4*)(po + 32 * dt + 8 * g + 4 * h) = (f32x4){o[dt][4 * g], o[dt][4 * g + 1], o[dt][4 * g + 2], o[dt][4 * g + 3]};
            if (h == 0) p.mb_l[((size_t)head * T_ + query) * 3 + slot] = l;
        }
        li = li2; chunk = chunk2; cnt = cnt2; ent = ent2;
#pragma unroll
        for (int kk = 0; kk < 4; ++kk) qf[kk] = qf2[kk];
    }
}

__device__ __forceinline__ void phase_moba_own(const P& p, char* lds) {
    const int tid = otid(), lane = tid & 63, w = tid >> 6, c = lane & 31, h = lane >> 5;
#pragma unroll 1
    for (int t = blockIdx.x; t < 8 * 64; t += gridDim.x) {
        const int head = t & 7, cur = t >> 3;
        const int q0 = cur * 256, qw = q0 + 32 * w, query = qw + c;
        const bf16_t* kbase = p.k16 + (size_t)(8 + head) * T_ * 64;
        const bf16_t* vtbase = p.vT16 + (size_t)(8 + head) * 64 * T_;
        bf16x8 qf[4];
        load_qfrag(qf, p.q16 + ((size_t)(8 + head) * T_ + query) * 64, h);
        const float M2 = shift_bound_l2(qnorm2(qf), p.kmax2[8 + head]);
        f32x16 o[2];
#pragma unroll
        for (int i = 0; i < 16; ++i) { o[0][i] = 0.f; o[1][i] = 0.f; }
        float l = 0.f;
        TileRegs tr;
        tile_gload(tr, kbase, vtbase, q0);
        __syncthreads();
        tile_swrite(tr, lds);
        __syncthreads();
#pragma unroll 1
        for (int kt = 0; kt < 4; ++kt) {
            if (kt < 3) tile_gload(tr, kbase, vtbase, q0 + (kt + 1) * 64);
            const char* kb = lds + (kt & 1) * ABUF_B;
            const int keybase = q0 + kt * 64;
            const unsigned W0 = causal_word(query, keybase), W1 = causal_word(query, keybase + 32);
            if (__ballot((W0 | W1) != 0u) != 0ull) attn_tile64(kb, kb + KTILE_B, qf, W0, W1, M2, l, o, c, h);
            if (kt < 3) {
                tile_swrite(tr, lds + ((kt + 1) & 1) * ABUF_B);
                __syncthreads();
            }
        }
        l += __shfl_xor(l, 32);
        const int nsel = cur < 3 ? cur : 3;
        {
            f32x4 pv[3][2][4];
            float pl[3], ws[3];
#pragma unroll
            for (int sI = 0; sI < 3; ++sI) {
                const int sc = sI < nsel ? sI : 0;
                ws[sI] = sI < nsel ? 1.0f : 0.0f;
                const float* po = p.mb_part + (((size_t)head * T_ + query) * 3 + sc) * 64;
#pragma unroll
                for (int dt = 0; dt < 2; ++dt)
#pragma unroll
                    for (int g = 0; g < 4; ++g) pv[sI][dt][g] = *(const f32x4*)(po + 32 * dt + 8 * g + 4 * h);
                pl[sI] = p.mb_l[((size_t)head * T_ + query) * 3 + sc];
            }
            if (nsel > 0) {
#pragma unroll
                for (int sI = 0; sI < 3; ++sI) {
#pragma unroll
                    for (int dt = 0; dt < 2; ++dt)
#pragma unroll
                        for (int g = 0; g < 4; ++g)
#pragma unroll
                            for (int j = 0; j < 4; ++j) o[dt][4 * g + j] += ws[sI] * pv[sI][dt][g][j];
                    l += ws[sI] * pl[sI];
                }
            }
        }
        store_o(p.o + (size_t)query * DM + 512 + head * 64, o, h, 1.0f / l);
    }
}

__device__ __forceinline__ void attn_tile64_2h(const char* kbA, const char* vbA, const char* kbB, const char* vbB,
                                               const bf16x8 (&qA)[4], const bf16x8 (&qB)[4], unsigned W0, unsigned W1, float MA, float MB,
                                               float& lA, float& lB, f32x16 (&oA)[2], f32x16 (&oB)[2], int c, int h) {
    u32x4 pA[2][2], pB[2][2];
    float lsA = 0.f, lsB = 0.f;
#pragma unroll
    for (int t2 = 0; t2 < 2; ++t2) {
        const unsigned Wh = (t2 ? W1 : W0) >> (4 * h);
        bool ok[16];
#pragma unroll
        for (int r = 0; r < 16; ++r) ok[r] = (Wh >> ((r & 3) + 8 * (r >> 2))) & 1u;
#pragma unroll
        for (int hd = 0; hd < 2; ++hd) {
            const char* kb = hd ? kbB : kbA;
            bf16x8 kf[4];
#pragma unroll
            for (int kk = 0; kk < 4; ++kk) kf[kk] = *(const bf16x8*)(kb + (32 * t2 + c) * KROW + (16 * kk + 8 * h) * 2);
            const float Mx = hd ? MB : MA;
            f32x16 sv;
#pragma unroll
            for (int i = 0; i < 16; ++i) sv[i] = ok[i] ? -Mx : -1.0e30f;
#pragma unroll
            for (int kk = 0; kk < 4; ++kk) sv = __builtin_amdgcn_mfma_f32_32x32x16_bf16(kf[kk], hd ? qB[kk] : qA[kk], sv, 0, 0, 0);
            f32v2_ ls2 = {0.f, 0.f};
#pragma unroll
            for (int sI = 0; sI < 2; ++sI) {
                f32v2_ a2[4];
#pragma unroll
                for (int j = 0; j < 4; ++j) {
                    a2[j][0] = fexp2(sv[8 * sI + 2 * j]);
                    a2[j][1] = fexp2(sv[8 * sI + 2 * j + 1]);
                    ls2 = ls2 + a2[j];
                }
                const u32x4 pk = (u32x4){pack2(a2[0][0], a2[0][1]), pack2(a2[1][0], a2[1][1]), pack2(a2[2][0], a2[2][1]), pack2(a2[3][0], a2[3][1])};
                if (hd) pB[t2][sI] = pk; else pA[t2][sI] = pk;
            }
            if (hd) lsB += ls2[0] + ls2[1]; else lsA += ls2[0] + ls2[1];
        }
    }
    lA += lsA;
    lB += lsB;
#pragma unroll
    for (int hd = 0; hd < 2; ++hd) {
        const char* vb = hd ? vbB : vbA;
#pragma unroll
        for (int t2 = 0; t2 < 2; ++t2) {
            u32x4 vf[2][2];
#pragma unroll
            for (int sI = 0; sI < 2; ++sI)
#pragma unroll
                for (int dt = 0; dt < 2; ++dt) {
                    vf[sI][dt] = *(const u32x4*)(vb + (32 * dt + c) * VROW + (32 * t2 + 16 * sI) * 2 + 16 * h);
                }
#pragma unroll
            for (int sI = 0; sI < 2; ++sI)
#pragma unroll
                for (int dt = 0; dt < 2; ++dt) {
                    if (hd == 0) oA[dt] = __builtin_amdgcn_mfma_f32_32x32x16_bf16(__builtin_bit_cast(bf16x8, vf[sI][dt]), __builtin_bit_cast(bf16x8, pA[t2][sI]), oA[dt], 0, 0, 0);
                    else oB[dt] = __builtin_amdgcn_mfma_f32_32x32x16_bf16(__builtin_bit_cast(bf16x8, vf[sI][dt]), __builtin_bit_cast(bf16x8, pB[t2][sI]), oB[dt], 0, 0, 0);
                }
        }
    }
}

__device__ __forceinline__ void phase_dsa(const P& p, char* lds) {
    const int tid = otid(), lane = tid & 63, w = tid >> 6, c = lane & 31, h = lane >> 5;
    const int G = gridDim.x;
#pragma unroll 1
    for (int r = 0; r * G < 8 * 64; ++r) {
        const int t = zz_unit(r, blockIdx.x, G);
        if (t >= 8 * 64) continue;
        const int hA = (t & 7) * 2, hB = hA + 1, qb = 63 - (t >> 3);
        const int q0 = qb * 256, qw = q0 + 32 * w, query = qw + c;
        const bf16_t* kbaseA = p.k16 + (size_t)hA * T_ * 64;
        const bf16_t* vtbaseA = p.vT16 + (size_t)hA * 64 * T_;
        const bf16_t* kbaseB = p.k16 + (size_t)hB * T_ * 64;
        const bf16_t* vtbaseB = p.vT16 + (size_t)hB * 64 * T_;
        bf16x8 qA[4], qB[4];
        load_qfrag(qA, p.q16 + ((size_t)hA * T_ + query) * 64, h);
        load_qfrag(qB, p.q16 + ((size_t)hB * T_ + query) * 64, h);
        const float MA = shift_bound_l2(qnorm2(qA), p.kmax2[16 + hA]), MB = shift_bound_l2(qnorm2(qB), p.kmax2[16 + hB]);
        f32x16 oA[2], oB[2];
#pragma unroll
        for (int i = 0; i < 16; ++i) { oA[0][i] = 0.f; oA[1][i] = 0.f; oB[0][i] = 0.f; oB[1][i] = 0.f; }
        float lA = 0.f, lB = 0.f;
        const int ktend = (q0 + 255) >> 6;
        TileRegs trA, trB;
        const unsigned* bmq = p.bm + query;
        unsigned W0 = bmq[0], W1 = bmq[(size_t)T_];
        tile_gload(trA, kbaseA, vtbaseA, 0);
        tile_gload(trB, kbaseB, vtbaseB, 0);
        __syncthreads();
        tile_swrite(trA, lds);
        tile_swrite(trB, lds + ABUF_B);
        __syncthreads();
        int buf = 0;
#pragma unroll 1
        for (int kt = 0; kt <= ktend; ++kt) {
            const bool more = kt < ktend;
            const int ktn = more ? kt + 1 : kt;
            const unsigned Wn0 = bmq[(size_t)(2 * ktn) * T_], Wn1 = bmq[(size_t)(2 * ktn + 1) * T_];
            tile_gload(trA, kbaseA, vtbaseA, ktn * 64);
            tile_gload(trB, kbaseB, vtbaseB, ktn * 64);
            const char* kb = lds + buf * (2 * ABUF_B);
            attn_tile64_2h(kb, kb + KTILE_B, kb + ABUF_B, kb + ABUF_B + KTILE_B, qA, qB, W0, W1, MA, MB, lA, lB, oA, oB, c, h);
            if (!more) break;
            tile_swrite(trA, lds + (buf ^ 1) * (2 * ABUF_B));
            tile_swrite(trB, lds + (buf ^ 1) * (2 * ABUF_B) + ABUF_B);
            __syncthreads();
            buf ^= 1;
            W0 = Wn0; W1 = Wn1;
        }
        lA += __shfl_xor(lA, 32);
        lB += __shfl_xor(lB, 32);
        store_o(p.o + (size_t)query * DM + hA * 64, oA, h, 1.0f / lA);
        store_o(p.o + (size_t)query * DM + hB * 64, oB, h, 1.0f / lB);
    }
}
#ifndef FORCE_SLOW
#define FORCE_SLOW 0
#endif
#define IDX_ROWS 32
#define IDX_HIST_B (IDX_ROWS * 4096)
#define IDX_INFO_OFF IDX_HIST_B
#define IDX_CAND_OFF (IDX_HIST_B + 1024)
#define IDX_CAP 16
#define IDX_LDS_B (IDX_CAND_OFF + IDX_ROWS * IDX_CAP * 8)
#define IDX_FCAP 256

template <int CTRL> __device__ __forceinline__ float dpp_f(float v) { return __int_as_float(__builtin_amdgcn_update_dpp(0, __float_as_int(v), CTRL, 0xf, 0xf, false)); }
__device__ __forceinline__ unsigned fkey(float s) {
    const unsigned u = __float_as_uint(s + 0.0f);
    return (u & 0x80000000u) ? ~u : (u | 0x80000000u);
}
__device__ __forceinline__ unsigned sbin(float s) {
    const unsigned u = __float_as_uint(s + 0.0f);
    int t = (int)((u & 0x7fffffffu) >> 17) - (115 << 6);
    t = t < 0 ? 0 : (t > 1023 ? 1023 : t);
    return (u >> 31) ? (unsigned)(1023 - t) : (unsigned)(1024 + t);
}

__device__ __forceinline__ void find_bin(const unsigned* hrow, int need, int lane, int& bin_out, int& above_out) {
    unsigned wv[16];
    const int wbase = 1008 - 16 * lane;
#pragma unroll
    for (int i = 0; i < 4; ++i) {
        const u32x4 q = *(const u32x4*)(hrow + wbase + 4 * i);
        wv[4 * i] = q[0]; wv[4 * i + 1] = q[1]; wv[4 * i + 2] = q[2]; wv[4 * i + 3] = q[3];
    }
    int tot = 0;
#pragma unroll
    for (int i = 0; i < 16; ++i) tot += (int)(wv[i] >> 16) + (int)(wv[i] & 0xffffu);
    int incl = tot;
#pragma unroll
    for (int o = 1; o < 64; o <<= 1) {
        const int v = __shfl_up(incl, o);
        if (lane >= o) incl += v;
    }
    const unsigned long long bal = __ballot(incl >= need);
    const int fl = __ffsll(bal) - 1;
    int b = 0, ab = 0;
    if (lane == fl) {
        int cum = incl - tot;
        bool found = false;
#pragma unroll
        for (int i = 15; i >= 0; --i) {
            const int hi = (int)(wv[i] >> 16), lo = (int)(wv[i] & 0xffffu);
            if (!found) { if (cum + hi >= need) { found = true; b = 2 * (wbase + i) + 1; ab = cum; } else cum += hi; }
            if (!found) { if (cum + lo >= need) { found = true; b = 2 * (wbase + i); ab = cum; } else cum += lo; }
        }
    }
    bin_out = __shfl(b, fl < 0 ? 0 : fl);
    above_out = __shfl(ab, fl < 0 ? 0 : fl);
}

struct IdxCtx {
    bf16x8 af[4];
    float wq[2][8];
    int qabs[2], qloc[2];
};

__device__ __forceinline__ void idx_setup(const P& p, IdxCtx& x, int q0, int w, int c, int h) {
    const int u = ((c >> 4) & 1) + 2 * ((c >> 2) & 1), hd = (c & 3) + 4 * ((c >> 3) & 1);
    const bf16_t* qp = p.qi + ((size_t)(q0 + 4 * w + u) * 8 + hd) * 64;
#pragma unroll
    for (int kk = 0; kk < 4; ++kk) x.af[kk] = *(const bf16x8*)(qp + 16 * kk + 8 * h);
#pragma unroll
    for (int uu = 0; uu < 2; ++uu) {
        x.qloc[uu] = 4 * w + 2 * h + uu;
        x.qabs[uu] = q0 + x.qloc[uu];
        const f32x4 a = *(const f32x4*)(p.wi + (size_t)x.qabs[uu] * 8), b = *(const f32x4*)(p.wi + (size_t)x.qabs[uu] * 8 + 4);
        x.wq[uu][0] = a[0]; x.wq[uu][1] = a[1]; x.wq[uu][2] = a[2]; x.wq[uu][3] = a[3];
        x.wq[uu][4] = b[0]; x.wq[uu][5] = b[1]; x.wq[uu][6] = b[2]; x.wq[uu][7] = b[3];
    }
}
__device__ __forceinline__ void idx_load(const P& p, bf16x8 (&bk)[4], int kt, int c, int h) {
    const bf16_t* kp = p.ki + (size_t)(32 * kt + c) * 64 + 8 * h;
#pragma unroll
    for (int kk = 0; kk < 4; ++kk) bk[kk] = *(const bf16x8*)(kp + 16 * kk);
}
__device__ __forceinline__ void idx_scores(const IdxCtx& x, const bf16x8 (&bk)[4], float& s0, float& s1) {
    f32x16 s;
#pragma unroll
    for (int i = 0; i < 16; ++i) s[i] = 0.f;
#pragma unroll
    for (int kk = 0; kk < 4; ++kk) s = __builtin_amdgcn_mfma_f32_32x32x16_bf16(x.af[kk], bk[kk], s, 0, 0, 0);
    float r[16];
#pragma unroll
    for (int i = 0; i < 16; ++i) r[i] = fmaxf(s[i], 0.f);
    const float e0 = __builtin_fmaf(x.wq[0][6], r[6], __builtin_fmaf(x.wq[0][4], r[4], __builtin_fmaf(x.wq[0][2], r[2], x.wq[0][0] * r[0])));
    const float o0 = __builtin_fmaf(x.wq[0][7], r[7], __builtin_fmaf(x.wq[0][5], r[5], __builtin_fmaf(x.wq[0][3], r[3], x.wq[0][1] * r[1])));
    const float e1 = __builtin_fmaf(x.wq[1][6], r[14], __builtin_fmaf(x.wq[1][4], r[12], __builtin_fmaf(x.wq[1][2], r[10], x.wq[1][0] * r[8])));
    const float o1 = __builtin_fmaf(x.wq[1][7], r[15], __builtin_fmaf(x.wq[1][5], r[13], __builtin_fmaf(x.wq[1][3], r[11], x.wq[1][1] * r[9])));
    s0 = e0 + o0;
    s1 = e1 + o1;
}

__device__ __forceinline__ float relu1(float v) { const int b = __float_as_int(v); return __int_as_float(b > 0 ? b : 0); }
__device__ __forceinline__ void idx_scores2(const IdxCtx& x, const bf16x8 (&bk0)[4], const bf16x8 (&bk1)[4], float& a0, float& a1, float& b0, float& b1) {
    f32x16 s, t;
#pragma unroll
    for (int i = 0; i < 16; ++i) { s[i] = 0.f; t[i] = 0.f; }
#pragma unroll
    for (int kk = 0; kk < 4; ++kk) {
        s = __builtin_amdgcn_mfma_f32_32x32x16_bf16(x.af[kk], bk0[kk], s, 0, 0, 0);
        t = __builtin_amdgcn_mfma_f32_32x32x16_bf16(x.af[kk], bk1[kk], t, 0, 0, 0);
    }
    float r[16], q[16];
#pragma unroll
    for (int i = 0; i < 16; ++i) { r[i] = relu1(s[i]); q[i] = relu1(t[i]); }
    {
        const float e0 = __builtin_fmaf(x.wq[0][6], r[6], __builtin_fmaf(x.wq[0][4], r[4], __builtin_fmaf(x.wq[0][2], r[2], x.wq[0][0] * r[0])));
        const float o0 = __builtin_fmaf(x.wq[0][7], r[7], __builtin_fmaf(x.wq[0][5], r[5], __builtin_fmaf(x.wq[0][3], r[3], x.wq[0][1] * r[1])));
        const float e1 = __builtin_fmaf(x.wq[1][6], r[14], __builtin_fmaf(x.wq[1][4], r[12], __builtin_fmaf(x.wq[1][2], r[10], x.wq[1][0] * r[8])));
        const float o1 = __builtin_fmaf(x.wq[1][7], r[15], __builtin_fmaf(x.wq[1][5], r[13], __builtin_fmaf(x.wq[1][3], r[11], x.wq[1][1] * r[9])));
        a0 = e0 + o0; a1 = e1 + o1;
    }
    {
        const float e0 = __builtin_fmaf(x.wq[0][6], q[6], __builtin_fmaf(x.wq[0][4], q[4], __builtin_fmaf(x.wq[0][2], q[2], x.wq[0][0] * q[0])));
        const float o0 = __builtin_fmaf(x.wq[0][7], q[7], __builtin_fmaf(x.wq[0][5], q[5], __builtin_fmaf(x.wq[0][3], q[3], x.wq[0][1] * q[1])));
        const float e1 = __builtin_fmaf(x.wq[1][6], q[14], __builtin_fmaf(x.wq[1][4], q[12], __builtin_fmaf(x.wq[1][2], q[10], x.wq[1][0] * q[8])));
        const float o1 = __builtin_fmaf(x.wq[1][7], q[15], __builtin_fmaf(x.wq[1][5], q[13], __builtin_fmaf(x.wq[1][3], q[11], x.wq[1][1] * q[9])));
        b0 = e0 + o0; b1 = e1 + o1;
    }
}

#define IDX_RING_OFF IDX_LDS_B
#define IDX_RING_TILE_B (64 * 144)
#define IDX_STAGE_OFF (IDX_RING_OFF + 2 * IDX_RING_TILE_B)
#define IDX_TOTAL_LDS_B (IDX_STAGE_OFF + 2 * 4096)
struct NoHook { __device__ __forceinline__ void operator()(int) const {} };
template <class F, class H = NoHook>
__device__ __forceinline__ void idx_sweep(const P& p, const IdxCtx& x, int ntile, int c, int h, char* lds, F body, H hook = H()) {
    const int tid = otid(), row = tid >> 3, cc = tid & 7;
    char* ring = lds + IDX_RING_OFF;
    const int nt64 = (ntile + 1) >> 1;
    const bf16_t* src = p.ki + (size_t)row * 64 + cc * 8;
    u32x4 reg = *(const u32x4*)src;
    __syncthreads();
    *(u32x4*)(ring + row * 144 + cc * 16) = reg;
    __syncthreads();
#pragma unroll 1
    for (int t = 0; t < nt64; ++t) {
        const bool more = t + 1 < nt64;
        if (more) reg = *(const u32x4*)(src + (size_t)(t + 1) * 64 * 64);
        if (t > 0) hook(t - 1);
        const char* rb = ring + (t & 1) * IDX_RING_TILE_B;
        bf16x8 bk0[4], bk1[4];
#pragma unroll
        for (int kk = 0; kk < 4; ++kk) {
            bk0[kk] = *(const bf16x8*)(rb + c * 144 + 32 * kk + 16 * h);
            bk1[kk] = *(const bf16x8*)(rb + (32 + c) * 144 + 32 * kk + 16 * h);
        }
        __builtin_amdgcn_sched_barrier(0);
        float sa0, sa1, sb0, sb1;
        idx_scores2(x, bk0, bk1, sa0, sa1, sb0, sb1);
        body(2 * t, sa0, sa1);
        body(2 * t + 1, sb0, sb1);
        if (more) *(u32x4*)(ring + ((t + 1) & 1) * IDX_RING_TILE_B + row * 144 + cc * 16) = reg;
        __syncthreads();
    }
    hook(nt64 - 1);
}

__device__ __forceinline__ void idx_unit_slow(const P& p, const IdxCtx& x, char* lds, int q0, int ntile, int tid, int lane, int w, int c, int h) {
    unsigned* hist = (unsigned*)lds;
    int* info = (int*)(lds + IDX_INFO_OFF);
    uint2* cand = (uint2*)(lds + IDX_CAND_OFF);
    __syncthreads();
    if (tid < IDX_ROWS) {
        const int nk = q0 + tid + 1;
        info[tid] = nk < 256 ? nk : 256;
        info[5 * IDX_ROWS + tid] = 0;
    }
#pragma unroll 1
    for (int pass = 0; pass < 3; ++pass) {
        for (int i = tid; i < IDX_HIST_B / 16; i += NTHR) ((u32x4*)hist)[i] = (u32x4){0u, 0u, 0u, 0u};
        __syncthreads();
        int pb1[2], pb2[2];
#pragma unroll
        for (int uu = 0; uu < 2; ++uu) { pb1[uu] = info[IDX_ROWS + x.qloc[uu]]; pb2[uu] = info[3 * IDX_ROWS + x.qloc[uu]]; }
        idx_sweep(p, x, ntile, c, h, lds, [&](int kt, float s0, float s1) {
            const int key = 32 * kt + c;
#pragma unroll
            for (int uu = 0; uu < 2; ++uu) {
                const bool valid = key <= x.qabs[uu];
                const unsigned ku = fkey(uu == 0 ? s0 : s1);
                if (pass == 0) {
                    if (valid) { const unsigned bin = ku >> 21; atomicAdd(hist + x.qloc[uu] * 1024 + (bin >> 1), 1u << (16 * (bin & 1))); }
                } else if (pass == 1) {
                    if (valid && (int)(ku >> 21) == pb1[uu]) { const unsigned bin = (ku >> 10) & 2047u; atomicAdd(hist + x.qloc[uu] * 1024 + (bin >> 1), 1u << (16 * (bin & 1))); }
                } else {
                    const bool sa = x.qabs[uu] < 256;
                    const unsigned pfx = ku >> 10, P22 = ((unsigned)pb1[uu] << 11) | (unsigned)pb2[uu];
                    const bool gt = valid && (sa || pfx > P22);
                    const bool eq = valid && !sa && pfx == P22;
                    const unsigned long long bal = __ballot(gt);
                    if (c == 0) hist[kt * IDX_ROWS + x.qloc[uu]] = h ? (unsigned)(bal >> 32) : (unsigned)bal;
                    if (eq) {
                        const int ix = atomicAdd(info + 5 * IDX_ROWS + x.qloc[uu], 1);
                        if (ix < IDX_CAP) cand[x.qloc[uu] * IDX_CAP + ix] = make_uint2(ku, (unsigned)key);
                    }
                }
            }
        });
        __syncthreads();
        if (pass < 2) {
#pragma unroll 1
            for (int rr = 0; rr < 4; ++rr) {
                const int row = 4 * w + rr;
                const int need = pass == 0 ? info[row] : info[2 * IDX_ROWS + row];
                int b, ab;
                find_bin(hist + row * 1024, need, lane, b, ab);
                if (lane == 0) {
                    if (pass == 0) { info[IDX_ROWS + row] = b; info[2 * IDX_ROWS + row] = need - ab; }
                    else { info[3 * IDX_ROWS + row] = b; info[4 * IDX_ROWS + row] = need - ab; }
                }
            }
            __syncthreads();
        }
    }
    if (tid < IDX_ROWS) {
        const int row = tid, n = info[5 * IDX_ROWS + row] < IDX_CAP ? info[5 * IDX_ROWS + row] : IDX_CAP, need2 = info[4 * IDX_ROWS + row];
        for (int i = 0; i < n; ++i) {
            const uint2 ci = cand[row * IDX_CAP + i];
            int rank = 0;
            for (int j = 0; j < n; ++j) {
                const uint2 cj = cand[row * IDX_CAP + j];
                rank += (cj.x > ci.x || (cj.x == ci.x && cj.y < ci.y)) ? 1 : 0;
            }
            if (rank < need2) hist[(ci.y >> 5) * IDX_ROWS + row] |= 1u << (ci.y & 31u);
        }
    }
    __syncthreads();
}

__device__ __forceinline__ void phase_indexer(const P& p, char* lds) {
    const int tid = otid(), lane = tid & 63, w = tid >> 6, c = lane & 31, h = lane >> 5;
    unsigned* hist = (unsigned*)lds;
    int* info = (int*)(lds + IDX_INFO_OFF);
    uint2* fcand = (uint2*)(lds + 65536);
#pragma unroll 1
    for (int rnd = 0; rnd * (int)gridDim.x < T_ / IDX_ROWS; ++rnd) {
        const int t = zz_unit(rnd, blockIdx.x, gridDim.x);
        if (t >= T_ / IDX_ROWS) continue;
        const int qblk = (T_ / IDX_ROWS - 1) - t;
        const int q0 = qblk * IDX_ROWS;
        IdxCtx x;
        idx_setup(p, x, q0, w, c, h);
        const int ntile = (q0 + IDX_ROWS - 1) / 32 + 1;
        const bool selall_blk = (q0 + IDX_ROWS) <= 256;
        __syncthreads();
        if (tid < IDX_ROWS) {
            const int nk = q0 + tid + 1;
            info[tid] = nk < 256 ? nk : 256;
            info[IDX_ROWS + tid] = 0;
            info[2 * IDX_ROWS + tid] = 0;
            info[5 * IDX_ROWS + tid] = 0;
        }
        const int Lrow = ((ntile + 1) >> 1) * 64;
        unsigned short* bins = (unsigned short*)p.act + (size_t)32 * 64 * ((qblk & 1) ? ((qblk >> 1) + 1) * ((qblk >> 1) + 1) : (qblk >> 1) * ((qblk >> 1) + 1));
        if (!selall_blk) {
            for (int i = tid; i < IDX_HIST_B / 16; i += NTHR) ((u32x4*)hist)[i] = (u32x4){0u, 0u, 0u, 0u};
            __syncthreads();
            idx_sweep(p, x, ntile, c, h, lds, [&](int kt, float s0, float s1) {
                const int key = 32 * kt + c;
                const unsigned b0 = sbin(s0), b1_ = sbin(s1);
                const unsigned inc0 = key <= x.qabs[0] ? (1u << (16 * (b0 & 1))) : 0u, inc1 = key <= x.qabs[1] ? (1u << (16 * (b1_ & 1))) : 0u;
                atomicAdd(hist + x.qloc[0] * 1024 + (b0 >> 1), inc0);
                atomicAdd(hist + x.qloc[1] * 1024 + (b1_ >> 1), inc1);
                const unsigned p0 = b0 | ((unsigned)__builtin_amdgcn_update_dpp(0, (int)b0, 0x101, 0xF, 0xF, true) << 16);
                const unsigned p1 = b1_ | ((unsigned)__builtin_amdgcn_update_dpp(0, (int)b1_, 0x101, 0xF, 0xF, true) << 16);
                const unsigned p0h = (unsigned)__builtin_amdgcn_update_dpp(0, (int)p0, 0x102, 0xF, 0xF, true);
                const unsigned p1h = (unsigned)__builtin_amdgcn_update_dpp(0, (int)p1, 0x102, 0xF, 0xF, true);
                if ((c & 3) == 0) {
                    unsigned short* stg = (unsigned short*)(lds + IDX_STAGE_OFF + ((key >> 6) & 1) * 4096);
                    *(uint2*)(stg + x.qloc[0] * 64 + (key & 63)) = make_uint2(p0, p0h);
                    *(uint2*)(stg + x.qloc[1] * 64 + (key & 63)) = make_uint2(p1, p1h);
                }
            }, [&](int t64) {
                if (tid < 256) *(u32x4*)(bins + (size_t)t64 * 2048 + tid * 8) = *(const u32x4*)(lds + IDX_STAGE_OFF + (t64 & 1) * 4096 + tid * 16);
            });
            __syncthreads();
#pragma unroll 1
            for (int rr = 0; rr < 4; ++rr) {
                const int row = 4 * w + rr;
                int b, ab;
                find_bin(hist + row * 1024, info[row], lane, b, ab);
                if (lane == 0) { info[IDX_ROWS + row] = b; info[2 * IDX_ROWS + row] = info[row] - ab; }
            }
            __syncthreads();
        }
        for (int i = tid; i < 65536 / 16; i += NTHR) ((u32x4*)hist)[i] = (u32x4){0u, 0u, 0u, 0u};
        __syncthreads();
        {
            const int row = 4 * w + ((lane >> 3) & 3), kc = lane & 7, th = lane >> 5, qrow = q0 + row;
            const int tb = info[IDX_ROWS + row];
            const bool sa = selall_blk;
            const int nt64 = Lrow >> 6;
            const unsigned short* br = bins + row * 64 + 8 * kc;
            const int nstep = (nt64 + 1) >> 1;
            const int tmax = nt64 - 1;
            auto ldg = [&](u32x4 (&d)[8], int g) {
#pragma unroll
                for (int u = 0; u < 8; ++u) { const int tl = 2 * (g + u) + th; d[u] = *(const u32x4*)(br + (size_t)(tl < tmax ? tl : tmax) * 2048); }
            };
            auto proc = [&](const u32x4 (&d)[8], int g) {
#pragma unroll
                for (int u = 0; u < 8; ++u) {
                    const int st = g + u;
                    const int tile = 2 * st + th, k0 = tile * 64 + 8 * kc;
                    const u32x4 cur = d[u];
                    unsigned m8 = 0u, e8 = 0u;
#pragma unroll
                    for (int i = 0; i < 8; ++i) {
                        const int bn = (int)((cur[i >> 1] >> (16 * (i & 1))) & 0xffffu), key = k0 + i;
                        const bool v = key <= qrow && tile < nt64;
                        if (v && (sa || bn > tb)) m8 |= 1u << i;
                        if (v && !sa && bn == tb) e8 |= 1u << i;
                    }
                    if (e8) {
                        int ix = atomicAdd(info + 5 * IDX_ROWS + row, __builtin_popcount(e8));
                        while (e8) {
                            const int i = __builtin_ctz(e8);
                            if (ix < IDX_FCAP) fcand[row * IDX_FCAP + ix] = make_uint2(0u, (unsigned)(k0 + i));
                            ++ix;
                            e8 &= e8 - 1u;
                        }
                    }
                    const unsigned w1 = (unsigned)__builtin_amdgcn_update_dpp(0, (int)m8, 0x101, 0xF, 0xF, true);
                    const unsigned w2 = (unsigned)__builtin_amdgcn_update_dpp(0, (int)m8, 0x102, 0xF, 0xF, true);
                    const unsigned w3 = (unsigned)__builtin_amdgcn_update_dpp(0, (int)m8, 0x103, 0xF, 0xF, true);
                    if ((kc & 3) == 0 && tile < nt64) hist[(tile * 2 + (kc >> 2)) * IDX_ROWS + row] = m8 | (w1 << 8) | (w2 << 16) | (w3 << 24);
                }
            };
            u32x4 ra[8], rb[8];
            ldg(ra, 0);
#pragma unroll 1
            for (int g = 0; g < nstep; g += 16) {
                ldg(rb, g + 8);
                proc(ra, g);
                if (g + 8 >= nstep) break;
                ldg(ra, g + 16);
                proc(rb, g + 8);
            }
        }
        const int ovf = __syncthreads_or(FORCE_SLOW || (tid < IDX_ROWS && info[5 * IDX_ROWS + tid] > IDX_FCAP));
        if (ovf) {
            idx_unit_slow(p, x, lds, q0, ntile, tid, lane, w, c, h);
        } else {
#pragma unroll 1
            for (int rr = 0; rr < 4; ++rr) {
                const int row = 4 * w + rr, n = info[5 * IDX_ROWS + row], need1 = info[2 * IDX_ROWS + row];
                uint2* cl = fcand + row * IDX_FCAP;
                if (n > 0) {
                    const int hd = lane >> 3, dc = lane & 7;
                    const bf16x8 qv = *(const bf16x8*)(p.qi + ((size_t)(q0 + row) * 8 + hd) * 64 + 8 * dc);
                    const float wgt = p.wi[(size_t)(q0 + row) * 8 + hd];
                    auto ldk = [&](bf16x8 (&kv)[8], int j0) {
#pragma unroll
                        for (int u = 0; u < 8; ++u) {
                            const unsigned key = cl[j0 + u < n ? j0 + u : n - 1].y;
                            kv[u] = *(const bf16x8*)(p.ki + (size_t)key * 64 + 8 * dc);
                        }
                    };
                    auto red = [&](const bf16x8 (&kv)[8], int j0) {
#pragma unroll
                        for (int u = 0; u < 8; ++u) {
                            float d = 0.f;
#pragma unroll
                            for (int e = 0; e < 8; ++e) d = __builtin_fmaf(bf2f((bf16_t)qv[e]), bf2f((bf16_t)kv[u][e]), d);
                            d += dpp_f<0xB1>(d); d += dpp_f<0x4E>(d); d += dpp_f<0x141>(d);
                            float sc = wgt * fmaxf(d, 0.f);
                            sc += dpp_f<0x128>(sc);
                            const float s1 = __int_as_float(__builtin_amdgcn_readlane(__float_as_int(sc), 16)), s2 = __int_as_float(__builtin_amdgcn_readlane(__float_as_int(sc), 32)),
                                        s3 = __int_as_float(__builtin_amdgcn_readlane(__float_as_int(sc), 48));
                            sc = (sc + s1) + (s2 + s3);
                            if (lane == 0 && j0 + u < n) cl[j0 + u].x = fkey(sc);
                        }
                    };
                    bf16x8 kvA[8], kvB[8];
                    ldk(kvA, 0);
#pragma unroll 1
                    for (int j0 = 0; j0 < n; j0 += 16) {
                        ldk(kvB, j0 + 8);
                        red(kvA, j0);
                        if (j0 + 8 >= n) break;
                        ldk(kvA, j0 + 16);
                        red(kvB, j0 + 8);
                    }
                }
                __builtin_amdgcn_s_waitcnt(0xc07f);
                __builtin_amdgcn_wave_barrier();
#pragma unroll 1
                for (int i0 = 0; i0 < n; i0 += 64) {
                    const int i = i0 + lane;
                    const uint2 ci = cl[i < n ? i : 0];
                    int rank = 0;
#pragma unroll 1
                    for (int j = 0; j < n; ++j) {
                        const uint2 cj = cl[j];
                        rank += (cj.x > ci.x || (cj.x == ci.x && cj.y < ci.y)) ? 1 : 0;
                    }
                    if (i < n && rank < need1) atomicOr(hist + (ci.y >> 5) * IDX_ROWS + row, 1u << (ci.y & 31u));
                }
            }
            __syncthreads();
        }
        const int nw = (((q0 & ~255) >> 5) + 8) * IDX_ROWS;
        for (int i = tid; i < nw; i += NTHR) {
            const int kt = i / IDX_ROWS, r = i % IDX_ROWS;
            p.bm[(size_t)kt * T_ + q0 + r] = hist[i];
        }
    }
}
#define XB_TMO      128
#define XB_XCNT(j)  (256  + 64 * (j))
#define XB_XSUB(j)  (1280 + 64 * (j))
#define XB_XGEN(j)  (2304 + 64 * (j))
#define XB_TOP      3328
#define XB_TOPGEN   3392
#define XCD_BAR_WORDS 3456
#define XB_SPIN_CAP (1u << 22)
#define LAS __attribute__((address_space(3)))

__device__ __forceinline__ unsigned xb_ld(unsigned* p)              { return __hip_atomic_load(p, __ATOMIC_RELAXED, __HIP_MEMORY_SCOPE_AGENT); }
__device__ __forceinline__ unsigned xb_add(unsigned* p, unsigned v) { return __hip_atomic_fetch_add(p, v, __ATOMIC_RELAXED, __HIP_MEMORY_SCOPE_AGENT); }
__device__ __forceinline__ unsigned xb_xcc_id() { return (unsigned)__builtin_amdgcn_s_getreg((3 << 11) | 20) & 0xFu; }
#define XB_SPIN(cond, bar) do { unsigned _sp = 0; while (cond) { __builtin_amdgcn_s_sleep(1); \
    if ((++_sp & 255u) == 0u) { if (xb_ld(&(bar)[XB_TMO])) break; if (_sp > XB_SPIN_CAP) { atomicAdd(&(bar)[XB_TMO], 1u); break; } } } } while (0)

struct XcdBarrier { unsigned* bar; unsigned x; volatile LAS unsigned* st; };

__device__ __forceinline__ XcdBarrier xcd_barrier_post(unsigned* bar, volatile LAS unsigned* st) {
    XcdBarrier b; b.bar = bar; b.x = xb_xcc_id(); b.st = st;
    if (threadIdx.x == 0) (void)xb_add(&bar[XB_XCNT(b.x)], 1u);
    return b;
}
__device__ __forceinline__ void xcd_barrier_complete(unsigned* bar, unsigned x, unsigned& nloc, unsigned& nx) {
    const unsigned G = gridDim.x * gridDim.y * gridDim.z;
    unsigned sum, cnt, mine, sp = 0u;
    for (;;) {
        sum = 0u; cnt = 0u; mine = 0u;
#pragma unroll
        for (unsigned j = 0; j < 16; ++j) { const unsigned c = xb_ld(&bar[XB_XCNT(j)]); sum += c; cnt += (c > 0u) ? 1u : 0u; mine = (j == x) ? c : mine; }
        if (sum == G) break;
        __builtin_amdgcn_s_sleep(1);
        if ((++sp & 255u) == 0u) { if (xb_ld(&bar[XB_TMO])) break; if (sp > XB_SPIN_CAP) { atomicAdd(&bar[XB_TMO], 1u); break; } }
    }
    nloc = mine > 0u ? mine : 1u; nx = cnt > 0u ? cnt : 1u;
}
__device__ __forceinline__ void xcd_barrier(const XcdBarrier& b) {
    asm volatile("s_waitcnt vmcnt(0)" ::: "memory");
    __syncthreads();
    if (threadIdx.x == 0) {
        unsigned* bar = b.bar;
        __builtin_amdgcn_s_waitcnt(0);
        unsigned nloc = b.st[0], nx = b.st[1];
        if (nloc == 0u) { xcd_barrier_complete(bar, b.x, nloc, nx); b.st[0] = nloc; b.st[1] = nx; }
        const unsigned old = xb_add(&bar[XB_XSUB(b.x)], 1u);
        const unsigned gen = old / nloc;
        if (old + 1u == (gen + 1u) * nloc) {
            __builtin_amdgcn_fence(__ATOMIC_RELEASE, "agent");
            asm volatile("s_waitcnt vmcnt(0)" ::: "memory");
            const unsigned og = xb_add(&bar[XB_TOP], 1u);
            const unsigned tg = og / nx;
            if (og + 1u == (tg + 1u) * nx) xb_add(&bar[XB_TOPGEN], 1u);
            else XB_SPIN(xb_ld(&bar[XB_TOPGEN]) == tg, bar);
            __builtin_amdgcn_fence(__ATOMIC_ACQUIRE, "agent");
            xb_add(&bar[XB_XGEN(b.x)], 1u);
            asm volatile("s_waitcnt vmcnt(0)" ::: "memory");
        } else {
            XB_SPIN(xb_ld(&bar[XB_XGEN(b.x)]) == gen, bar);
            __builtin_amdgcn_fence(__ATOMIC_ACQUIRE, "agent");
            asm volatile("s_waitcnt vmcnt(0)" ::: "memory");
        }
    }
    __syncthreads();
}


#define GSYNC() xcd_barrier(xb)
#define MEGA_LDS_B (IDX_TOTAL_LDS_B > (RT_DEC_OFF + 4096) ? IDX_TOTAL_LDS_B : (RT_DEC_OFF + 4096))
template <int layer>
__device__ __forceinline__ void tail_phases(const P& p, char* lds, const XcdBarrier& xb) {
    phase_outproj(p, layer == 0 ? p.wb_ab_out : p.wb_c_out, p.xb, lds);
    GSYNC();
    phase_ln_router(p, layer, lds);
    GSYNC();
    phase_moe1(p, layer, lds);
    GSYNC();
    phase_moe2(p, layer, lds);
    GSYNC();
    phase_combine_ln(p, layer, lds);
    GSYNC();
    phase_ple(p, layer, layer == 0 ? (float*)nullptr : p.out, lds);
    if (layer == 0) GSYNC();
}

__global__ void __launch_bounds__(512, 2) mega(P p) {
    extern __shared__ __attribute__((aligned(16))) char lds[];
    cg::grid_group grid = cg::this_grid();
    volatile LAS unsigned* st = (volatile LAS unsigned*)(lds + MEGA_LDS_B);
    if (threadIdx.x == 0) { st[0] = 0u; st[1] = 0u; }
    __syncthreads();
    const XcdBarrier xb = xcd_barrier_post(p.bar, st);
    phase_convert(p, lds);
    if (p.bar == nullptr) grid.sync();
    xcd_barrier(xb);
    const int half_ = (int)(blockIdx.x >> 3) & 1;
    if (half_ == 0) conv_moe_layer(p, 0, lds);
    phase_pp(p, lds);
    phase_inproj<0>(p, lds);
    if (half_ == 1) conv_moe_layer(p, 1, lds);
    GSYNC();
    phase_moba_gate(p, lds);
    phase_sb(p, lds);
    GSYNC();
    phase_moba_sparse(p, lds);
    GSYNC();
    phase_moba_own(p, lds);
    GSYNC();
#if defined(DEBUG_STAGE) && (DEBUG_STAGE == 2 || DEBUG_STAGE == 1)
    return;
#endif
    tail_phases<0>(p, lds, xb);
    phase_inproj<1>(p, lds);
    GSYNC();
    phase_indexer(p, lds);
    GSYNC();
    phase_dsa(p, lds);
    GSYNC();
    tail_phases<1>(p, lds, xb);
}

static inline char* carve(char*& cur, size_t bytes) { char* r = cur; cur += (bytes + 255) & ~(size_t)255; return r; }

static void make_params(P& p, void* const* d_in, void* d_out, void* d_ws) {
    p.x = (const float*)d_in[0]; p.p = (const float*)d_in[1]; p.ab_w_in = (const float*)d_in[2]; p.ab_w_out = (const float*)d_in[3];
    p.c_w_in = (const float*)d_in[4]; p.c_w_out = (const float*)d_in[5]; p.ln_g = (const float*)d_in[6]; p.ln_b = (const float*)d_in[7];
    p.router_w = (const float*)d_in[8]; p.router_b = (const float*)d_in[9]; p.moe_w1 = (const float*)d_in[10]; p.moe_b1 = (const float*)d_in[11];
    p.moe_w2 = (const float*)d_in[12]; p.moe_b2 = (const float*)d_in[13]; p.ple_w_proj = (const float*)d_in[14]; p.ple_w_gate = (const float*)d_in[15];
    p.out = (float*)d_out;
    char* cur = (char*)d_ws;
    const size_t T = T_;
    p.cnt = (int*)carve(cur, 256);
    p.dbg = (float*)carve(cur, 256);
    p.dyn = (unsigned*)carve(cur, 256);
    p.bar = (unsigned*)carve(cur, XCD_BAR_WORDS * sizeof(unsigned));
    p.wb_ab_in = (bf16_t*)carve(cur, (size_t)3072 * 1024 * 2);
    p.wb_ab_out = (bf16_t*)carve(cur, (size_t)1024 * 1024 * 2);
    p.wb_c_in = (bf16_t*)carve(cur, (size_t)C_INP * 1024 * 2);
    p.ksum = (float*)carve(cur, 8 * 64 * 64 * 4);
    p.kmax2 = (unsigned*)carve(cur, 256);
    p.mb_cnt = (int*)carve(cur, 512 * 4);
    p.mb_list = (int*)carve(cur, (size_t)512 * T * 4);
    p.mb_part = (float*)carve(cur, (size_t)8 * T * 3 * 64 * 4);
    p.mb_l = (float*)carve(cur, (size_t)8 * T * 3 * 4);
    p.wb_c_out = (bf16_t*)carve(cur, (size_t)1024 * 1024 * 2);
    p.wb_w1 = (bf16_t*)carve(cur, (size_t)64 * 2048 * 1024 * 2);
    p.wb_w2 = (bf16_t*)carve(cur, (size_t)64 * 1024 * 1024 * 2);
    p.wb_g = (bf16_t*)carve(cur, (size_t)2 * 1024 * 1024 * 2);
    p.wb_p = (bf16_t*)carve(cur, (size_t)2 * 1024 * 256 * 2);
    p.xb = (bf16_t*)carve(cur, T * DM * 2);
    p.pb = (bf16_t*)carve(cur, 2 * T * 256 * 2);
    p.pp = (float*)carve(cur, 2 * T * DM * 4);
    p.rope = (float*)carve(cur, T * 32 * 2 * 4);
    p.q16 = (bf16_t*)carve(cur, 16 * T * 64 * 2);
    p.k16 = (bf16_t*)carve(cur, 16 * T * 64 * 2);
    p.vT16 = (bf16_t*)carve(cur, 16 * T * 64 * 2);
    p.o = (bf16_t*)carve(cur, T * DM * 2);
    p.ypre = (float*)carve(cur, T * DM * 4);
    p.x1 = (float*)carve(cur, T * DM * 4);
    p.x1b = (bf16_t*)carve(cur, T * DM * 2);
    p.act = (bf16_t*)carve(cur, (size_t)(65536 + 32 * 256) * DM * 2);
    p.oslot = (bf16_t*)carve(cur, (size_t)(65536 + 32 * 256) * DM * 2);
    p.x2 = (float*)carve(cur, T * DM * 4);
    p.x2b = (bf16_t*)carve(cur, T * DM * 2);
    p.x3 = (float*)carve(cur, T * DM * 4);
    p.qi = (bf16_t*)carve(cur, T * 8 * 64 * 2);
    p.ki = (bf16_t*)carve(cur, T * 64 * 2);
    p.wi = (float*)carve(cur, T * 8 * 4);
    p.bm = (unsigned*)carve(cur, (size_t)512 * T * 4);
    p.tok_of = (int*)carve(cur, (size_t)32 * T * 4);
    p.sel_e = (int*)carve(cur, T * 4 * 4);
    p.sel_pos = (int*)carve(cur, T * 4 * 4);
    p.sel_g = (float*)carve(cur, T * 4 * 4);
}

extern "C" void kernel_launch(void* const* d_in, const int* in_sizes, int n_in, void* d_out, int out_size, void* d_ws, size_t ws_size, hipStream_t stream) {
    P p{};
    make_params(p, d_in, d_out, d_ws);
    constexpr size_t kDynLds = MEGA_LDS_B + 16;
    static int grid_blocks = 0;
    if (!grid_blocks) {
        int dev = 0, cus = 0, per_cu = 0;
        hipGetDevice(&dev);
        hipDeviceGetAttribute(&cus, hipDeviceAttributeMultiprocessorCount, dev);
        hipFuncSetAttribute((const void*)mega, hipFuncAttributeMaxDynamicSharedMemorySize, (int)kDynLds);
        hipOccupancyMaxActiveBlocksPerMultiprocessor(&per_cu, mega, NTHR, kDynLds);
        if (per_cu > 1) per_cu = 1;
        if (per_cu < 1) per_cu = 1;
        grid_blocks = cus * per_cu;
    }
    hipMemsetAsync(p.dyn, 0, 256 + XCD_BAR_WORDS * sizeof(unsigned), stream);
    void* args[] = {&p};
    hipError_t e = hipLaunchCooperativeKernel((void*)mega, dim3(grid_blocks), dim3(NTHR), args, kDynLds, stream);
    if (e != hipSuccess) fprintf(stderr, "cooperative launch failed: %s (grid %d)\n", hipGetErrorString(e), grid_blocks);
#if defined(DEBUG_STAGE) && DEBUG_STAGE == 1
    k_dbg_zero<<<1, 64, 0, stream>>>(p);
    k_chk_sb<<<512, 64, 0, stream>>>(p);
    k_report<<<1024, 256, 0, stream>>>(p, 0, 100.0f);
#endif
#if defined(DEBUG_STAGE) && DEBUG_STAGE == 5
    k_dbg_zero<<<1, 64, 0, stream>>>(p);
    k_chk_moe<<<128, 256, 0, stream>>>(p);
    k_report<<<1024, 256, 0, stream>>>(p, 0, 100.0f);
#endif
#if defined(DEBUG_STAGE) && DEBUG_STAGE == 4
    k_dbg_zero<<<1, 64, 0, stream>>>(p);
    k_chk_dsa<<<512, 64, 0, stream>>>(p);
    k_report<<<1024, 256, 0, stream>>>(p, 0, 100.0f);
#endif
#if defined(DEBUG_STAGE) && DEBUG_STAGE == 3
    k_dbg_zero<<<1, 64, 0, stream>>>(p);
    k_chk_idx<<<32, 256, 65536, stream>>>(p);
    k_report<<<1024, 256, 0, stream>>>(p, 1, 1.0f / 32.0f);
#endif
#if defined(DEBUG_STAGE) && DEBUG_STAGE == 2
    k_dbg_zero<<<1, 64, 0, stream>>>(p);
    k_chk_moba<<<512, 64, 0, stream>>>(p);
    k_report<<<1024, 256, 0, stream>>>(p, 1, 1.0f);
#endif
}
```
